# Optimizing an MI355X kernel written in HIP

```python
import jax, jax.numpy as jnp
from jax import lax
import numpy as np

D_MODEL = 1024
BATCH = 8
SEQ = 8192
DEPTH = 4

N_MIXERS = 4
RMS_EPS = 1e-6
N_MOD = 6

SB_HEADS = 16
SB_HEAD_DIM = D_MODEL // SB_HEADS
SB_QBLOCK = 128

GLA_HEADS = 4
GLA_DK = D_MODEL // (2 * GLA_HEADS)
GLA_DV = D_MODEL // GLA_HEADS
GLA_GATE_RANK = 16
GLA_GATE_TAU = 16.0
GLA_CHUNK = 64
GLA_IN = 2 * GLA_HEADS * GLA_DK + 2 * GLA_HEADS * GLA_DV + GLA_GATE_RANK

CONV_WIDTH = 3

DIL_PATTERNS = ((128, 1), (512, 4), (2048, 16))
DIL_GROUPS = len(DIL_PATTERNS)
DIL_HEADS = 8
DIL_HEAD_DIM = 64
DIL_QBLOCK = 128

MOE_GROUPS = 4
MOE_PER_GROUP = 8
MOE_EXPERTS = MOE_GROUPS * MOE_PER_GROUP
MOE_TOPK = 2
MOE_D_FF = D_MODEL // 2
MOE_BLOCK = 128

N_SB = (DEPTH + 3) // N_MIXERS
N_GLA = (DEPTH + 2) // N_MIXERS
N_CONV = (DEPTH + 1) // N_MIXERS
N_DIL = DEPTH // N_MIXERS

kernel_name = "hybrid_sb_gla_conv_dilated_hmoe"


def rms_norm(x, g):
    x32 = x.astype(jnp.float32)
    y = x32 * lax.rsqrt(jnp.mean(x32 * x32, axis=-1, keepdims=True) + RMS_EPS)
    return (y * g.astype(jnp.float32)).astype(x.dtype)


def stick_breaking_attention(q, k, v):
    B, H, S, d = q.shape
    nb = S // SB_QBLOCK
    scale = d ** -0.5
    kpos = jnp.arange(S)
    qb = jnp.moveaxis(q.reshape(B, H, nb, SB_QBLOCK, d), 2, 0)

    def one_block(args):
        q_blk, blk = args
        qpos = blk * SB_QBLOCK + jnp.arange(SB_QBLOCK)
        z = jnp.einsum('bhqd,bhkd->bhqk', q_blk, k, preferred_element_type=jnp.float32) * scale
        causal = kpos[None, :] < qpos[:, None]
        log_keep = jnp.where(causal, jax.nn.log_sigmoid(-z), 0.0)
        suffix = lax.cumsum(log_keep, axis=3, reverse=True) - log_keep
        a = jnp.where(causal, jnp.exp(jax.nn.log_sigmoid(z) + suffix), 0.0)
        return jnp.einsum('bhqk,bhkd->bhqd', a.astype(v.dtype), v)

    out = lax.map(one_block, (qb, jnp.arange(nb)))
    return jnp.moveaxis(out, 0, 2).reshape(B, H, S, d)


def sb_mixer(h, w_in, w_out):
    B, S, _ = h.shape
    qkv = (h @ w_in).reshape(B, S, 3, SB_HEADS, SB_HEAD_DIM)
    qkv = jnp.transpose(qkv, (2, 0, 3, 1, 4))
    o = stick_breaking_attention(qkv[0], qkv[1], qkv[2])
    return jnp.transpose(o, (0, 2, 1, 3)).reshape(B, S, SB_HEADS * SB_HEAD_DIM) @ w_out


def gla_chunked(q, k, v, log_a):
    B, H, S, dk = q.shape
    dv = v.shape[-1]
    C = GLA_CHUNK
    nc = S // C
    f32 = jnp.float32

    def chunks(a):
        return a.astype(f32).reshape(B, H, nc, C, a.shape[-1])

    q, k, v, g = chunks(q), chunks(k), chunks(v), chunks(log_a)
    b = jnp.cumsum(g, axis=3)
    b_last = b[:, :, :, -1:, :]
    q_in = q * jnp.exp(b)
    k_in = k * jnp.exp(-b)
    k_state = k * jnp.exp(b_last - b)
    causal = jnp.tril(jnp.ones((C, C), dtype=bool))
    scores = jnp.where(causal, jnp.einsum('bhnid,bhnjd->bhnij', q_in, k_in), 0.0)
    o_intra = jnp.einsum('bhnij,bhnjv->bhniv', scores, v)

    def step(state, inp):
        q_n, k_n, v_n, decay_n = inp
        o_n = jnp.einsum('bhid,bhdv->bhiv', q_n, state)
        state = decay_n[..., None] * state + jnp.einsum('bhjd,bhjv->bhdv', k_n, v_n)
        return state, o_n

    xs = (jnp.moveaxis(q_in, 2, 0), jnp.moveaxis(k_state, 2, 0), jnp.moveaxis(v, 2, 0),
          jnp.moveaxis(jnp.exp(b_last[:, :, :, 0, :]), 2, 0))
    _, o_inter = lax.scan(step, jnp.zeros((B, H, dk, dv), f32), xs)
    o = o_intra + jnp.moveaxis(o_inter, 0, 2)
    return o.reshape(B, H, S, dv)


def gla_mixer(h, w_in, w_gate_up, b_gate, norm_g, w_out):
    B, S, _ = h.shape
    dqk = GLA_HEADS * GLA_DK
    dv = GLA_HEADS * GLA_DV
    proj = h @ w_in
    q, k, v, r, g_down = jnp.split(proj, [dqk, 2 * dqk, 2 * dqk + dv, 2 * dqk + 2 * dv], axis=-1)
    log_a = jax.nn.log_sigmoid((g_down @ w_gate_up + b_gate).astype(jnp.float32)) / GLA_GATE_TAU

    def heads(a, d):
        return jnp.transpose(a.reshape(B, S, GLA_HEADS, d), (0, 2, 1, 3))

    o = gla_chunked(heads(q, GLA_DK) * GLA_DK ** -0.5, heads(k, GLA_DK),
                    heads(v, GLA_DV), heads(log_a, GLA_DK))
    o = rms_norm(o, norm_g)
    o = jnp.transpose(o, (0, 2, 1, 3)).reshape(B, S, dv).astype(h.dtype) * jax.nn.silu(r)
    return o @ w_out


def conv_mixer(h, w_in, conv_w, conv_b, w_out):
    S = h.shape[1]
    gate_b, gate_c, u = jnp.split(h @ w_in, 3, axis=-1)
    u = gate_c * u
    u_pad = jnp.pad(u, ((0, 0), (CONV_WIDTH - 1, 0), (0, 0)))
    y = sum(conv_w[j] * u_pad[:, j:j + S] for j in range(CONV_WIDTH)) + conv_b
    return (gate_b * y) @ w_out


def dilated_window_attention(q, k, v, window, dilation):
    B, H, S, d = q.shape
    Q = DIL_QBLOCK
    steps = window // dilation
    span = dilation * Q
    Sp = -(-S // span) * span
    L = Sp // dilation
    nb = L // Q

    def strided(a):
        a = jnp.pad(a, ((0, 0), (0, 0), (0, Sp - S), (0, 0)))
        a = jnp.transpose(a.reshape(B, H, L, dilation, d), (0, 1, 3, 2, 4))
        return a.reshape(B, H, dilation, nb, Q, d)

    def with_prev(a):
        prev = jnp.concatenate([jnp.zeros_like(a[:, :, :, :1]), a[:, :, :, :-1]], axis=3)
        return jnp.concatenate([prev, a], axis=4)

    qb = strided(q)
    kc, vc = with_prev(strided(k)), with_prev(strided(v))
    z = jnp.einsum('bhrnqd,bhrnkd->bhrnqk', qb, kc, preferred_element_type=jnp.float32) * d ** -0.5
    qi = jnp.arange(Q)[:, None]
    kj = jnp.arange(2 * Q)[None, :]
    dist = qi + Q - kj
    in_window = (dist >= 0) & (dist <= steps)
    before_start = (jnp.arange(nb)[:, None, None] == 0) & (kj < Q)[None]
    valid = in_window[None] & ~before_start
    z = jnp.where(valid, z, -jnp.inf)
    m = jnp.max(z, axis=-1, keepdims=True)
    lse = m + jnp.log(jnp.sum(jnp.exp(z - m), axis=-1, keepdims=True))
    p = jnp.exp(z - lse)
    o = jnp.einsum('bhrnqk,bhrnkd->bhrnqd', p.astype(vc.dtype), vc)

    def unstride(a):
        e = a.shape[-1]
        a = jnp.moveaxis(a.reshape(B, H, dilation, L, e), 2, 3).reshape(B, H, Sp, e)
        return a[:, :, :S]

    return unstride(o), unstride(lse)[..., 0]


def dil_mixer(h, w_in, w_out):
    B, S, _ = h.shape
    proj = (h @ w_in).reshape(B, S, DIL_GROUPS, 3, DIL_HEADS, DIL_HEAD_DIM)
    proj = jnp.transpose(proj, (2, 3, 0, 4, 1, 5))
    outs, lses = [], []
    for g, (window, dilation) in enumerate(DIL_PATTERNS):
        o_g, lse_g = dilated_window_attention(proj[g, 0], proj[g, 1], proj[g, 2], window, dilation)
        outs.append(o_g)
        lses.append(lse_g)
    o = jnp.stack(outs)
    w = jax.nn.softmax(jnp.stack(lses), axis=0)
    o = jnp.einsum('gbhs,gbhsd->bshd', w.astype(o.dtype), o).reshape(B, S, DIL_HEADS * DIL_HEAD_DIM)
    return o @ w_out


def hier_moe(h, w_grp, b_grp, w_exp, b_exp, w_gate, w_up, w_down):
    T, D = h.shape
    f32 = jnp.float32
    grp_logits = (h @ w_grp + b_grp).astype(f32)
    grp = jnp.argmax(grp_logits, axis=-1)
    p_grp = jnp.take_along_axis(jax.nn.softmax(grp_logits, axis=-1), grp[:, None], axis=-1)
    exp_logits = (h @ w_exp + b_exp).astype(f32).reshape(T, MOE_GROUPS, MOE_PER_GROUP)
    in_grp = jnp.take_along_axis(exp_logits, grp[:, None, None], axis=1)[:, 0]
    p_in, top_i = lax.top_k(jax.nn.softmax(in_grp, axis=-1), MOE_TOPK)
    gate = p_grp * p_in / jnp.sum(p_in, axis=-1, keepdims=True)
    expert = grp[:, None] * MOE_PER_GROUP + top_i

    A = T * MOE_TOPK
    flat_e = expert.reshape(A)
    order = jnp.argsort(flat_e)
    sorted_e = flat_e[order]
    sorted_tok = order // MOE_TOPK
    sorted_w = gate.reshape(A)[order]
    counts = jnp.bincount(flat_e, length=MOE_EXPERTS)
    padded = (counts + MOE_BLOCK - 1) // MOE_BLOCK * MOE_BLOCK
    pad_end = jnp.cumsum(padded)
    pad_start = pad_end - padded
    start = jnp.cumsum(counts) - counts
    dest = pad_start[sorted_e] + jnp.arange(A) - start[sorted_e]
    P = (-(-A // MOE_BLOCK) + MOE_EXPERTS) * MOE_BLOCK
    NB = P // MOE_BLOCK
    slot_tok = jnp.full((P,), T, dtype=jnp.int32).at[dest].set(sorted_tok.astype(jnp.int32))
    slot_w = jnp.zeros((P,), f32).at[dest].set(sorted_w)
    blk_e = jnp.minimum(jnp.searchsorted(pad_end, jnp.arange(NB) * MOE_BLOCK, side='right'),
                        MOE_EXPERTS - 1)
    h_pad = jnp.concatenate([h, jnp.zeros((1, D), h.dtype)], axis=0)
    xb = h_pad[slot_tok].reshape(NB, MOE_BLOCK, D)

    def expert_block(args):
        x_blk, e = args
        return (jax.nn.silu(x_blk @ w_gate[e]) * (x_blk @ w_up[e])) @ w_down[e]

    yb = lax.map(expert_block, (xb, blk_e)).reshape(P, D)
    y = jax.ops.segment_sum(yb.astype(f32) * slot_w[:, None], slot_tok, num_segments=T + 1)[:T]
    return y.astype(h.dtype)


def setup_inputs(seed: int = 0) -> dict:
    key = jax.random.key(seed)
    keys = jax.random.split(key, 26)
    D = D_MODEL

    def nrm(i, shape, scale):
        return jax.random.normal(keys[i], shape, jnp.float32) * scale

    sb_w = SB_HEADS * SB_HEAD_DIM
    gla_dqk = GLA_HEADS * GLA_DK
    gla_dv = GLA_HEADS * GLA_DV
    dil_w = DIL_HEADS * DIL_HEAD_DIM
    return {
        "x": nrm(0, (BATCH, SEQ, D), 1.0),
        "c": nrm(1, (BATCH, D), 1.0),
        "ada_w": nrm(2, (DEPTH, D, N_MOD * D), 0.5 * D ** -0.5),
        "ada_b": nrm(3, (DEPTH, N_MOD * D), 0.01),
        "norm_g": 1.0 + nrm(4, (DEPTH, 2, D), 0.02),
        "final_g": 1.0 + nrm(5, (D,), 0.02),
        "sb_w_in": nrm(6, (N_SB, D, 3 * sb_w), D ** -0.5),
        "sb_w_out": nrm(7, (N_SB, sb_w, D), sb_w ** -0.5),
        "gla_w_in": nrm(8, (N_GLA, D, GLA_IN), D ** -0.5),
        "gla_w_gate_up": nrm(9, (N_GLA, GLA_GATE_RANK, gla_dqk), GLA_GATE_RANK ** -0.5),
        "gla_b_gate": nrm(10, (N_GLA, gla_dqk), 0.01),
        "gla_norm_g": 1.0 + nrm(11, (N_GLA, GLA_DV), 0.02),
        "gla_w_out": nrm(12, (N_GLA, gla_dv, D), gla_dv ** -0.5),
        "conv_w_in": nrm(13, (N_CONV, D, 3 * D), D ** -0.5),
        "conv_w": nrm(14, (N_CONV, CONV_WIDTH, D), CONV_WIDTH ** -0.5),
        "conv_b": nrm(15, (N_CONV, D), 0.01),
        "conv_w_out": nrm(16, (N_CONV, D, D), D ** -0.5),
        "dil_w_in": nrm(17, (N_DIL, D, DIL_GROUPS * 3 * dil_w), D ** -0.5),
        "dil_w_out": nrm(18, (N_DIL, dil_w, D), dil_w ** -0.5),
        "moe_w_grp": nrm(19, (DEPTH, D, MOE_GROUPS), D ** -0.5),
        "moe_b_grp": nrm(20, (DEPTH, MOE_GROUPS), 0.01),
        "moe_w_exp": nrm(21, (DEPTH, D, MOE_EXPERTS), D ** -0.5),
        "moe_b_exp": nrm(22, (DEPTH, MOE_EXPERTS), 0.01),
        "moe_w_gate": nrm(23, (DEPTH, MOE_EXPERTS, D, MOE_D_FF), D ** -0.5),
        "moe_w_up": nrm(24, (DEPTH, MOE_EXPERTS, D, MOE_D_FF), D ** -0.5),
        "moe_w_down": nrm(25, (DEPTH, MOE_EXPERTS, MOE_D_FF, D), MOE_D_FF ** -0.5),
    }


def reference(x, c, ada_w, ada_b, norm_g, final_g, sb_w_in, sb_w_out, gla_w_in, gla_w_gate_up,
              gla_b_gate, gla_norm_g, gla_w_out, conv_w_in, conv_w, conv_b, conv_w_out,
              dil_w_in, dil_w_out, moe_w_grp, moe_b_grp, moe_w_exp, moe_b_exp, moe_w_gate,
              moe_w_up, moe_w_down):
    B, S, D = x.shape
    cond = jax.nn.silu(c)
    for i in range(DEPTH):
        mod = cond @ ada_w[i] + ada_b[i]
        sh1, sc1, g1, sh2, sc2, g2 = jnp.split(mod[:, None, :], N_MOD, axis=-1)

        h = rms_norm(x, norm_g[i, 0]) * (1.0 + sc1) + sh1
        kind, j = i % N_MIXERS, i // N_MIXERS
        if kind == 0:
            y = sb_mixer(h, sb_w_in[j], sb_w_out[j])
        elif kind == 1:
            y = gla_mixer(h, gla_w_in[j], gla_w_gate_up[j], gla_b_gate[j], gla_norm_g[j], gla_w_out[j])
        elif kind == 2:
            y = conv_mixer(h, conv_w_in[j], conv_w[j], conv_b[j], conv_w_out[j])
        else:
            y = dil_mixer(h, dil_w_in[j], dil_w_out[j])
        x = (x + g1 * y).astype(x.dtype)

        h = rms_norm(x, norm_g[i, 1]) * (1.0 + sc2) + sh2
        y = hier_moe(h.reshape(B * S, D), moe_w_grp[i], moe_b_grp[i], moe_w_exp[i], moe_b_exp[i],
                     moe_w_gate[i], moe_w_up[i], moe_w_down[i]).reshape(B, S, D)
        x = (x + g2 * y).astype(x.dtype)
    return rms_norm(x, final_g)
```

```cpp
#include <hip/hip_runtime.h>
#include <cstdio>
#include <cstdint>
#ifndef MK_N_LAUNCHES
#define MK_N_LAUNCHES 1
#endif
#define LAS __attribute__((address_space(3)))
#define GAS __attribute__((address_space(1)))
typedef unsigned short bf16;
typedef short bf16x8 __attribute__((ext_vector_type(8)));
typedef short s16x4 __attribute__((ext_vector_type(4)));
typedef float f32x2 __attribute__((ext_vector_type(2)));
typedef float f32x4 __attribute__((ext_vector_type(4)));
typedef float f32x16 __attribute__((ext_vector_type(16)));
typedef unsigned u32x2 __attribute__((ext_vector_type(2)));
typedef unsigned u32x4 __attribute__((ext_vector_type(4)));
#define DI __device__ __forceinline__

constexpr int NB = 8, SEQ = 8192, D = 1024, T = NB * SEQ, DEPTH = 4;
constexpr float RMS_EPS = 1e-6f;
constexpr float LOG2E = 1.4426950408889634f;
constexpr int NWAVES = 8, NTHR = 512;
constexpr int MOE_E = 32, MOE_FF = 512;
constexpr int PMAX = 2 * T + MOE_E * 256;
constexpr int KSPLIT = 8;

constexpr size_t MiB = 1u << 20;
constexpr size_t WS_CTL = 0, CTL_ZERO_BYTES = 1 * MiB;
constexpr size_t WS_MODP = 2 * MiB;
constexpr size_t WS_MODF = 9 * MiB;
constexpr size_t WS_TOKE = 10 * MiB;
constexpr size_t WS_TOKW = WS_TOKE + 512 * 1024;
constexpr size_t WS_TOKS = WS_TOKW + 512 * 1024;
constexpr size_t WS_SLOTTOK = WS_TOKS + 512 * 1024;
constexpr size_t WS_HIST = 13 * MiB;
constexpr size_t WS_TILEE = WS_HIST + 64 * 1024;
constexpr size_t WS_GDOWN = 14 * MiB;
constexpr size_t WS_DECAY = 18 * MiB;
constexpr size_t WS_LSE = 20 * MiB;
constexpr size_t WS_WMIX = 26 * MiB;
constexpr size_t W_SBIN = WS_WMIX, W_SBOUT = W_SBIN + 6 * MiB, W_GLAIN = W_SBOUT + 2 * MiB, W_GLAOUT = W_GLAIN + 6 * MiB, W_CONVIN = W_GLAOUT + 2 * MiB,
                 W_CONVOUT = W_CONVIN + 6 * MiB, W_DILIN = W_CONVOUT + 2 * MiB, W_DILOUT = W_DILIN + 9 * MiB;
constexpr size_t WS_W1T = 62 * MiB;
constexpr size_t WS_W2T = 126 * MiB;
constexpr size_t WS_HO = 158 * MiB;
constexpr size_t WS_BIG = 286 * MiB;
constexpr size_t WS_KST = WS_BIG + 384 * MiB;
constexpr size_t WS_VT = WS_KST + 64 * MiB;
constexpr size_t WS_SC = WS_VT + 128 * MiB;
constexpr size_t WS_ACT = WS_BIG;
constexpr size_t WS_YB = WS_BIG + 140 * MiB;
constexpr size_t WS_END = WS_SC + 32 * MiB;
constexpr int CW_BAR = 4096;

constexpr int LDS_BYTES = 160 * 1024 - 512;
constexpr int MISC_OFF = LDS_BYTES - 512;

DI unsigned f2bf(float f) { unsigned u = __builtin_bit_cast(unsigned, f); return (u + 0x7fffu + ((u >> 16) & 1u)) >> 16; }
typedef __bf16 bf16n2 __attribute__((ext_vector_type(2)));
DI unsigned pk2(float lo, float hi) { const f32x2 v = {lo, hi}; return __builtin_bit_cast(unsigned, __builtin_convertvector(v, bf16n2)); }
DI float bf2f(unsigned short b) { return __builtin_bit_cast(float, (unsigned)b << 16); }
DI float bflo(unsigned w) { return __builtin_bit_cast(float, w << 16); }
DI float bfhi(unsigned w) { return __builtin_bit_cast(float, w & 0xffff0000u); }
DI float wave_sum(float v) {
#pragma unroll
    for (int o = 1; o < 64; o <<= 1) v += __shfl_xor(v, o);
    return v;
}
DI float fexp2(float x) { return __builtin_amdgcn_exp2f(x); }
DI float flog2(float x) { return __builtin_amdgcn_logf(x); }
#define LDS_WAIT() asm volatile("s_waitcnt lgkmcnt(0)" ::: "memory")
#define VM_WAIT() asm volatile("s_waitcnt vmcnt(0)" ::: "memory")

#define XB_TMO      128
#define XB_XCNT(j)  (256  + 64 * (j))
#define XB_XSUB(j)  (1280 + 64 * (j))
#define XB_XGEN(j)  (2304 + 64 * (j))
#define XB_TOP      3328
#define XB_TOPGEN   3392
#define XCD_BAR_WORDS 3456
#define XB_SPIN_CAP (1u << 20)
DI unsigned xb_ld(unsigned* p)              { return __hip_atomic_load(p, __ATOMIC_RELAXED, __HIP_MEMORY_SCOPE_AGENT); }
DI unsigned xb_add(unsigned* p, unsigned v) { return __hip_atomic_fetch_add(p, v, __ATOMIC_RELAXED, __HIP_MEMORY_SCOPE_AGENT); }
DI unsigned xb_xcc_id() { return (unsigned)__builtin_amdgcn_s_getreg((3 << 11) | 20) & 0xFu; }
#define XB_SPIN(cond, bar) do { unsigned _sp = 0; while (cond) { __builtin_amdgcn_s_sleep(1); \
    if ((++_sp & 255u) == 0u) { if (xb_ld(&(bar)[XB_TMO])) break; if (_sp > XB_SPIN_CAP) { atomicAdd(&(bar)[XB_TMO], 1u); break; } } } } while (0)
struct XcdBarrier { unsigned* bar; unsigned x; volatile LAS unsigned* st; };
DI XcdBarrier xcd_barrier_post(unsigned* bar, volatile LAS unsigned* st) {
    XcdBarrier b; b.bar = bar; b.x = xb_xcc_id(); b.st = st;
    if (threadIdx.x == 0) (void)xb_add(&bar[XB_XCNT(b.x)], 1u);
    return b;
}
DI void xcd_barrier_complete(unsigned* bar, unsigned x, unsigned& nloc, unsigned& nx) {
    const unsigned G = gridDim.x * gridDim.y * gridDim.z;
    unsigned sum, cnt, mine, sp = 0u;
    for (;;) {
        sum = 0u; cnt = 0u; mine = 0u;
#pragma unroll
        for (unsigned j = 0; j < 16; ++j) { const unsigned c = xb_ld(&bar[XB_XCNT(j)]); sum += c; cnt += (c > 0u) ? 1u : 0u; mine = (j == x) ? c : mine; }
        if (sum == G) break;
        __builtin_amdgcn_s_sleep(1);
        if ((++sp & 255u) == 0u) { if (xb_ld(&bar[XB_TMO])) break; if (sp > XB_SPIN_CAP) { atomicAdd(&bar[XB_TMO], 1u); break; } }
    }
    nloc = mine > 0u ? mine : 1u; nx = cnt > 0u ? cnt : 1u;
}
DI void xcd_barrier(const XcdBarrier& b) {
    asm volatile("s_waitcnt vmcnt(0)" ::: "memory");
    __syncthreads();
    if (threadIdx.x == 0) {
        unsigned* bar = b.bar;
        __builtin_amdgcn_s_waitcnt(0);
        unsigned nloc = b.st[0], nx = b.st[1];
        if (nloc == 0u) { xcd_barrier_complete(bar, b.x, nloc, nx); b.st[0] = nloc; b.st[1] = nx; }
        const unsigned old = xb_add(&bar[XB_XSUB(b.x)], 1u);
        const unsigned gen = old / nloc;
        if (old + 1u == (gen + 1u) * nloc) {
            __builtin_amdgcn_fence(__ATOMIC_RELEASE, "agent");
            asm volatile("s_waitcnt vmcnt(0)" ::: "memory");
            const unsigned og = xb_add(&bar[XB_TOP], 1u);
            const unsigned tg = og / nx;
            if (og + 1u == (tg + 1u) * nx) xb_add(&bar[XB_TOPGEN], 1u);
            else XB_SPIN(xb_ld(&bar[XB_TOPGEN]) == tg, bar);
            __builtin_amdgcn_fence(__ATOMIC_ACQUIRE, "agent");
            xb_add(&bar[XB_XGEN(b.x)], 1u);
            asm volatile("s_waitcnt vmcnt(0)" ::: "memory");
        } else {
            XB_SPIN(xb_ld(&bar[XB_XGEN(b.x)]) == gen, bar);
            __builtin_amdgcn_fence(__ATOMIC_ACQUIRE, "agent");
            asm volatile("s_waitcnt vmcnt(0)" ::: "memory");
        }
    }
    __syncthreads();
}

namespace pg8 {
constexpr int BM = 256, BK = 64, HALF = 128, HTB = HALF * BK * 2, STAGE_BYTES = 8 * HTB, NXCD = 8, WGM = 8;
DI int lds_byte(int r, int c) { const int st = (r >> 4) * 2 + (c >> 5), rr = r & 15, cc = c & 31, ob = rr * 64 + cc * 2; return st * 1024 + (ob ^ (((ob >> 9) & 1) << 5)); }
DI void stage_rc(int b, int& R, int& C) { const int st = b / 1024, sb = b % 1024, swz = sb ^ (((sb >> 9) & 1) << 5); R = (st >> 1) * 16 + swz / 64; C = (st & 1) * 32 + (swz % 64) / 2; }
DI int perm32(int rho) { const int n = rho >> 4, i = rho & 15; return 8 * (i >> 2) + 4 * n + (i & 3); }
struct Unit { int pm, pn, eb; };

struct DenseSched {
    int nM, nN, nwg, G, c; const char* Bt; int K;
    DI void init(int M, int N, int K_, const void* Bt_, int G_, int c_) { nM = M / BM; nN = N / BM; nwg = nM * nN; G = G_; c = c_; Bt = (const char*)Bt_; K = K_; }
    DI bool next(int i, Unit& u) const {
        const long L = (long)i * G + c; if (L >= nwg) return false;
        int wgid = (int)L; { const int q = nwg / NXCD, r = nwg % NXCD, xcd = wgid % NXCD, off = wgid / NXCD; wgid = (xcd < r ? xcd * (q + 1) : r * (q + 1) + (xcd - r) * q) + off; }
        const int nig = WGM * nN, gid = wgid / nig, fm = gid * WGM, gsz = (nM - fm) < WGM ? (nM - fm) : WGM;
        u.pm = fm + ((wgid % nig) % gsz); u.pn = (wgid % nig) / gsz; u.eb = 0; return true;
    }
    DI unsigned a_row(const Unit& u, int r) const { return (unsigned)(u.pm * BM + r); }
    DI const char* b_base(const Unit& u) const { return Bt + (size_t)u.pn * BM * K * 2; }
};
template <bool GATHER> struct MoeSched {
    int G, c, K; const char* Bt; size_t estride; const int* tile_e; const int* slot_tok; int nunits;
    DI bool next(int i, Unit& u) const {
        const int L = i * G + c; if (L >= nunits) return false;
        u.pm = L >> 2; u.pn = L & 3; u.eb = __builtin_amdgcn_readfirstlane(__hip_atomic_load(tile_e + u.pm, __ATOMIC_RELAXED, __HIP_MEMORY_SCOPE_AGENT)); return true;
    }
    DI unsigned a_row(const Unit& u, int r) const { if (GATHER) return (unsigned)__hip_atomic_load(slot_tok + u.pm * BM + r, __ATOMIC_RELAXED, __HIP_MEMORY_SCOPE_AGENT); return (unsigned)(u.pm * BM + r); }
    DI const char* b_base(const Unit& u) const { return Bt + (size_t)u.eb * estride + (size_t)u.pn * BM * K * 2; }
};

struct EpiProj {
    static constexpr bool PERM = true;
    bf16* O; int ldc; int period, qcols; float qscale;
    DI void operator()(const f32x4 (&acc)[2][2][4][2], const Unit& u, int wr, int wc, int fr, int fq) const {
        const int row0 = u.pm * BM + wr * 64 + fr, colt = u.pn * BM;
        const float sc = ((colt % period) < qcols) ? qscale : 1.f;
        const int col0 = colt + wc * 32 + 8 * fq;
#pragma unroll
        for (int ai = 0; ai < 2; ++ai)
#pragma unroll
            for (int m = 0; m < 4; ++m) { bf16* rowp = O + (size_t)(row0 + ai * HALF + m * 16) * ldc + col0;
#pragma unroll
                for (int bj = 0; bj < 2; ++bj) { const f32x4 v0 = acc[ai][bj][m][0] * sc, v1 = acc[ai][bj][m][1] * sc;
                    u32x4 w; w.x = pk2(v0[0], v0[1]); w.y = pk2(v0[2], v0[3]); w.z = pk2(v1[0], v1[1]); w.w = pk2(v1[2], v1[3]);
                    *(u32x4*)(rowp + bj * HALF) = w; } }
    }
};
struct EpiMoe1 {
    static constexpr bool PERM = true;
    bf16* O;
    DI void operator()(const f32x4 (&acc)[2][2][4][2], const Unit& u, int wr, int wc, int fr, int fq) const {
        const int row0 = u.pm * BM + wr * 64 + fr, col0 = u.pn * 128 + wc * 32 + 8 * fq;
#pragma unroll
        for (int ai = 0; ai < 2; ++ai)
#pragma unroll
            for (int m = 0; m < 4; ++m) { bf16* rowp = O + (size_t)(row0 + ai * HALF + m * 16) * MOE_FF + col0;
                float r[8];
#pragma unroll
                for (int n = 0; n < 2; ++n)
#pragma unroll
                    for (int e = 0; e < 4; ++e) { const float g = acc[ai][0][m][n][e], up = acc[ai][1][m][n][e];
                        r[n * 4 + e] = g * __builtin_amdgcn_rcpf(1.f + fexp2(-g * LOG2E)) * up; }
                u32x4 w; w.x = pk2(r[0], r[1]); w.y = pk2(r[2], r[3]); w.z = pk2(r[4], r[5]); w.w = pk2(r[6], r[7]);
                *(u32x4*)rowp = w; }
    }
};
struct EpiResid {
    static constexpr bool PERM = false;
    const float* resid; float* out; const float* gate;
    DI void operator()(const f32x4 (&acc)[2][2][4][2], const Unit& u, int wr, int wc, int fr, int fq) const {
        const int row0 = u.pm * BM + wr * 64 + fr, col0 = u.pn * BM + wc * 32 + 4 * fq;
        const float* gv = gate + (size_t)((u.pm * BM) / SEQ) * 6144 + col0;
        f32x4 g[2][2];
#pragma unroll
        for (int bj = 0; bj < 2; ++bj)
#pragma unroll
            for (int n = 0; n < 2; ++n) g[bj][n] = *(const f32x4*)(gv + bj * HALF + n * 16);
#pragma unroll
        for (int ai = 0; ai < 2; ++ai)
#pragma unroll
            for (int m = 0; m < 4; ++m) { const size_t off = (size_t)(row0 + ai * HALF + m * 16) * D + col0;
#pragma unroll
                for (int bj = 0; bj < 2; ++bj)
#pragma unroll
                    for (int n = 0; n < 2; ++n) { const f32x4 bs = *(const f32x4*)(resid + off + bj * HALF + n * 16);
                        *(f32x4*)(out + off + bj * HALF + n * 16) = bs + g[bj][n] * acc[ai][bj][m][n]; }
                if (m & 1) asm volatile("" ::: "memory"); }
    }
};

template <class Epi, class Sched, bool ALIGN_EPI>
DI void gemm_phase(const int tid, LAS unsigned char* lds, const char* gA, const int lda  , const int K, const Sched& S, const Epi& E) {
    const int wid = __builtin_amdgcn_readfirstlane(tid >> 6), lane = tid & 63, wr = wid >> 2, wc = wid & 3, fr = lane & 15, fq = lane >> 4;
    const int nt = K / BK;
    int Rr[2], Cc[2]; unsigned voffB[2];
#pragma unroll
    for (int i = 0; i < 2; ++i) { stage_rc(tid * 16 + i * 8192, Rr[i], Cc[i]); const int Rb = Epi::PERM ? ((Rr[i] & ~31) + perm32(Rr[i] & 31)) : Rr[i];
        voffB[i] = (unsigned)(Rb * K + Cc[i]) * 2u; }
    const size_t kstep = (size_t)(BK * 2);
    const size_t hstepB = (size_t)HALF * K * 2;
    const unsigned ldsw = (unsigned)wid * 1024u;
    const int aoff = lds_byte(wr * 64 + fr, fq * 8), boff = lds_byte(wc * 32 + fr, fq * 8);
#define PG8_SA(b, h) (((b) * 2 + (h)) * HTB)
#define PG8_SB(b, h) ((4 + (b) * 2 + (h)) * HTB)
#define PG8_STAGEB(bufoff, gbase) do { _Pragma("unroll") for (int _i = 0; _i < 2; ++_i) \
        __builtin_amdgcn_global_load_lds((const unsigned*)((const char*)(gbase) + voffB[_i]), (LAS unsigned*)(lds + (bufoff) + ldsw + _i * 8192), 16, 0, 0); } while (0)
#define PG8_STAGEA(bufoff, gbase, o0, o1) do { \
        __builtin_amdgcn_global_load_lds((const unsigned*)((const char*)(gbase) + (o0)), (LAS unsigned*)(lds + (bufoff) + ldsw), 16, 0, 0); \
        __builtin_amdgcn_global_load_lds((const unsigned*)((const char*)(gbase) + (o1)), (LAS unsigned*)(lds + (bufoff) + ldsw + 8192), 16, 0, 0); } while (0)
#define PG8_LDA(dst, b, h) do { _Pragma("unroll") for (int m = 0; m < 4; ++m) _Pragma("unroll") for (int k = 0; k < 2; ++k) dst[m][k] = *(const LAS bf16x8*)(lds + PG8_SA(b, h) + aoff + m * 2048 + k * 1024); } while (0)
#define PG8_LDB(dst, b, h) do { _Pragma("unroll") for (int n = 0; n < 2; ++n) _Pragma("unroll") for (int k = 0; k < 2; ++k) dst[n][k] = *(const LAS bf16x8*)(lds + PG8_SB(b, h) + boff + n * 2048 + k * 1024); } while (0)
#define PG8_MMA(ai, bj, At, Bt) do { __builtin_amdgcn_s_setprio(1); _Pragma("unroll") for (int m = 0; m < 4; ++m) _Pragma("unroll") for (int n = 0; n < 2; ++n) _Pragma("unroll") for (int k = 0; k < 2; ++k) \
        acc[ai][bj][m][n] = __builtin_amdgcn_mfma_f32_16x16x32_bf16(Bt[n][k], At[m][k], acc[ai][bj][m][n], 0, 0, 0); __builtin_amdgcn_s_setprio(0); } while (0)
#define PG8_WAIT_V(n) asm volatile("s_waitcnt vmcnt(" #n ")" ::: "memory")
#define PG8_WAIT_L(n) asm volatile("s_waitcnt lgkmcnt(" #n ")" ::: "memory")
#define PG8_BAR __builtin_amdgcn_s_barrier()
#define PG8_SCHED __builtin_amdgcn_sched_barrier(0)
    Unit cur, nxt; int ui = 0;
    if (!S.next(0, cur)) return;
    f32x4 acc[2][2][4][2];
#pragma unroll
    for (int a = 0; a < 2; ++a)
#pragma unroll
        for (int b = 0; b < 2; ++b)
#pragma unroll
            for (int m = 0; m < 4; ++m)
#pragma unroll
                for (int n = 0; n < 2; ++n) acc[a][b][m][n] = (f32x4){0.f, 0.f, 0.f, 0.f};
    bf16x8 At[4][2], B0[2][2], B1[2][2];
    unsigned vA[2][2], vN[2][2];
#pragma unroll
    for (int h = 0; h < 2; ++h)
#pragma unroll
        for (int i = 0; i < 2; ++i) vA[h][i] = (S.a_row(cur, h * HALF + Rr[i]) * (unsigned)lda + (unsigned)Cc[i]) * 2u;
    const char* cB = S.b_base(cur);
    PG8_STAGEB(PG8_SB(0, 0), cB); PG8_STAGEB(PG8_SB(0, 1), cB + hstepB); PG8_STAGEA(PG8_SA(0, 0), gA, vA[0][0], vA[0][1]); PG8_STAGEA(PG8_SA(0, 1), gA, vA[1][0], vA[1][1]);
    if (wr == 1) PG8_BAR;
    PG8_WAIT_V(2); PG8_BAR;
    PG8_STAGEB(PG8_SB(1, 0), cB + kstep); PG8_STAGEA(PG8_SA(1, 0), gA + kstep, vA[0][0], vA[0][1]); PG8_STAGEB(PG8_SB(1, 1), cB + hstepB + kstep);
    PG8_WAIT_V(6); PG8_BAR;
    for (;;) {
        const bool has_next = S.next(ui + 1, nxt);
        const char* nB = has_next ? S.b_base(nxt) : cB;
#pragma unroll
        for (int h = 0; h < 2; ++h)
#pragma unroll
            for (int i = 0; i < 2; ++i) vN[h][i] = has_next ? (S.a_row(nxt, h * HALF + Rr[i]) * (unsigned)lda + (unsigned)Cc[i]) * 2u : vA[h][i];
        for (int t = 0; t < nt; t += 2) {
            const bool last = (t == nt - 2);
            const char* a1 = gA + (size_t)(t + 1) * kstep;
            const char* a2 = gA + (last ? (size_t)0 : (size_t)(t + 2) * kstep); const char* b2 = last ? nB : cB + (size_t)(t + 2) * kstep;
            const char* a3 = a2 + kstep; const char* b3 = b2 + kstep;
            const unsigned o00 = last ? vN[0][0] : vA[0][0], o01 = last ? vN[0][1] : vA[0][1], o10 = last ? vN[1][0] : vA[1][0], o11 = last ? vN[1][1] : vA[1][1];
            PG8_LDB(B0, 0, 0); PG8_LDB(B1, 0, 1); PG8_SCHED; PG8_LDA(At, 0, 0); PG8_STAGEA(PG8_SA(1, 1), a1, vA[1][0], vA[1][1]);
            PG8_WAIT_V(8); PG8_WAIT_L(0); PG8_BAR; PG8_MMA(0, 0, At, B0); PG8_MMA(0, 1, At, B1); PG8_BAR; PG8_SCHED;
            PG8_LDA(At, 0, 1); PG8_STAGEB(PG8_SB(0, 0), b2); PG8_STAGEB(PG8_SB(0, 1), b2 + hstepB); PG8_STAGEA(PG8_SA(0, 0), a2, o00, o01);
            PG8_WAIT_V(8); PG8_WAIT_L(0); PG8_BAR; PG8_MMA(1, 0, At, B0); PG8_MMA(1, 1, At, B1); PG8_BAR; PG8_SCHED;
            PG8_LDB(B0, 1, 0); PG8_LDB(B1, 1, 1); PG8_SCHED; PG8_LDA(At, 1, 0); PG8_STAGEA(PG8_SA(0, 1), a2, o10, o11);
            PG8_WAIT_V(8); PG8_WAIT_L(0); PG8_BAR; PG8_MMA(0, 0, At, B0); PG8_MMA(0, 1, At, B1); PG8_BAR; PG8_SCHED;
            PG8_LDA(At, 1, 1); PG8_STAGEB(PG8_SB(1, 0), b3); PG8_STAGEB(PG8_SB(1, 1), b3 + hstepB); PG8_STAGEA(PG8_SA(1, 0), a3, o00, o01);
            PG8_WAIT_V(8); PG8_WAIT_L(0); PG8_BAR; PG8_MMA(1, 0, At, B0); PG8_MMA(1, 1, At, B1); PG8_BAR; PG8_SCHED;
        }
        if constexpr (ALIGN_EPI) { if (wr == 0) PG8_BAR; }
        E(acc, cur, wr, wc, fr, fq);
        if (!has_next) break;
#pragma unroll
        for (int a = 0; a < 2; ++a)
#pragma unroll
            for (int b = 0; b < 2; ++b)
#pragma unroll
                for (int m = 0; m < 4; ++m)
#pragma unroll
                    for (int n = 0; n < 2; ++n) acc[a][b][m][n] = (f32x4){0.f, 0.f, 0.f, 0.f};
        cur = nxt; cB = nB; ++ui;
#pragma unroll
        for (int h = 0; h < 2; ++h)
#pragma unroll
            for (int i = 0; i < 2; ++i) vA[h][i] = vN[h][i];
        if constexpr (ALIGN_EPI) { if (wr == 1) PG8_BAR; }
    }
    PG8_WAIT_V(0);
    if constexpr (!ALIGN_EPI) { if (wr == 0) PG8_BAR; }
    PG8_BAR;
#undef PG8_SA
#undef PG8_SB
#undef PG8_STAGEA
#undef PG8_STAGEB
#undef PG8_LDA
#undef PG8_LDB
#undef PG8_MMA
#undef PG8_WAIT_V
#undef PG8_WAIT_L
#undef PG8_BAR
#undef PG8_SCHED
}
}

struct Params {
    const float* in[26];
    float* out; unsigned char* ws;
    int ph_lo, ph_hi;
};
enum { I_X = 0, I_C, I_ADAW, I_ADAB, I_NORMG, I_FINALG, I_SBWIN, I_SBWOUT, I_GLAWIN, I_GLAGU, I_GLABG, I_GLANG, I_GLAWOUT, I_CONVWIN, I_CONVW, I_CONVB, I_CONVWOUT,
       I_DILWIN, I_DILWOUT, I_MGRPW, I_MGRPB, I_MEXPW, I_MEXPB, I_MWG, I_MWU, I_MWD };
struct Ctx {
    LAS unsigned char* lds; volatile LAS unsigned* MISC;
    int tid, lane, wave, G, bid;
    const Params* p; unsigned char* ws;
};

DI void transpose_item(const float* W, int ldw  , int k0, int n0, bf16* WT, size_t drow0, int ldk  , LAS float* scr, int lane) {
#pragma unroll 8
    for (int i = 0; i < 32; ++i) { const int kk = 2 * i + (lane >> 5); scr[kk * 33 + (lane & 31)] = W[(size_t)(k0 + kk) * ldw + n0 + (lane & 31)]; }
    LDS_WAIT();
    const int c = lane & 7;
#pragma unroll
    for (int j = 0; j < 4; ++j) { const int n = (lane >> 3) + 8 * j; const LAS float* s = scr + (8 * c) * 33 + n;
        u32x4 o; o.x = pk2(s[0 * 33], s[1 * 33]); o.y = pk2(s[2 * 33], s[3 * 33]); o.z = pk2(s[4 * 33], s[5 * 33]); o.w = pk2(s[6 * 33], s[7 * 33]);
        *(u32x4*)(WT + (drow0 + n) * (size_t)ldk + k0 + 8 * c) = o; }
    LDS_WAIT();
}
DI void transpose_matrix(Ctx& F, const float* W, int K, int N, int ldw, int ncol0, bf16* WT, int gw, int NGW) {
    LAS float* scr = (LAS float*)(F.lds + F.wave * 16384);
    const int nblk = N / 32, nitems = (K / 64) * nblk;
    for (int it = gw; it < nitems; it += NGW) { const int kb = it / nblk, nb = it % nblk;
        transpose_item(W, ldw, 64 * kb, ncol0 + 32 * nb, WT, (size_t)(32 * nb), K, scr, F.lane); }
}

DI void ph_prologue(Ctx& F) {
    const Params& P = *F.p; unsigned char* ws = F.ws;
    const int gw = F.bid * NWAVES + F.wave, NGW = F.G * NWAVES;
    transpose_matrix(F, P.in[I_SBWIN], D, 3072, 3072, 0, (bf16*)(ws + W_SBIN), gw, NGW);
    transpose_matrix(F, P.in[I_SBWOUT], D, D, D, 0, (bf16*)(ws + W_SBOUT), gw, NGW);
    transpose_matrix(F, P.in[I_GLAWIN], D, 3072, 3088, 0, (bf16*)(ws + W_GLAIN), gw, NGW);
    transpose_matrix(F, P.in[I_GLAWOUT], D, D, D, 0, (bf16*)(ws + W_GLAOUT), gw, NGW);
    transpose_matrix(F, P.in[I_CONVWIN], D, 3072, 3072, 0, (bf16*)(ws + W_CONVIN), gw, NGW);
    transpose_matrix(F, P.in[I_CONVWOUT], D, D, D, 0, (bf16*)(ws + W_CONVOUT), gw, NGW);
    transpose_matrix(F, P.in[I_DILWIN], D, 4608, 4608, 0, (bf16*)(ws + W_DILIN), gw, NGW);
    transpose_matrix(F, P.in[I_DILWOUT], 512, D, D, 0, (bf16*)(ws + W_DILOUT), gw, NGW);
    const float* c = P.in[I_C]; const float* aw = P.in[I_ADAW]; float* modp = (float*)(ws + WS_MODP);
    for (int it = gw; it < DEPTH * 96 * KSPLIT; it += NGW) {
        const int ks = it % KSPLIT, jb = (it / KSPLIT) % 96, l = it / (KSPLIT * 96);
        const int j = jb * 64 + F.lane; const int k0 = ks * (D / KSPLIT);
        float a[NB];
#pragma unroll
        for (int b = 0; b < NB; ++b) a[b] = 0.f;
        const float* wp = aw + ((size_t)l * D + k0) * 6144 + j;
#pragma unroll 4
        for (int k = 0; k < D / KSPLIT; ++k) { const float w = wp[(size_t)k * 6144];
#pragma unroll
            for (int b = 0; b < NB; ++b) { const float cv = c[b * D + k0 + k]; const float sl = cv / (1.f + __expf(-cv)); a[b] += sl * w; } }
#pragma unroll
        for (int b = 0; b < NB; ++b) modp[(((size_t)ks * DEPTH + l) * NB + b) * 6144 + j] = a[b];
    }
}
DI float mod_sum(const float* modp, const float* adab, int l, int b, int j) {
    float s = adab[l * 6144 + j];
#pragma unroll
    for (int ks = 0; ks < KSPLIT; ++ks) s += modp[(((size_t)ks * DEPTH + l) * NB + b) * 6144 + j];
    return s;
}

DI void mod_vec(const float* modp, const float* adab, int l, int b, int chunk, int lane, f32x4 (&out)[4]) {
#pragma unroll
    for (int j = 0; j < 4; ++j) out[j] = *(const f32x4*)(adab + l * 6144 + chunk * D + 4 * lane + 256 * j);
#pragma unroll 1
    for (int ks = 0; ks < KSPLIT; ++ks) { const float* p = modp + (((size_t)ks * DEPTH + l) * NB + b) * 6144 + chunk * D + 4 * lane;
#pragma unroll
        for (int j = 0; j < 4; ++j) out[j] = out[j] + *(const f32x4*)(p + 256 * j); }
}
DI void row_load(const float* row, int lane, f32x4 (&v)[4]) {
#pragma unroll
    for (int j = 0; j < 4; ++j) v[j] = *(const f32x4*)(row + 4 * lane + 256 * j);
}
DI void row_store_bf16(bf16* row, int lane, const f32x4 (&v)[4]) {
#pragma unroll
    for (int j = 0; j < 4; ++j) { u32x2 w; w.x = pk2(v[j][0], v[j][1]); w.y = pk2(v[j][2], v[j][3]); *(u32x2*)(row + 4 * lane + 256 * j) = w; }
}
DI float row_rstd(const f32x4 (&v)[4]) {
    float s = 0.f;
#pragma unroll
    for (int j = 0; j < 4; ++j) s += (v[j][0] * v[j][0] + v[j][1] * v[j][1]) + (v[j][2] * v[j][2] + v[j][3] * v[j][3]);
    return 1.f / sqrtf(wave_sum(s) * (1.f / D) + RMS_EPS);
}
DI void moe_combine_row(Ctx& F, int row, const f32x4 (&g2)[4], f32x4 (&v)[4]) {
    unsigned char* ws = F.ws;
    const int* ts = (const int*)(ws + WS_TOKS); const float* tw = (const float*)(ws + WS_TOKW); const bf16* yb = (const bf16*)(ws + WS_YB);
    const int s0 = __hip_atomic_load(ts + row * 2, __ATOMIC_RELAXED, __HIP_MEMORY_SCOPE_AGENT), s1 = __hip_atomic_load(ts + row * 2 + 1, __ATOMIC_RELAXED, __HIP_MEMORY_SCOPE_AGENT);
    const float w0 = __hip_atomic_load(tw + row * 2, __ATOMIC_RELAXED, __HIP_MEMORY_SCOPE_AGENT), w1 = __hip_atomic_load(tw + row * 2 + 1, __ATOMIC_RELAXED, __HIP_MEMORY_SCOPE_AGENT);
#pragma unroll
    for (int j = 0; j < 4; ++j) { const u32x2 a = *(const u32x2*)(yb + (size_t)s0 * D + 4 * F.lane + 256 * j), b = *(const u32x2*)(yb + (size_t)s1 * D + 4 * F.lane + 256 * j);
        f32x4 y; y[0] = w0 * bflo(a.x) + w1 * bflo(b.x); y[1] = w0 * bfhi(a.x) + w1 * bfhi(b.x); y[2] = w0 * bflo(a.y) + w1 * bflo(b.y); y[3] = w0 * bfhi(a.y) + w1 * bfhi(b.y);
        v[j] = v[j] + g2[j] * y; }
}
DI void moe_weight_convert(Ctx& F, int l, int gw, int NGW) {
    const Params& P = *F.p; unsigned char* ws = F.ws;
    LAS float* scr = (LAS float*)(F.lds + F.wave * 16384);
    bf16* W1T = (bf16*)(ws + WS_W1T); bf16* W2T = (bf16*)(ws + WS_W2T);
    const int per_e = 256, n1 = MOE_E * 2 * per_e;
    for (int it = gw; it < n1; it += NGW) { const int e = it / (2 * per_e), r = it % (2 * per_e), half = r / per_e, q = r % per_e, kb = q / 16, nb = q % 16;
        const float* W = (half ? P.in[I_MWU] : P.in[I_MWG]) + ((size_t)l * MOE_E + e) * D * MOE_FF;
        const int n0 = 32 * nb; const size_t drow0 = (size_t)e * 1024 + (size_t)(n0 / 128) * 256 + half * 128 + (n0 % 128);
        transpose_item(W, MOE_FF, 64 * kb, n0, W1T, drow0, D, scr, F.lane); }
    for (int it = gw; it < MOE_E * per_e; it += NGW) { const int e = it / per_e, q = it % per_e, kb = q / 32, nb = q % 32;
        const float* W = P.in[I_MWD] + ((size_t)l * MOE_E + e) * MOE_FF * D;
        transpose_item(W, D, 64 * kb, 32 * nb, W2T, (size_t)e * 1024 + 32 * nb, MOE_FF, scr, F.lane); }
}

DI void ph_norm1(Ctx& F, int l) {
    const Params& P = *F.p; unsigned char* ws = F.ws;
    const int gw = F.bid * NWAVES + F.wave, NGW = F.G * NWAVES;
    const float* modp = (const float*)(ws + WS_MODP); float* modf = (float*)(ws + WS_MODF);
    if (l == 0) {
        for (int i = F.bid * NTHR + F.tid; i < DEPTH * NB * 6144; i += F.G * NTHR) { const int j = i % 6144, b = (i / 6144) % NB, ll = i / (6144 * NB); modf[i] = mod_sum(modp, P.in[I_ADAB], ll, b, j); }
    }
    const bool gla = (l == 1);
    LAS float* wgd = (LAS float*)F.lds;
    if (gla) { const float* w = P.in[I_GLAWIN];
        for (int idx = F.tid; idx < 16 * D; idx += NTHR) { const int c = idx & (D - 1), o = idx >> 10; wgd[idx] = w[(size_t)c * 3088 + 3072 + o]; }
        __syncthreads(); }
    const float* xin = (l == 0) ? P.in[I_X] : P.out; float* X = P.out;
    bf16* HO = (bf16*)(ws + WS_HO); float* gdn = (float*)(ws + WS_GDOWN);
    const float* ng = P.in[I_NORMG] + (size_t)(l * 2 + 0) * D;
    for (int blk = gw; blk < T / 32; blk += NGW) {
        const int row0 = blk * 32, b = row0 / SEQ;
        f32x4 gm[4], sh[4], g2[4];
        mod_vec(modp, P.in[I_ADAB], l, b, 0, F.lane, sh); mod_vec(modp, P.in[I_ADAB], l, b, 1, F.lane, gm);
#pragma unroll
        for (int j = 0; j < 4; ++j) gm[j] = *(const f32x4*)(ng + 4 * F.lane + 256 * j) * (gm[j] + 1.f);
        if (l > 0) mod_vec(modp, P.in[I_ADAB], l - 1, b, 5, F.lane, g2);
        else {
#pragma unroll
            for (int j = 0; j < 4; ++j) g2[j] = (f32x4){0.f, 0.f, 0.f, 0.f}; }
        for (int r = 0; r < 32; ++r) { const int row = row0 + r;
            f32x4 v[4]; row_load(xin + (size_t)row * D, F.lane, v);
            if (l > 0) { moe_combine_row(F, row, g2, v);
#pragma unroll
                for (int j = 0; j < 4; ++j) *(f32x4*)(X + (size_t)row * D + 4 * F.lane + 256 * j) = v[j]; }
            const float rstd = row_rstd(v);
#pragma unroll
            for (int j = 0; j < 4; ++j) v[j] = v[j] * rstd * gm[j] + sh[j];
            row_store_bf16(HO + (size_t)row * D, F.lane, v);
            if (gla) {
                float mine = 0.f;
#pragma unroll 2
                for (int o = 0; o < 16; ++o) { float s = 0.f;
#pragma unroll
                    for (int j = 0; j < 4; ++j) { const f32x4 w = *(const LAS f32x4*)(wgd + o * D + 4 * F.lane + 256 * j); s += (v[j][0] * w[0] + v[j][1] * w[1]) + (v[j][2] * w[2] + v[j][3] * w[3]); }
                    s = wave_sum(s); if (F.lane == o) mine = s; }
                if (F.lane < 16) gdn[(size_t)row * 16 + F.lane] = mine;
            }
        }
    }
    __syncthreads();
    moe_weight_convert(F, l, gw, NGW);
}

#define MFMA32(a, b, c) __builtin_amdgcn_mfma_f32_32x32x16_bf16((a), (b), (c), 0, 0, 0)
DI bf16x8 ldg8(const bf16* p) { return *(const bf16x8*)p; }
DI bf16x8 pack8(float a0, float a1, float a2, float a3, float a4, float a5, float a6, float a7) {
    u32x4 p; p.x = pk2(a0, a1); p.y = pk2(a2, a3); p.z = pk2(a4, a5); p.w = pk2(a6, a7); return __builtin_bit_cast(bf16x8, p);
}
DI bf16x8 pack_step(const f32x16& x, int s) { return s == 0 ? pack8(x[0], x[1], x[2], x[3], x[4], x[5], x[6], x[7]) : pack8(x[8], x[9], x[10], x[11], x[12], x[13], x[14], x[15]); }
DI f32x16 zero16() { f32x16 z; for (int i = 0; i < 16; ++i) z[i] = 0.f; return z; }
DI bf16x8 tr_read2(unsigned a_lo, unsigned a_hi) {
    s16x4 lo, hi;
    asm volatile("ds_read_b64_tr_b16 %0, %2\n\tds_read_b64_tr_b16 %1, %3\n\ts_waitcnt lgkmcnt(0)" : "=&v"(lo), "=&v"(hi) : "v"(a_lo), "v"(a_hi) : "memory");
    return __builtin_shufflevector(lo, hi, 0, 1, 2, 3, 4, 5, 6, 7);
}
constexpr int VPITCH = 144;
DI bf16x8 vt_frag(unsigned vbase, int lane, int dblk, int s) {
    const int i16 = lane & 15, q = i16 >> 2, p = i16 & 3, blk = (lane >> 4) & 1, h2 = lane >> 5;
    const unsigned col = (unsigned)((32 * dblk + 16 * blk) * 2 + 8 * p);
    return tr_read2(vbase + (unsigned)((16 * s + 4 * h2 + q) * VPITCH) + col, vbase + (unsigned)((16 * s + 8 + 4 * h2 + q) * VPITCH) + col);
}

DI void ph_sb_attn(Ctx& F) {
    unsigned char* ws = F.ws; bf16* proj = (bf16*)(ws + WS_BIG);
    const int lane = F.lane, r = lane & 31, h2 = lane >> 5;
    LAS unsigned char* vl = F.lds + F.wave * (32 * VPITCH);
    const unsigned vbase = (unsigned)(size_t)vl;
    for (int it = F.bid; it < NB * 16 * 32; it += F.G) {
        const int b = it >> 9, hd = (it >> 5) & 15, qb = it & 31;
        const int q0 = qb * 256 + F.wave * 32; const size_t rowbase = (size_t)b * SEQ;
        const bf16* qp = proj + (rowbase + q0 + r) * 3072 + hd * 64;
        bf16x8 Qf[4];
#pragma unroll
        for (int kk = 0; kk < 4; ++kk) Qf[kk] = ldg8(qp + 16 * kk + 8 * h2);
        f32x16 o0 = zero16(), o1 = zero16(); float carry = 0.f;
        const int qpos = q0 + r;
        for (int kt = q0 >> 5; kt >= 0; --kt) {
            const bf16* kp = proj + (rowbase + kt * 32 + r) * 3072 + 1024 + hd * 64;
            bf16x8 Kf[4];
#pragma unroll
            for (int kk = 0; kk < 4; ++kk) Kf[kk] = ldg8(kp + 16 * kk + 8 * h2);
            const bf16* vp = proj + (rowbase + kt * 32 + (lane >> 1)) * 3072 + 2048 + hd * 64 + (lane & 1) * 32;
            u32x4 vv[4];
#pragma unroll
            for (int i = 0; i < 4; ++i) vv[i] = *(const u32x4*)(vp + 8 * i);
            f32x16 st = zero16();
#pragma unroll
            for (int kk = 0; kk < 4; ++kk) st = MFMA32(Kf[kk], Qf[kk], st);
#pragma unroll
            for (int i = 0; i < 4; ++i) *(LAS u32x4*)(vl + (lane >> 1) * VPITCH + (lane & 1) * 64 + 16 * i) = vv[i];
            float Lv[16]; float sg[4], pg[4];
            const int kbase = kt * 32 + 4 * h2;
#pragma unroll
            for (int i = 0; i < 16; ++i) { const int kpos = kbase + (i & 3) + 8 * (i >> 2); const float z = st[i];
                const float sp = fmaxf(z, 0.f) + flog2(1.f + fexp2(-fabsf(z)));
                Lv[i] = (kpos < qpos) ? -sp : 0.f; }
#pragma unroll
            for (int g = 0; g < 4; ++g) { sg[g] = (Lv[4 * g] + Lv[4 * g + 1]) + (Lv[4 * g + 2] + Lv[4 * g + 3]); pg[g] = __shfl_xor(sg[g], 32); }
            float after = carry; float a[16];
#pragma unroll
            for (int g = 3; g >= 0; --g) {
                float run = after + (h2 == 0 ? pg[g] : 0.f);
#pragma unroll
                for (int k = 3; k >= 0; --k) { const int i = 4 * g + k; run += Lv[i]; const int kpos = kbase + k + 8 * g;
                    a[i] = (kpos < qpos) ? fexp2(st[i] + run) : 0.f; }
                after += sg[g] + pg[g];
            }
            carry = after;
            const bf16x8 P0 = pack8(a[0], a[1], a[2], a[3], a[4], a[5], a[6], a[7]), P1 = pack8(a[8], a[9], a[10], a[11], a[12], a[13], a[14], a[15]);
            LDS_WAIT();
            const bf16x8 v00 = vt_frag(vbase, lane, 0, 0), v01 = vt_frag(vbase, lane, 0, 1), v10 = vt_frag(vbase, lane, 1, 0), v11 = vt_frag(vbase, lane, 1, 1);
            o0 = MFMA32(v00, P0, o0); o0 = MFMA32(v01, P1, o0); o1 = MFMA32(v10, P0, o1); o1 = MFMA32(v11, P1, o1);
            if (__all(carry < -126.f)) break;
        }
        bf16* op = proj + (rowbase + q0 + r) * 3072 + hd * 64 + 4 * h2;
#pragma unroll
        for (int g = 0; g < 4; ++g) { u32x2 w; w.x = pk2(o0[4 * g], o0[4 * g + 1]); w.y = pk2(o0[4 * g + 2], o0[4 * g + 3]); *(u32x2*)(op + 8 * g) = w;
            u32x2 w1; w1.x = pk2(o1[4 * g], o1[4 * g + 1]); w1.y = pk2(o1[4 * g + 2], o1[4 * g + 3]); *(u32x2*)(op + 32 + 8 * g) = w1; }
    }
}

DI void ph_dil_attn(Ctx& F) {
    unsigned char* ws = F.ws; bf16* proj = (bf16*)(ws + WS_BIG); float* lse = (float*)(ws + WS_LSE);
    const int lane = F.lane, r = lane & 31, h2 = lane >> 5;
    LAS unsigned char* vl = F.lds + F.wave * (32 * VPITCH);
    const unsigned vbase = (unsigned)(size_t)vl;
    const int gw = F.bid * NWAVES + F.wave, NGW = F.G * NWAVES;
    for (int it = gw; it < 3 * NB * 8 * 256; it += NGW) {
        const int mt_all = it & 255, hd = (it >> 8) & 7, b = (it >> 11) & 7, g = it >> 14;
        const int lr = 2 * g, rr = 1 << lr;
        const int tiles_per_class = 256 >> lr;
        const int rho = mt_all / tiles_per_class, mt = mt_all % tiles_per_class;
        const size_t rowbase = (size_t)b * SEQ + rho; const int cq = g * 1536 + hd * 64;
        const int m0 = mt * 32;
        const bf16* qp = proj + (rowbase + (size_t)(m0 + r) * rr) * 4608 + cq;
        bf16x8 Qf[4];
#pragma unroll
        for (int kk = 0; kk < 4; ++kk) Qf[kk] = ldg8(qp + 16 * kk + 8 * h2);
        f32x16 o0 = zero16(), o1 = zero16(); float mrun = -__builtin_inff(), lrun = 0.f;
        const int mq = m0 + r;
        for (int kt = (mt >= 4 ? mt - 4 : 0); kt <= mt; ++kt) {
            const bf16* kp = proj + (rowbase + (size_t)(kt * 32 + r) * rr) * 4608 + cq + 512;
            bf16x8 Kf[4];
#pragma unroll
            for (int kk = 0; kk < 4; ++kk) Kf[kk] = ldg8(kp + 16 * kk + 8 * h2);
            const bf16* vp = proj + (rowbase + (size_t)(kt * 32 + (lane >> 1)) * rr) * 4608 + cq + 1024 + (lane & 1) * 32;
            u32x4 vv[4];
#pragma unroll
            for (int i = 0; i < 4; ++i) vv[i] = *(const u32x4*)(vp + 8 * i);
            f32x16 st = zero16();
#pragma unroll
            for (int kk = 0; kk < 4; ++kk) st = MFMA32(Kf[kk], Qf[kk], st);
#pragma unroll
            for (int i = 0; i < 4; ++i) *(LAS u32x4*)(vl + (lane >> 1) * VPITCH + (lane & 1) * 64 + 16 * i) = vv[i];
            const int kbase = kt * 32 + 4 * h2;
            float mx = -__builtin_inff();
#pragma unroll
            for (int i = 0; i < 16; ++i) { const int mk = kbase + (i & 3) + 8 * (i >> 2); const bool valid = (mk <= mq) && (mq - mk <= 128);
                st[i] = valid ? st[i] : -__builtin_inff(); mx = fmaxf(mx, st[i]); }
            mx = fmaxf(mx, __shfl_xor(mx, 32));
            const float mnew = fmaxf(mrun, mx);
            const float alpha = fexp2(mrun - mnew);
            float a[16]; float ps = 0.f;
#pragma unroll
            for (int i = 0; i < 16; ++i) { a[i] = fexp2(st[i] - mnew); ps += a[i]; }
            ps += __shfl_xor(ps, 32);
            lrun = lrun * alpha + ps; mrun = mnew;
#pragma unroll
            for (int i = 0; i < 16; ++i) { o0[i] *= alpha; o1[i] *= alpha; }
            const bf16x8 P0 = pack8(a[0], a[1], a[2], a[3], a[4], a[5], a[6], a[7]), P1 = pack8(a[8], a[9], a[10], a[11], a[12], a[13], a[14], a[15]);
            LDS_WAIT();
            const bf16x8 v00 = vt_frag(vbase, lane, 0, 0), v01 = vt_frag(vbase, lane, 0, 1), v10 = vt_frag(vbase, lane, 1, 0), v11 = vt_frag(vbase, lane, 1, 1);
            o0 = MFMA32(v00, P0, o0); o0 = MFMA32(v01, P1, o0); o1 = MFMA32(v10, P0, o1); o1 = MFMA32(v11, P1, o1);
        }
        const float inv = 1.f / lrun;
        const size_t orow = rowbase + (size_t)(m0 + r) * rr;
        bf16* op = proj + orow * 4608 + cq + 4 * h2;
#pragma unroll
        for (int gq = 0; gq < 4; ++gq) { u32x2 w; w.x = pk2(o0[4 * gq] * inv, o0[4 * gq + 1] * inv); w.y = pk2(o0[4 * gq + 2] * inv, o0[4 * gq + 3] * inv); *(u32x2*)(op + 8 * gq) = w;
            u32x2 w1; w1.x = pk2(o1[4 * gq] * inv, o1[4 * gq + 1] * inv); w1.y = pk2(o1[4 * gq + 2] * inv, o1[4 * gq + 3] * inv); *(u32x2*)(op + 32 + 8 * gq) = w1; }
        if (h2 == 0) lse[((size_t)g * T + orow) * 8 + hd] = mrun + flog2(lrun);
    }
}
DI void ph_dil_combine(Ctx& F) {
    unsigned char* ws = F.ws; const bf16* proj = (const bf16*)(ws + WS_BIG); const float* lse = (const float*)(ws + WS_LSE); bf16* HO = (bf16*)(ws + WS_HO);
    const int gw = F.bid * NWAVES + F.wave, NGW = F.G * NWAVES; const int lane = F.lane, hd = lane >> 3;
    for (int row = gw; row < T; row += NGW) {
        const float l0 = lse[((size_t)0 * T + row) * 8 + hd], l1 = lse[((size_t)1 * T + row) * 8 + hd], l2 = lse[((size_t)2 * T + row) * 8 + hd];
        const float m = fmaxf(l0, fmaxf(l1, l2)); float w0 = fexp2(l0 - m), w1 = fexp2(l1 - m), w2 = fexp2(l2 - m); const float inv = 1.f / (w0 + w1 + w2); w0 *= inv; w1 *= inv; w2 *= inv;
        const bf16* p = proj + (size_t)row * 4608 + 8 * lane;
        const u32x4 a = *(const u32x4*)p, b = *(const u32x4*)(p + 1536), c = *(const u32x4*)(p + 3072);
        u32x4 o;
#pragma unroll
        for (int e = 0; e < 4; ++e) { const float lo = w0 * bflo(a[e]) + w1 * bflo(b[e]) + w2 * bflo(c[e]), hi = w0 * bfhi(a[e]) + w1 * bfhi(b[e]) + w2 * bfhi(c[e]); o[e] = pk2(lo, hi); }
        *(u32x4*)(HO + (size_t)row * 512 + 8 * lane) = o;
    }
}

DI void ph_conv(Ctx& F) {
    const Params& P = *F.p; unsigned char* ws = F.ws; const bf16* proj = (const bf16*)(ws + WS_BIG); bf16* HO = (bf16*)(ws + WS_HO);
    const int gw = F.bid * NWAVES + F.wave, NGW = F.G * NWAVES; const int lane = F.lane;
    const float* cw = P.in[I_CONVW]; const float* cb = P.in[I_CONVB];
    f32x4 w0[4], w1[4], w2[4], bb[4];
#pragma unroll
    for (int j = 0; j < 4; ++j) { const int col = 4 * lane + 256 * j; w0[j] = *(const f32x4*)(cw + col); w1[j] = *(const f32x4*)(cw + D + col); w2[j] = *(const f32x4*)(cw + 2 * D + col); bb[j] = *(const f32x4*)(cb + col); }
    for (int blk = gw; blk < T / 32; blk += NGW) {
        const int row0 = blk * 32, pos0 = row0 % SEQ;
        f32x4 um1[4], um2[4];
#pragma unroll
        for (int j = 0; j < 4; ++j) { um1[j] = (f32x4){0.f, 0.f, 0.f, 0.f}; um2[j] = um1[j]; }
        if (pos0 >= 2) {
#pragma unroll
            for (int j = 0; j < 4; ++j) { const int col = 4 * lane + 256 * j;
                const u32x2 c1 = *(const u32x2*)(proj + (size_t)(row0 - 1) * 3072 + 1024 + col), u1 = *(const u32x2*)(proj + (size_t)(row0 - 1) * 3072 + 2048 + col);
                const u32x2 c2 = *(const u32x2*)(proj + (size_t)(row0 - 2) * 3072 + 1024 + col), u2 = *(const u32x2*)(proj + (size_t)(row0 - 2) * 3072 + 2048 + col);
                um1[j] = (f32x4){bflo(c1.x) * bflo(u1.x), bfhi(c1.x) * bfhi(u1.x), bflo(c1.y) * bflo(u1.y), bfhi(c1.y) * bfhi(u1.y)};
                um2[j] = (f32x4){bflo(c2.x) * bflo(u2.x), bfhi(c2.x) * bfhi(u2.x), bflo(c2.y) * bflo(u2.y), bfhi(c2.y) * bfhi(u2.y)}; }
        }
        for (int rr = 0; rr < 32; ++rr) { const size_t row = (size_t)row0 + rr;
#pragma unroll
            for (int j = 0; j < 4; ++j) { const int col = 4 * lane + 256 * j;
                const u32x2 gb = *(const u32x2*)(proj + row * 3072 + col), c0 = *(const u32x2*)(proj + row * 3072 + 1024 + col), u0 = *(const u32x2*)(proj + row * 3072 + 2048 + col);
                const f32x4 uc = (f32x4){bflo(c0.x) * bflo(u0.x), bfhi(c0.x) * bfhi(u0.x), bflo(c0.y) * bflo(u0.y), bfhi(c0.y) * bfhi(u0.y)};
                const f32x4 y = w0[j] * um2[j] + w1[j] * um1[j] + w2[j] * uc + bb[j];
                const f32x4 gbv = (f32x4){bflo(gb.x), bfhi(gb.x), bflo(gb.y), bfhi(gb.y)};
                const f32x4 z = gbv * y; u32x2 o; o.x = pk2(z[0], z[1]); o.y = pk2(z[2], z[3]);
                *(u32x2*)(HO + row * D + col) = o;
                um2[j] = um1[j]; um1[j] = uc; }
        }
    }
}

constexpr int G1_GD = 0, G1_QIN = 4096, G1_PITCH = 1040, G1_KIN = G1_QIN + 64 * G1_PITCH;
DI void ph_gla_g1(Ctx& F) {
    const Params& P = *F.p; unsigned char* ws = F.ws; bf16* proj = (bf16*)(ws + WS_BIG);
    const float* gdn = (const float*)(ws + WS_GDOWN); float* decay = (float*)(ws + WS_DECAY);
    bf16* kst = (bf16*)(ws + WS_KST); bf16* vT = (bf16*)(ws + WS_VT); bf16* sc = (bf16*)(ws + WS_SC);
    LAS float* GD = (LAS float*)(F.lds + G1_GD); LAS unsigned char* QIN = F.lds + G1_QIN; LAS unsigned char* KIN = F.lds + G1_KIN;
    const int tid = F.tid, ch = tid, hd = ch >> 7, lane = F.lane, r = lane & 31, h2 = lane >> 5;
    float wup[16];
#pragma unroll
    for (int o = 0; o < 16; ++o) wup[o] = P.in[I_GLAGU][o * 512 + ch];
    const float bg = P.in[I_GLABG][ch];
    for (int item = F.bid; item < T / 64; item += F.G) {
        const size_t row0 = (size_t)item * 64;
        __syncthreads();
        if (tid < 256) *(LAS f32x4*)(GD + tid * 4) = *(const f32x4*)(gdn + row0 * 16 + tid * 4);
        __syncthreads();
        float bs[64]; float bc = 0.f;
#pragma unroll
        for (int i = 0; i < 64; ++i) {
            float u = bg;
#pragma unroll
            for (int q4 = 0; q4 < 4; ++q4) { const f32x4 g = *(const LAS f32x4*)(GD + i * 16 + q4 * 4); u += (g[0] * wup[q4 * 4] + g[1] * wup[q4 * 4 + 1]) + (g[2] * wup[q4 * 4 + 2] + g[3] * wup[q4 * 4 + 3]); }
            const float u2 = u * LOG2E;
            const float ls2 = -(fmaxf(-u2, 0.f) + flog2(1.f + fexp2(-fabsf(u2))));
            bc += ls2 * (1.f / 16.f); bs[i] = bc;
        }
        unsigned kp[32];
        bf16* qcol = proj + row0 * 3072 + ch;
#pragma unroll
        for (int i = 0; i < 64; ++i) {
            const float qv = bf2f(qcol[(size_t)i * 3072]), kv = bf2f(qcol[(size_t)i * 3072 + 512]);
            const float qin = qv * fexp2(bs[i]), kin = kv * fexp2(-bs[i]), kstv = kv * fexp2(bs[63] - bs[i]);
            const unsigned short qb = (unsigned short)f2bf(qin);
            qcol[(size_t)i * 3072] = qb;
            *(LAS unsigned short*)(QIN + i * G1_PITCH + ch * 2) = qb;
            *(LAS unsigned short*)(KIN + i * G1_PITCH + ch * 2) = (unsigned short)f2bf(kin);
            if (i & 1) kp[i >> 1] |= f2bf(kstv) << 16; else kp[i >> 1] = f2bf(kstv);
        }
        { u32x4* dst = (u32x4*)(kst + ((size_t)item * 512 + ch) * 64);
#pragma unroll
          for (int q8 = 0; q8 < 8; ++q8) dst[q8] = (u32x4){kp[4 * q8], kp[4 * q8 + 1], kp[4 * q8 + 2], kp[4 * q8 + 3]}; }
        decay[(size_t)item * 512 + ch] = fexp2(bs[63]);
#pragma unroll
        for (int half = 0; half < 2; ++half) { const int cc = ch + 512 * half; const bf16* vcol = proj + row0 * 3072 + 1024 + cc;
            unsigned vp[32];
#pragma unroll
            for (int i = 0; i < 64; i += 2) vp[i >> 1] = (unsigned)vcol[(size_t)i * 3072] | ((unsigned)vcol[(size_t)(i + 1) * 3072] << 16);
            u32x4* dst = (u32x4*)(vT + ((size_t)item * 1024 + cc) * 64);
#pragma unroll
            for (int q8 = 0; q8 < 8; ++q8) dst[q8] = (u32x4){vp[4 * q8], vp[4 * q8 + 1], vp[4 * q8 + 2], vp[4 * q8 + 3]}; }
        __syncthreads();
        { const int shd = F.wave >> 1, jt = F.wave & 1;
#pragma unroll
          for (int itile = 0; itile < 2; ++itile) {
            f32x16 st = zero16();
            if (jt <= itile) {
#pragma unroll
                for (int s = 0; s < 8; ++s) { const bf16x8 kf = *(const LAS bf16x8*)(KIN + (jt * 32 + r) * G1_PITCH + (shd * 128 + 16 * s + 8 * h2) * 2);
                    const bf16x8 qf = *(const LAS bf16x8*)(QIN + (itile * 32 + r) * G1_PITCH + (shd * 128 + 16 * s + 8 * h2) * 2);
                    st = MFMA32(kf, qf, st); }
            }
            const int iq = itile * 32 + r;
            bf16* dst = sc + (((size_t)item * 4 + shd) * 64 + iq) * 64 + jt * 32 + 4 * h2;
#pragma unroll
            for (int g = 0; g < 4; ++g) { float v[4];
#pragma unroll
                for (int k = 0; k < 4; ++k) { const int j = jt * 32 + 8 * g + 4 * h2 + k; v[k] = (j <= iq) ? st[4 * g + k] : 0.f; }
                u32x2 w; w.x = pk2(v[0], v[1]); w.y = pk2(v[2], v[3]); *(u32x2*)(dst + 8 * g) = w; }
          } }
    }
}
DI void ph_gla_g2(Ctx& F) {
    unsigned char* ws = F.ws; const bf16* proj = (const bf16*)(ws + WS_BIG); const float* decay = (const float*)(ws + WS_DECAY);
    const bf16* kst = (const bf16*)(ws + WS_KST); const bf16* vT = (const bf16*)(ws + WS_VT); const bf16* sc = (const bf16*)(ws + WS_SC); bf16* oraw = (bf16*)(ws + WS_HO);
    const int lane = F.lane, r = lane & 31, h2 = lane >> 5;
    const int gwv = F.wave * F.G + F.bid, NGW = F.G * NWAVES;
    for (int it = gwv; it < NB * 4 * 8; it += NGW) {
        const int b = it >> 5, hd = (it >> 3) & 3, dvs = it & 7;
        f32x16 S[4];
#pragma unroll
        for (int mt = 0; mt < 4; ++mt) S[mt] = zero16();
        for (int n = 0; n < SEQ / 64; ++n) {
            const size_t ci = (size_t)b * (SEQ / 64) + n;
            const bf16* vrow = vT + (ci * 1024 + hd * 256 + dvs * 32 + r) * 64 + 8 * h2;
            bf16x8 Vf[4];
#pragma unroll
            for (int s = 0; s < 4; ++s) Vf[s] = ldg8(vrow + 16 * s);
            bf16x8 Sb[4][2];
#pragma unroll
            for (int mt = 0; mt < 4; ++mt) { Sb[mt][0] = pack_step(S[mt], 0); Sb[mt][1] = pack_step(S[mt], 1); }
#pragma unroll
            for (int itile = 0; itile < 2; ++itile) {
                f32x16 o = zero16();
                const bf16* scrow = sc + ((ci * 4 + hd) * 64 + itile * 32 + r) * 64 + 8 * h2;
#pragma unroll
                for (int s = 0; s < 4; ++s) o = MFMA32(Vf[s], ldg8(scrow + 16 * s), o);
                const bf16* qrow = proj + (ci * 64 + itile * 32 + r) * 3072 + hd * 128 + 4 * h2;
#pragma unroll
                for (int mt = 0; mt < 4; ++mt)
#pragma unroll
                    for (int s2 = 0; s2 < 2; ++s2) { const u32x2 lo = *(const u32x2*)(qrow + 32 * mt + 16 * s2), hi = *(const u32x2*)(qrow + 32 * mt + 16 * s2 + 8);
                        const u32x4 fr = (u32x4){lo.x, lo.y, hi.x, hi.y};
                        o = MFMA32(Sb[mt][s2], __builtin_bit_cast(bf16x8, fr), o); }
                bf16* op = oraw + (ci * 64 + itile * 32 + r) * 1024 + hd * 256 + dvs * 32 + 4 * h2;
#pragma unroll
                for (int g = 0; g < 4; ++g) { u32x2 w; w.x = pk2(o[4 * g], o[4 * g + 1]); w.y = pk2(o[4 * g + 2], o[4 * g + 3]); *(u32x2*)(op + 8 * g) = w; }
            }
#pragma unroll
            for (int mt = 0; mt < 4; ++mt) {
                const float* dp = decay + ci * 512 + hd * 128 + 32 * mt + 4 * h2;
#pragma unroll
                for (int g = 0; g < 4; ++g) { const f32x4 dv = *(const f32x4*)(dp + 8 * g);
#pragma unroll
                    for (int k = 0; k < 4; ++k) S[mt][4 * g + k] *= dv[k]; }
                const bf16* krow = kst + ((ci * 4 + hd) * 128 + 32 * mt + r) * 64 + 8 * h2;
#pragma unroll
                for (int s = 0; s < 4; ++s) S[mt] = MFMA32(ldg8(krow + 16 * s), Vf[s], S[mt]);
            }
        }
    }
}
DI void ph_gla_g3(Ctx& F) {
    const Params& P = *F.p; unsigned char* ws = F.ws; const bf16* proj = (const bf16*)(ws + WS_BIG); bf16* HO = (bf16*)(ws + WS_HO);
    const int gw = F.bid * NWAVES + F.wave, NGW = F.G * NWAVES; const int lane = F.lane;
    float gn[16];
#pragma unroll
    for (int e = 0; e < 16; ++e) gn[e] = P.in[I_GLANG][(16 * lane + e) & 255];
    for (int row = gw; row < T; row += NGW) {
        bf16* op = HO + (size_t)row * D + 16 * lane; const bf16* rp = proj + (size_t)row * 3072 + 2048 + 16 * lane;
        const u32x4 a0 = *(const u32x4*)op, a1 = *(const u32x4*)(op + 8), r0 = *(const u32x4*)rp, r1 = *(const u32x4*)(rp + 8);
        float v[16], rv[16];
#pragma unroll
        for (int e = 0; e < 4; ++e) { v[2 * e] = bflo(a0[e]); v[2 * e + 1] = bfhi(a0[e]); v[8 + 2 * e] = bflo(a1[e]); v[8 + 2 * e + 1] = bfhi(a1[e]);
            rv[2 * e] = bflo(r0[e]); rv[2 * e + 1] = bfhi(r0[e]); rv[8 + 2 * e] = bflo(r1[e]); rv[8 + 2 * e + 1] = bfhi(r1[e]); }
        float ss = 0.f;
#pragma unroll
        for (int e = 0; e < 16; ++e) ss += v[e] * v[e];
        ss += __shfl_xor(ss, 1); ss += __shfl_xor(ss, 2); ss += __shfl_xor(ss, 4); ss += __shfl_xor(ss, 8);
        const float rstd = 1.f / sqrtf(ss * (1.f / 256.f) + RMS_EPS);
        float o[16];
#pragma unroll
        for (int e = 0; e < 16; ++e) { const float rr = rv[e]; o[e] = v[e] * rstd * gn[e] * (rr / (1.f + __expf(-rr))); }
        u32x4 w0, w1;
#pragma unroll
        for (int e = 0; e < 4; ++e) { w0[e] = pk2(o[2 * e], o[2 * e + 1]); w1[e] = pk2(o[8 + 2 * e], o[8 + 2 * e + 1]); }
        *(u32x4*)op = w0; *(u32x4*)(op + 8) = w1;
    }
}

DI void ph_norm2(Ctx& F, int l) {
    const Params& P = *F.p; unsigned char* ws = F.ws;
    const float* modp = (const float*)(ws + WS_MODP);
    LAS float* WT = (LAS float*)F.lds;
    volatile LAS unsigned* hist = F.MISC + 32;
    const float* wg = P.in[I_MGRPW] + (size_t)l * D * 4; const float* we = P.in[I_MEXPW] + (size_t)l * D * 32;
    const float* bgp = P.in[I_MGRPB] + l * 4; const float* bep = P.in[I_MEXPB] + l * 32;
    __syncthreads();
    for (int idx = F.tid; idx < 36 * D; idx += NTHR) { const int c = idx & (D - 1), o = idx >> 10; WT[idx] = (o < 4) ? wg[c * 4 + o] : we[c * 32 + (o - 4)]; }
    __syncthreads();
    const float* X = P.out; bf16* HO = (bf16*)(ws + WS_HO);
    int* tok_e = (int*)(ws + WS_TOKE); float* tok_w = (float*)(ws + WS_TOKW); int* hist_g = (int*)(ws + WS_HIST);
    const float* ng = P.in[I_NORMG] + (size_t)(l * 2 + 1) * D;
    const int lane = F.lane;
    for (int vb = F.bid; vb < T / 256; vb += F.G) {
        if (F.tid < 32) hist[F.tid] = 0u;
        __syncthreads();
        const int row0 = vb * 256 + F.wave * 32, b = row0 / SEQ;
        f32x4 gm[4], sh[4];
        mod_vec(modp, P.in[I_ADAB], l, b, 3, lane, sh); mod_vec(modp, P.in[I_ADAB], l, b, 4, lane, gm);
#pragma unroll
        for (int j = 0; j < 4; ++j) gm[j] = *(const f32x4*)(ng + 4 * lane + 256 * j) * (gm[j] + 1.f);
        for (int rr = 0; rr < 32; ++rr) { const int row = row0 + rr;
            f32x4 v[4]; row_load(X + (size_t)row * D, lane, v);
            const float rstd = row_rstd(v);
#pragma unroll
            for (int j = 0; j < 4; ++j) v[j] = v[j] * rstd * gm[j] + sh[j];
            row_store_bf16(HO + (size_t)row * D, lane, v);
            float gl[4];
#pragma unroll
            for (int o = 0; o < 4; ++o) { float s = 0.f;
#pragma unroll
                for (int j = 0; j < 4; ++j) { const f32x4 w = *(const LAS f32x4*)(WT + o * D + 4 * lane + 256 * j); s += (v[j][0] * w[0] + v[j][1] * w[1]) + (v[j][2] * w[2] + v[j][3] * w[3]); }
                gl[o] = wave_sum(s) + bgp[o]; }
            int grp = 0; float gmax = gl[0];
#pragma unroll
            for (int o = 1; o < 4; ++o) if (gl[o] > gmax) { gmax = gl[o]; grp = o; }
            float gden = 0.f;
#pragma unroll
            for (int o = 0; o < 4; ++o) gden += __expf(gl[o] - gmax);
            const float pgrp = 1.f / gden;
            float b1 = -__builtin_inff(), b2 = -__builtin_inff(); int i1 = 0, i2 = 0;
#pragma unroll
            for (int k = 0; k < 8; ++k) { float s = 0.f; const LAS float* wrow = WT + (4 + grp * 8 + k) * D + 4 * lane;
#pragma unroll
                for (int j = 0; j < 4; ++j) { const f32x4 w = *(const LAS f32x4*)(wrow + 256 * j); s += (v[j][0] * w[0] + v[j][1] * w[1]) + (v[j][2] * w[2] + v[j][3] * w[3]); }
                s = wave_sum(s) + bep[grp * 8 + k];
                if (s > b1) { b2 = b1; i2 = i1; b1 = s; i1 = k; } else if (s > b2) { b2 = s; i2 = k; } }
            const float e2 = __expf(b2 - b1), inv = 1.f / (1.f + e2);
            if (lane == 0) { const int e0g = grp * 8 + i1, e1g = grp * 8 + i2;
                tok_e[row * 2] = e0g; tok_e[row * 2 + 1] = e1g; tok_w[row * 2] = pgrp * inv; tok_w[row * 2 + 1] = pgrp * e2 * inv;
                __hip_atomic_fetch_add((LAS unsigned*)(hist + e0g), 1u, __ATOMIC_RELAXED, __HIP_MEMORY_SCOPE_WORKGROUP); __hip_atomic_fetch_add((LAS unsigned*)(hist + e1g), 1u, __ATOMIC_RELAXED, __HIP_MEMORY_SCOPE_WORKGROUP); }
        }
        __syncthreads();
        if (F.tid < 32) hist_g[vb * 32 + F.tid] = (int)hist[F.tid];
        __syncthreads();
    }
}
DI void ph_scatter(Ctx& F) {
    unsigned char* ws = F.ws;
    const int* hist_g = (const int*)(ws + WS_HIST); const int* tok_e = (const int*)(ws + WS_TOKE);
    int* tok_s = (int*)(ws + WS_TOKS); int* slot_tok = (int*)(ws + WS_SLOTTOK); int* tile_e = (int*)(ws + WS_TILEE);
    LAS int* H = (LAS int*)F.lds; LAS int* eid = H + 8192; LAS int* tot = eid + 512; LAS int* base = tot + 32; LAS int* pstart = base + 32; LAS int* ptotal = pstart + 32;
    for (int vb = F.bid; vb < T / 256; vb += F.G) {
        __syncthreads();
        for (int i = F.tid; i < 8192; i += NTHR) H[i] = hist_g[i];
        eid[F.tid] = tok_e[vb * 512 + F.tid];
        __syncthreads();
        if (F.tid < 32) { int total = 0, before = 0; for (int bb = 0; bb < 256; ++bb) { const int c = H[bb * 32 + F.tid]; total += c; before += (bb < vb) ? c : 0; } tot[F.tid] = total; base[F.tid] = before; }
        __syncthreads();
        if (F.tid == 0) { int ps = 0; for (int e = 0; e < 32; ++e) { pstart[e] = ps; ps += ((tot[e] + 255) >> 8) << 8; } ptotal[0] = ps; }
        __syncthreads();
        const int e = eid[F.tid]; int rank = 0;
        for (int j = 0; j < F.tid; ++j) rank += (eid[j] == e) ? 1 : 0;
        const int slot = pstart[e] + base[e] + rank;
        slot_tok[slot] = vb * 256 + (F.tid >> 1); tok_s[vb * 512 + F.tid] = slot;
        if (vb == 0) {
            if (F.tid < 32) { const int ee = F.tid, s0 = pstart[ee] + tot[ee], s1 = pstart[ee] + (((tot[ee] + 255) >> 8) << 8);
                for (int s = s0; s < s1; ++s) slot_tok[s] = 0;
                for (int tl = pstart[ee] >> 8; tl < (s1 >> 8); ++tl) tile_e[tl] = ee; }
            if (F.tid == 0) tile_e[1023] = ptotal[0] >> 8;
        }
    }
}
DI void ph_final(Ctx& F) {
    const Params& P = *F.p; unsigned char* ws = F.ws;
    const int gw = F.bid * NWAVES + F.wave, NGW = F.G * NWAVES;
    const float* modp = (const float*)(ws + WS_MODP); float* X = P.out; const float* fg = P.in[I_FINALG];
    for (int blk = gw; blk < T / 32; blk += NGW) {
        const int row0 = blk * 32, b = row0 / SEQ;
        f32x4 g2[4], gf[4];
        mod_vec(modp, P.in[I_ADAB], DEPTH - 1, b, 5, F.lane, g2);
#pragma unroll
        for (int j = 0; j < 4; ++j) gf[j] = *(const f32x4*)(fg + 4 * F.lane + 256 * j);
        for (int r = 0; r < 32; ++r) { const int row = row0 + r;
            f32x4 v[4]; row_load(X + (size_t)row * D, F.lane, v);
            moe_combine_row(F, row, g2, v);
            const float rstd = row_rstd(v);
#pragma unroll
            for (int j = 0; j < 4; ++j) *(f32x4*)(X + (size_t)row * D + 4 * F.lane + 256 * j) = v[j] * rstd * gf[j];
        }
    }
}

constexpr int N_PHASES = 42;
#ifndef EN
#define EN 0xFFFFu
#endif
#define ENB(i) (((EN) >> (i)) & 1u)
__host__ __device__ inline bool phase_exists(int k) { if (k == 0 || k == 41) return true; const int l = (k - 1) / 10, j = (k - 1) % 10; if (j == 3) return l == 1 || l == 3; if (j == 4) return l == 1; return true; }

__global__ void __launch_bounds__(NTHR, 2) fwd(Params P) {
    extern __shared__ __attribute__((aligned(16))) unsigned char lds_raw[];
    Ctx F;
    F.lds = (LAS unsigned char*)lds_raw; F.MISC = (volatile LAS unsigned*)(F.lds + MISC_OFF);
    F.tid = threadIdx.x; F.lane = F.tid & 63; F.wave = __builtin_amdgcn_readfirstlane(F.tid >> 6); F.G = gridDim.x; F.bid = blockIdx.x; F.p = &P;
    if (F.tid < 128) F.MISC[F.tid] = 0u;
    __syncthreads();
#if MK_N_LAUNCHES == 1
    XcdBarrier bar = xcd_barrier_post((unsigned*)(P.ws + WS_CTL) + CW_BAR, F.MISC + 8);
#define SEAM(k) do { if ((k) + 1 < P.ph_hi) xcd_barrier(bar); } while (0)
#else
#define SEAM(k) do { } while (0)
#endif
#define RUN(k) (P.ph_lo <= (k) && (k) < P.ph_hi)
#define FRESH() int t_ = threadIdx.x; asm volatile("" : "+v"(t_)); F.tid = t_; F.lane = t_ & 63; F.wave = __builtin_amdgcn_readfirstlane(t_ >> 6); \
    unsigned char* ws = P.ws; asm volatile("" : "+s"(ws)); F.ws = ws; bf16* HO = (bf16*)(ws + WS_HO); bf16* BIG = (bf16*)(ws + WS_BIG); float* modf = (float*)(ws + WS_MODF); (void)HO; (void)BIG; (void)modf
    if (ENB(0) && RUN(0)) { FRESH(); ph_prologue(F); SEAM(0); }
#pragma unroll
    for (int l = 0; l < DEPTH; ++l) {
        const int pb = 1 + 10 * l;
        if (ENB(1) && RUN(pb + 0)) { FRESH(); ph_norm1(F, l); SEAM(pb + 0); }
        if (ENB(2) && RUN(pb + 1)) { FRESH();
            const int N = (l == 3) ? 4608 : 3072;
            const void* Bt = ws + (l == 0 ? W_SBIN : l == 1 ? W_GLAIN : l == 2 ? W_CONVIN : W_DILIN);
            pg8::DenseSched S; S.init(T, N, D, Bt, F.G, F.bid);
            pg8::EpiProj E; E.O = BIG; E.ldc = N; E.period = (l == 3) ? 1536 : 3072; E.qcols = (l == 0) ? 1024 : (l == 2) ? 0 : 512;
            E.qscale = (l == 1) ? 0.08838834764831845f : 0.125f * LOG2E;
            pg8::gemm_phase<pg8::EpiProj, pg8::DenseSched, true>(F.tid, F.lds, (const char*)HO, D, D, S, E);
            SEAM(pb + 1);
        }
        if (RUN(pb + 2)) { FRESH();
            if (l == 0) { if (ENB(3)) ph_sb_attn(F); } else if (l == 1) { if (ENB(4)) ph_gla_g1(F); } else if (l == 2) { if (ENB(5)) ph_conv(F); } else { if (ENB(6)) ph_dil_attn(F); }
            SEAM(pb + 2);
        }
        if ((l == 1 || l == 3) && RUN(pb + 3)) { FRESH(); if (l == 1) { if (ENB(7)) ph_gla_g2(F); } else { if (ENB(8)) ph_dil_combine(F); } SEAM(pb + 3); }
        if (ENB(9) && l == 1 && RUN(pb + 4)) { FRESH(); ph_gla_g3(F); SEAM(pb + 4); }
        if (ENB(10) && RUN(pb + 5)) { FRESH();
            const int K = (l == 3) ? 512 : D; const int lda = (l == 0) ? 3072 : K;
            const char* A = (l == 0) ? (const char*)BIG : (const char*)HO;
            const void* Bt = ws + (l == 0 ? W_SBOUT : l == 1 ? W_GLAOUT : l == 2 ? W_CONVOUT : W_DILOUT);
            pg8::DenseSched S; S.init(T, D, K, Bt, F.G, F.bid);
            pg8::EpiResid E; E.resid = (l == 0) ? P.in[I_X] : P.out; E.out = P.out; E.gate = modf + (size_t)l * NB * 6144 + 2 * D;
            pg8::gemm_phase<pg8::EpiResid, pg8::DenseSched, true>(F.tid, F.lds, A, lda, K, S, E);
            SEAM(pb + 5);
        }
        if (ENB(11) && RUN(pb + 6)) { FRESH(); ph_norm2(F, l); SEAM(pb + 6); }
        if (ENB(12) && RUN(pb + 7)) { FRESH(); ph_scatter(F); SEAM(pb + 7); }
        if (ENB(13) && RUN(pb + 8)) { FRESH();
            const int* tile_e = (const int*)(ws + WS_TILEE);
            const int ntiles = __builtin_amdgcn_readfirstlane(__hip_atomic_load(tile_e + 1023, __ATOMIC_RELAXED, __HIP_MEMORY_SCOPE_AGENT));
            pg8::MoeSched<true> S; S.G = F.G; S.c = F.bid; S.K = D; S.Bt = (const char*)(ws + WS_W1T); S.estride = (size_t)1024 * D * 2; S.tile_e = tile_e; S.slot_tok = (const int*)(ws + WS_SLOTTOK); S.nunits = ntiles * 4;
            pg8::EpiMoe1 E; E.O = (bf16*)(ws + WS_ACT);
            pg8::gemm_phase<pg8::EpiMoe1, pg8::MoeSched<true>, true>(F.tid, F.lds, (const char*)HO, D, D, S, E);
            SEAM(pb + 8);
        }
        if (ENB(14) && RUN(pb + 9)) { FRESH();
            const int* tile_e = (const int*)(ws + WS_TILEE);
            const int ntiles = __builtin_amdgcn_readfirstlane(__hip_atomic_load(tile_e + 1023, __ATOMIC_RELAXED, __HIP_MEMORY_SCOPE_AGENT));
            pg8::MoeSched<false> S; S.G = F.G; S.c = F.bid; S.K = MOE_FF; S.Bt = (const char*)(ws + WS_W2T); S.estride = (size_t)1024 * MOE_FF * 2; S.tile_e = tile_e; S.slot_tok = nullptr; S.nunits = ntiles * 4;
            pg8::EpiProj E; E.O = (bf16*)(ws + WS_YB); E.ldc = D; E.period = 1 << 30; E.qcols = 0; E.qscale = 1.f;
            pg8::gemm_phase<pg8::EpiProj, pg8::MoeSched<false>, true>(F.tid, F.lds, (const char*)(ws + WS_ACT), MOE_FF, MOE_FF, S, E);
            SEAM(pb + 9);
        }
    }
    if (ENB(15) && RUN(41)) { FRESH(); ph_final(F); }
#undef RUN
#undef SEAM
}

extern "C" void kernel_launch(void* const* d_in, const int* in_sizes, int n_in, void* d_out, int out_size, void* d_ws, size_t ws_size, hipStream_t stream) {
    static int grid = 0;
    if (grid == 0) {
        if (n_in != 26 || out_size != T * D || ws_size < WS_END) { fprintf(stderr, "kernel_launch: unexpected shapes (n_in %d, out %d, ws %zu < %zu)\n", n_in, out_size, ws_size, (size_t)WS_END); grid = -1; return; }
        int dev = 0, cus = 0, per_cu = 0;
        if (hipGetDevice(&dev) != hipSuccess || hipDeviceGetAttribute(&cus, hipDeviceAttributeMultiprocessorCount, dev) != hipSuccess) { grid = -1; return; }
        if (hipFuncSetAttribute((const void*)fwd, hipFuncAttributeMaxDynamicSharedMemorySize, LDS_BYTES) != hipSuccess) { fprintf(stderr, "kernel_launch: hipFuncSetAttribute failed\n"); grid = -1; return; }
        if (hipOccupancyMaxActiveBlocksPerMultiprocessor(&per_cu, (const void*)fwd, NTHR, LDS_BYTES) != hipSuccess || per_cu < 1) fprintf(stderr, "kernel_launch: occupancy query reports %d\n", per_cu);
        (void)hipGetLastError();
        grid = cus;
    }
    if (grid < 0) return;
    (void)hipMemsetAsync((char*)d_ws + WS_CTL, 0, CTL_ZERO_BYTES, stream);
    Params p{};
    for (int i = 0; i < 26; ++i) p.in[i] = (const float*)d_in[i];
    p.out = (float*)d_out; p.ws = (unsigned char*)d_ws;
#if MK_N_LAUNCHES == 1
    p.ph_lo = 0; p.ph_hi = N_PHASES;
    hipLaunchKernelGGL(fwd, dim3(grid), dim3(NTHR), LDS_BYTES, stream, p);
#else
    for (int k = 0; k < N_PHASES; ++k) { if (!phase_exists(k)) continue; p.ph_lo = k; p.ph_hi = k + 1; hipLaunchKernelGGL(fwd, dim3(grid), dim3(NTHR), LDS_BYTES, stream, p); }
#endif
}
```

```cpp
#include <hip/hip_runtime.h>
#include <cstdio>
#include <cstdint>
#ifndef MK_N_LAUNCHES
#define MK_N_LAUNCHES 1
#endif
#define LAS __attribute__((address_space(3)))
#define GAS __attribute__((address_space(1)))
typedef unsigned short bf16;
typedef short bf16x8 __attribute__((ext_vector_type(8)));
typedef short s16x4 __attribute__((ext_vector_type(4)));
typedef float f32x2 __attribute__((ext_vector_type(2)));
typedef float f32x4 __attribute__((ext_vector_type(4)));
typedef float f32x16 __attribute__((ext_vector_type(16)));
typedef unsigned u32x2 __attribute__((ext_vector_type(2)));
typedef unsigned u32x4 __attribute__((ext_vector_type(4)));
typedef int i32x4 __attribute__((ext_vector_type(4)));
typedef int i32x8 __attribute__((ext_vector_type(8)));
#define DI __device__ __forceinline__

constexpr int NB = 8, SEQ = 8192, D = 1024, T = NB * SEQ, DEPTH = 4;
constexpr float RMS_EPS = 1e-6f;
constexpr float LOG2E = 1.4426950408889634f;
constexpr int NWAVES = 8, NTHR = 512;
constexpr int MOE_E = 32, MOE_FF = 512;
constexpr int PMAX = 2 * T + MOE_E * 256;
constexpr int KSPLIT = 8;
#ifndef INFP8_MASK
#define INFP8_MASK 0x9
#endif
#ifndef OUTFP8_MASK
#define OUTFP8_MASK 0x0
#endif
__host__ __device__ constexpr bool out_fp8(int l) { return ((OUTFP8_MASK) >> l) & 1; }
__host__ __device__ constexpr bool in_fp8(int l) { return ((INFP8_MASK) >> l) & 1; }

constexpr size_t MiB = 1u << 20;
constexpr size_t WS_CTL = 0, CTL_ZERO_BYTES = 1 * MiB;
constexpr size_t WS_MODP = 2 * MiB;
constexpr size_t WS_MODF = 9 * MiB;
constexpr size_t WS_TOKE = 10 * MiB;
constexpr size_t WS_TOKW = WS_TOKE + 512 * 1024;
constexpr size_t WS_TOKS = WS_TOKW + 512 * 1024;
constexpr size_t WS_SLOTTOK = WS_TOKS + 512 * 1024;
constexpr size_t WS_HIST = 13 * MiB;
constexpr size_t WS_TILEE = WS_HIST + 64 * 1024;
constexpr size_t WS_GDOWN = 14 * MiB;
constexpr size_t WS_DECAY = 18 * MiB;
constexpr size_t WS_LSE = 20 * MiB;
constexpr size_t WS_WMIX = 26 * MiB;
constexpr size_t W_SBIN = WS_WMIX, W_SBOUT = W_SBIN + 6 * MiB, W_GLAIN = W_SBOUT + 2 * MiB, W_GLAOUT = W_GLAIN + 6 * MiB, W_CONVIN = W_GLAOUT + 2 * MiB,
                 W_CONVOUT = W_CONVIN + 6 * MiB, W_DILIN = W_CONVOUT + 2 * MiB, W_DILOUT = W_DILIN + 9 * MiB;
constexpr size_t WS_W1T = 62 * MiB;
constexpr size_t WS_W2T = 126 * MiB;
constexpr size_t WS_HO = 158 * MiB;
constexpr size_t WS_BIG = 286 * MiB;
constexpr size_t WS_KST = WS_BIG + 384 * MiB;
constexpr size_t WS_VT = WS_KST + 64 * MiB;
constexpr size_t WS_SC = WS_VT + 128 * MiB;
constexpr size_t WS_ACT = WS_BIG;
constexpr size_t WS_YB = WS_BIG + 140 * MiB;
constexpr size_t WS_SEND = WS_SC + 32 * MiB;
constexpr size_t WS_DSEG = WS_SEND + 32 * MiB;
constexpr size_t WS_XB = WS_DSEG + 1 * MiB;
constexpr size_t WS_SSP = WS_XB + 128 * MiB;
constexpr size_t WS_END = WS_SSP + 4 * MiB;
constexpr int CW_BAR = 4096;

constexpr int LDS_BYTES = 160 * 1024 - 512;
constexpr int MISC_OFF = LDS_BYTES - 512;

DI unsigned f2bf(float f) { unsigned u = __builtin_bit_cast(unsigned, f); return (u + 0x7fffu + ((u >> 16) & 1u)) >> 16; }
typedef __bf16 bf16n2 __attribute__((ext_vector_type(2)));
DI unsigned pk2(float lo, float hi) { const f32x2 v = {lo, hi}; return __builtin_bit_cast(unsigned, __builtin_convertvector(v, bf16n2)); }
DI unsigned pk4_fp8(float a, float b, float c, float d) {
    a = __builtin_amdgcn_fmed3f(a, -448.f, 448.f); b = __builtin_amdgcn_fmed3f(b, -448.f, 448.f); c = __builtin_amdgcn_fmed3f(c, -448.f, 448.f); d = __builtin_amdgcn_fmed3f(d, -448.f, 448.f);
    int w = 0; w = __builtin_amdgcn_cvt_pk_fp8_f32(a, b, w, false); w = __builtin_amdgcn_cvt_pk_fp8_f32(c, d, w, true); return (unsigned)w;
}
DI float bf2f(unsigned short b) { return __builtin_bit_cast(float, (unsigned)b << 16); }
DI float bflo(unsigned w) { return __builtin_bit_cast(float, w << 16); }
DI float bfhi(unsigned w) { return __builtin_bit_cast(float, w & 0xffff0000u); }
DI float wave_sum(float v) {
#pragma unroll
    for (int o = 1; o < 64; o <<= 1) v += __shfl_xor(v, o);
    return v;
}
template <int N> DI float halving_reduce(float (&a)[N], int lane) {
    int bit = 32;
#pragma unroll
    for (int n = N; n > 1; n >>= 1) {
        const bool hi = (lane & bit) != 0;
#pragma unroll
        for (int i = 0; i < n / 2; ++i) { const float keep = hi ? a[n / 2 + i] : a[i], send = hi ? a[i] : a[n / 2 + i]; a[i] = keep + __shfl_xor(send, bit); }
        bit >>= 1;
    }
    float k = a[0];
#pragma unroll
    for (; bit >= 1; bit >>= 1) k += __shfl_xor(k, bit);
    return k;
}
DI float rdlane(float v, int l) { return __builtin_bit_cast(float, __builtin_amdgcn_readlane(__builtin_bit_cast(int, v), l)); }
DI float fexp2(float x) { return __builtin_amdgcn_exp2f(x); }
DI float flog2(float x) { return __builtin_amdgcn_logf(x); }
#define LDS_WAIT() asm volatile("s_waitcnt lgkmcnt(0)" ::: "memory")
#define VM_WAIT() asm volatile("s_waitcnt vmcnt(0)" ::: "memory")

#define XB_TMO      128
#define XB_XCNT(j)  (256  + 64 * (j))
#define XB_XSUB(j)  (1280 + 64 * (j))
#define XB_XGEN(j)  (2304 + 64 * (j))
#define XB_TOP      3328
#define XB_TOPGEN   3392
#define XCD_BAR_WORDS 3456
#define XB_SPIN_CAP (1u << 20)
DI unsigned xb_ld(unsigned* p)              { return __hip_atomic_load(p, __ATOMIC_RELAXED, __HIP_MEMORY_SCOPE_AGENT); }
DI unsigned xb_add(unsigned* p, unsigned v) { return __hip_atomic_fetch_add(p, v, __ATOMIC_RELAXED, __HIP_MEMORY_SCOPE_AGENT); }
DI unsigned xb_xcc_id() { return (unsigned)__builtin_amdgcn_s_getreg((3 << 11) | 20) & 0xFu; }
#define XB_SPIN(cond, bar) do { unsigned _sp = 0; while (cond) { __builtin_amdgcn_s_sleep(1); \
    if ((++_sp & 255u) == 0u) { if (xb_ld(&(bar)[XB_TMO])) break; if (_sp > XB_SPIN_CAP) { atomicAdd(&(bar)[XB_TMO], 1u); break; } } } } while (0)
struct XcdBarrier { unsigned* bar; unsigned x; volatile LAS unsigned* st; };
DI XcdBarrier xcd_barrier_post(unsigned* bar, volatile LAS unsigned* st) {
    XcdBarrier b; b.bar = bar; b.x = xb_xcc_id(); b.st = st;
    if (threadIdx.x == 0) (void)xb_add(&bar[XB_XCNT(b.x)], 1u);
    return b;
}
DI void xcd_barrier_complete(unsigned* bar, unsigned x, unsigned& nloc, unsigned& nx) {
    const unsigned G = gridDim.x * gridDim.y * gridDim.z;
    unsigned sum, cnt, mine, sp = 0u;
    for (;;) {
        sum = 0u; cnt = 0u; mine = 0u;
#pragma unroll
        for (unsigned j = 0; j < 16; ++j) { const unsigned c = xb_ld(&bar[XB_XCNT(j)]); sum += c; cnt += (c > 0u) ? 1u : 0u; mine = (j == x) ? c : mine; }
        if (sum == G) break;
        __builtin_amdgcn_s_sleep(1);
        if ((++sp & 255u) == 0u) { if (xb_ld(&bar[XB_TMO])) break; if (sp > XB_SPIN_CAP) { atomicAdd(&bar[XB_TMO], 1u); break; } }
    }
    nloc = mine > 0u ? mine : 1u; nx = cnt > 0u ? cnt : 1u;
}
template <bool FIRST> DI void xcd_barrier(const XcdBarrier& b) {
    asm volatile("s_waitcnt vmcnt(0)" ::: "memory");
    __syncthreads();
    if (threadIdx.x == 0) {
        unsigned* bar = b.bar;
        __builtin_amdgcn_s_waitcnt(0);
        unsigned nloc = b.st[0], nx = b.st[1];
        if constexpr (FIRST) { if (nloc == 0u) { xcd_barrier_complete(bar, b.x, nloc, nx); b.st[0] = nloc; b.st[1] = nx; } }
        const unsigned old = xb_add(&bar[XB_XSUB(b.x)], 1u);
        const unsigned gen = old / nloc;
        if (old + 1u == (gen + 1u) * nloc) {
            __builtin_amdgcn_fence(__ATOMIC_RELEASE, "agent");
            asm volatile("s_waitcnt vmcnt(0)" ::: "memory");
            const unsigned og = xb_add(&bar[XB_TOP], 1u);
            const unsigned tg = og / nx;
            if (og + 1u == (tg + 1u) * nx) xb_add(&bar[XB_TOPGEN], 1u);
            else XB_SPIN(xb_ld(&bar[XB_TOPGEN]) == tg, bar);
            __builtin_amdgcn_fence(__ATOMIC_ACQUIRE, "agent");
            xb_add(&bar[XB_XGEN(b.x)], 1u);
            asm volatile("s_waitcnt vmcnt(0)" ::: "memory");
        } else {
            XB_SPIN(xb_ld(&bar[XB_XGEN(b.x)]) == gen, bar);
            __builtin_amdgcn_fence(__ATOMIC_ACQUIRE, "agent");
            asm volatile("s_waitcnt vmcnt(0)" ::: "memory");
        }
    }
    __syncthreads();
}

namespace pg8 {
constexpr int BM = 256, BK = 64, HALF = 128, HTB = HALF * BK * 2, STAGE_BYTES = 8 * HTB, NXCD = 8, WGM = 8;
DI int lds_byte(int r, int c) { const int st = (r >> 4) * 2 + (c >> 5), rr = r & 15, cc = c & 31, ob = rr * 64 + cc * 2; return st * 1024 + (ob ^ (((ob >> 9) & 1) << 5)); }
DI void stage_rc(int b, int& R, int& C) { const int st = b / 1024, sb = b % 1024, swz = sb ^ (((sb >> 9) & 1) << 5); R = (st >> 1) * 16 + swz / 64; C = (st & 1) * 32 + (swz % 64) / 2; }
DI int perm32(int rho) { const int n = rho >> 4, i = rho & 15; return 8 * (i >> 2) + 4 * n + (i & 3); }
struct Unit { int pm, pn, eb; };

struct DenseSched {
    int nM, nN, nwg, G, c; const char* Bt; int ldb;
    DI void init(int M, int N, int ldb_bytes, const void* Bt_, int G_, int c_) { nM = M / BM; nN = N / BM; nwg = nM * nN; G = G_; c = c_; Bt = (const char*)Bt_; ldb = ldb_bytes; }
    DI bool next(int i, Unit& u) const {
        const long L = (long)i * G + c; if (L >= nwg) return false;
        int wgid = (int)L; { const int q = nwg / NXCD, r = nwg % NXCD, xcd = wgid % NXCD, off = wgid / NXCD; wgid = (xcd < r ? xcd * (q + 1) : r * (q + 1) + (xcd - r) * q) + off; }
        const int nig = WGM * nN, gid = wgid / nig, fm = gid * WGM, gsz = (nM - fm) < WGM ? (nM - fm) : WGM;
        u.pm = fm + ((wgid % nig) % gsz); u.pn = (wgid % nig) / gsz; u.eb = 0; return true;
    }
    DI unsigned a_row(const Unit& u, int r) const { return (unsigned)(u.pm * BM + r); }
    DI const char* b_base(const Unit& u) const { return Bt + (size_t)u.pn * BM * ldb; }
};
template <bool GATHER> struct MoeSched {
    int G, c, ldb; const char* Bt; size_t estride; const int* tile_e; const int* slot_tok; int nunits;
    DI bool next(int i, Unit& u) const {
        const int L = i * G + c; if (L >= nunits) return false;
        u.pm = L >> 2; u.pn = L & 3; u.eb = __builtin_amdgcn_readfirstlane(__hip_atomic_load(tile_e + u.pm, __ATOMIC_RELAXED, __HIP_MEMORY_SCOPE_AGENT)); return true;
    }
    DI unsigned a_row(const Unit& u, int r) const { if (GATHER) return (unsigned)__hip_atomic_load(slot_tok + u.pm * BM + r, __ATOMIC_RELAXED, __HIP_MEMORY_SCOPE_AGENT); return (unsigned)(u.pm * BM + r); }
    DI const char* b_base(const Unit& u) const { return Bt + (size_t)u.eb * estride + (size_t)u.pn * BM * ldb; }
};

struct EpiProj {
    static constexpr bool PERM = true;
    bf16* O; int ldc; int period, qcols; float qscale, base;
    DI void operator()(const f32x4 (&acc)[2][2][4][2], const Unit& u, int wr, int wc, int fr, int fq) const {
        const int row0 = u.pm * BM + wr * 64 + fr, colt = u.pn * BM;
        const float sc = base * (((colt % period) < qcols) ? qscale : 1.f);
        const int col0 = colt + wc * 32 + 8 * fq;
#pragma unroll
        for (int ai = 0; ai < 2; ++ai)
#pragma unroll
            for (int m = 0; m < 4; ++m) { bf16* rowp = O + (size_t)(row0 + ai * HALF + m * 16) * ldc + col0;
#pragma unroll
                for (int bj = 0; bj < 2; ++bj) { const f32x4 v0 = acc[ai][bj][m][0] * sc, v1 = acc[ai][bj][m][1] * sc;
                    u32x4 w; w.x = pk2(v0[0], v0[1]); w.y = pk2(v0[2], v0[3]); w.z = pk2(v1[0], v1[1]); w.w = pk2(v1[2], v1[3]);
                    *(u32x4*)(rowp + bj * HALF) = w; } }
    }
};
constexpr float MOE_S_W1 = 32.f, MOE_S_ACT = 8.f, MOE_S_W2 = 16.f;
struct EpiMoe1 {
    static constexpr bool PERM = true;
    unsigned char* O;
    DI void operator()(const f32x4 (&acc)[2][2][4][2], const Unit& u, int wr, int wc, int fr, int fq) const {
        const int row0 = u.pm * BM + wr * 64 + fr, col0 = u.pn * 128 + wc * 32 + 8 * fq;
#pragma unroll
        for (int ai = 0; ai < 2; ++ai)
#pragma unroll
            for (int m = 0; m < 4; ++m) { unsigned char* rowp = O + (size_t)(row0 + ai * HALF + m * 16) * MOE_FF + col0;
                float r[8];
#pragma unroll
                for (int n = 0; n < 2; ++n)
#pragma unroll
                    for (int e = 0; e < 4; ++e) { const float g = acc[ai][0][m][n][e] * (1.f / MOE_S_W1), up = acc[ai][1][m][n][e] * (MOE_S_ACT / MOE_S_W1);
                        r[n * 4 + e] = g * __builtin_amdgcn_rcpf(1.f + fexp2(-g * LOG2E)) * up; }
                u32x2 w; w.x = pk4_fp8(r[0], r[1], r[2], r[3]); w.y = pk4_fp8(r[4], r[5], r[6], r[7]);
                *(u32x2*)rowp = w; }
    }
};
constexpr float MOE_S_Y = 16.f;
struct EpiY8 {
    static constexpr bool PERM = true;
    unsigned char* O; float s;
    DI void operator()(const f32x4 (&acc)[2][2][4][2], const Unit& u, int wr, int wc, int fr, int fq) const {
        const int row0 = u.pm * BM + wr * 64 + fr, col0 = u.pn * BM + wc * 32 + 8 * fq;
#pragma unroll
        for (int ai = 0; ai < 2; ++ai)
#pragma unroll
            for (int m = 0; m < 4; ++m) { unsigned char* rowp = O + (size_t)(row0 + ai * HALF + m * 16) * D + col0;
#pragma unroll
                for (int bj = 0; bj < 2; ++bj) { const f32x4 v0 = acc[ai][bj][m][0] * s, v1 = acc[ai][bj][m][1] * s;
                    u32x2 w; w.x = pk4_fp8(v0[0], v0[1], v0[2], v0[3]); w.y = pk4_fp8(v1[0], v1[1], v1[2], v1[3]);
                    *(u32x2*)(rowp + bj * HALF) = w; } }
    }
};
template <bool RF32> struct EpiResid {
    static constexpr bool PERM = true;
    const void* resid; bf16* out; const float* gate; float gscale; float* ssp;
    DI void finish(const f32x4 (&a)[2][4][2], const f32x4 (&g)[2][2], const f32x4 (&r)[2][2], size_t off, int row, int pn, int wc, int fq, const int m) const {
        float sq = 0.f;
#pragma unroll
        for (int bj = 0; bj < 2; ++bj) { const f32x4 v0 = r[bj][0] + g[bj][0] * a[bj][m][0], v1 = r[bj][1] + g[bj][1] * a[bj][m][1];
            u32x4 o; o.x = pk2(v0[0], v0[1]); o.y = pk2(v0[2], v0[3]); o.z = pk2(v1[0], v1[1]); o.w = pk2(v1[2], v1[3]);
            *(u32x4*)(out + off + bj * HALF) = o;
#pragma unroll
            for (int e = 0; e < 4; ++e) { const float x0 = bflo(o[e]), x1 = bfhi(o[e]); sq += x0 * x0 + x1 * x1; } }
        sq += __shfl_xor(sq, 16); sq += __shfl_xor(sq, 32);
        if (fq == 0) ssp[(size_t)row * 16 + pn * 4 + wc] = sq;
    }
    DI void operator()(const f32x4 (&acc)[2][2][4][2], const Unit& u, int wr, int wc, int fr, int fq) const {
        const int row0 = u.pm * BM + wr * 64 + fr, col0 = u.pn * BM + wc * 32 + 8 * fq;
        const float* gv = gate + (size_t)((u.pm * BM) / SEQ) * 6144 + col0;
        f32x4 g[2][2];
#pragma unroll
        for (int bj = 0; bj < 2; ++bj)
#pragma unroll
            for (int n = 0; n < 2; ++n) g[bj][n] = *(const f32x4*)(gv + bj * HALF + 4 * n) * gscale;
        if (RF32) {
#pragma unroll
            for (int ai = 0; ai < 2; ++ai)
#pragma unroll
                for (int mp = 0; mp < 4; mp += 2) {
                    f32x4 rr[2][2][2];
#pragma unroll
                    for (int m = 0; m < 2; ++m)
#pragma unroll
                        for (int bj = 0; bj < 2; ++bj) { const float* p = (const float*)resid + (size_t)(row0 + ai * HALF + (mp + m) * 16) * D + col0 + bj * HALF; rr[m][bj][0] = *(const f32x4*)p; rr[m][bj][1] = *(const f32x4*)(p + 4); }
#pragma unroll
                    for (int m = 0; m < 2; ++m) { const int row = row0 + ai * HALF + (mp + m) * 16; finish(acc[ai], g, rr[m], (size_t)row * D + col0, row, u.pn, wc, fq, mp + m); }
                    asm volatile("" ::: "memory");
                }
        } else {
#pragma unroll
            for (int ai = 0; ai < 2; ++ai) {
                u32x4 rw[4][2];
#pragma unroll
                for (int m = 0; m < 4; ++m)
#pragma unroll
                    for (int bj = 0; bj < 2; ++bj) rw[m][bj] = *(const u32x4*)((const bf16*)resid + (size_t)(row0 + ai * HALF + m * 16) * D + col0 + bj * HALF);
#pragma unroll
                for (int m = 0; m < 4; ++m) { const int row = row0 + ai * HALF + m * 16; f32x4 rr[2][2];
#pragma unroll
                    for (int bj = 0; bj < 2; ++bj) { const u32x4 w = rw[m][bj]; rr[bj][0] = (f32x4){bflo(w.x), bfhi(w.x), bflo(w.y), bfhi(w.y)}; rr[bj][1] = (f32x4){bflo(w.z), bfhi(w.z), bflo(w.w), bfhi(w.w)}; }
                    finish(acc[ai], g, rr, (size_t)row * D + col0, row, u.pn, wc, fq, m); }
                asm volatile("" ::: "memory");
            }
        }
    }
};

template <class Epi, class Sched, bool ALIGN_EPI, bool FP8 = false>
DI void gemm_phase(const int tid, LAS unsigned char* lds, const char* gA, const int lda  , const int nt, const Sched& S, const Epi& E) {
    const int wid = __builtin_amdgcn_readfirstlane(tid >> 6), lane = tid & 63, wr = wid >> 2, wc = wid & 3, fr = lane & 15, fq = lane >> 4;
    int Rr[2], Cc[2]; unsigned voffB[2];
#pragma unroll
    for (int i = 0; i < 2; ++i) { stage_rc(tid * 16 + i * 8192, Rr[i], Cc[i]); const int Rb = Epi::PERM ? ((Rr[i] & ~31) + perm32(Rr[i] & 31)) : Rr[i];
        voffB[i] = (unsigned)(Rb * S.ldb + Cc[i] * 2); }
    const size_t kstep = (size_t)(BK * 2);
    const size_t hstepB = (size_t)HALF * S.ldb;
    const unsigned ldsw = (unsigned)wid * 1024u;
    const int aoff = lds_byte(wr * 64 + fr, fq * 8), boff = lds_byte(wc * 32 + fr, fq * 8);
#define PG8_SA(b, h) (((b) * 2 + (h)) * HTB)
#define PG8_SB(b, h) ((4 + (b) * 2 + (h)) * HTB)
#define PG8_STAGEB(bufoff, gbase) do { _Pragma("unroll") for (int _i = 0; _i < 2; ++_i) \
        __builtin_amdgcn_global_load_lds((const unsigned*)((const char*)(gbase) + voffB[_i]), (LAS unsigned*)(lds + (bufoff) + ldsw + _i * 8192), 16, 0, 0); } while (0)
#define PG8_STAGEA(bufoff, gbase, o0, o1) do { \
        __builtin_amdgcn_global_load_lds((const unsigned*)((const char*)(gbase) + (o0)), (LAS unsigned*)(lds + (bufoff) + ldsw), 16, 0, 0); \
        __builtin_amdgcn_global_load_lds((const unsigned*)((const char*)(gbase) + (o1)), (LAS unsigned*)(lds + (bufoff) + ldsw + 8192), 16, 0, 0); } while (0)
#define PG8_LD8(off) __builtin_shufflevector(*(const LAS i32x4*)(lds + (off)), *(const LAS i32x4*)(lds + (off) + 1024), 0, 1, 2, 3, 4, 5, 6, 7)
#define PG8_LDA(dst, b, h) do { if constexpr (FP8) { _Pragma("unroll") for (int m = 0; m < 4; ++m) dst##8[m] = PG8_LD8(PG8_SA(b, h) + aoff + m * 2048); } \
        else { _Pragma("unroll") for (int m = 0; m < 4; ++m) _Pragma("unroll") for (int k = 0; k < 2; ++k) dst[m][k] = *(const LAS bf16x8*)(lds + PG8_SA(b, h) + aoff + m * 2048 + k * 1024); } } while (0)
#define PG8_LDB(dst, b, h) do { if constexpr (FP8) { _Pragma("unroll") for (int n = 0; n < 2; ++n) dst##8[n] = PG8_LD8(PG8_SB(b, h) + boff + n * 2048); } \
        else { _Pragma("unroll") for (int n = 0; n < 2; ++n) _Pragma("unroll") for (int k = 0; k < 2; ++k) dst[n][k] = *(const LAS bf16x8*)(lds + PG8_SB(b, h) + boff + n * 2048 + k * 1024); } } while (0)
#define PG8_MMA(ai, bj, At, Bt) do { __builtin_amdgcn_s_setprio(1); \
        if constexpr (FP8) { _Pragma("unroll") for (int m = 0; m < 4; ++m) _Pragma("unroll") for (int n = 0; n < 2; ++n) \
            acc[ai][bj][m][n] = __builtin_amdgcn_mfma_scale_f32_16x16x128_f8f6f4(Bt##8[n], At##8[m], acc[ai][bj][m][n], 0, 0, 0, 0x7f7f7f7f, 0, 0x7f7f7f7f); } \
        else { _Pragma("unroll") for (int m = 0; m < 4; ++m) _Pragma("unroll") for (int n = 0; n < 2; ++n) _Pragma("unroll") for (int k = 0; k < 2; ++k) \
            acc[ai][bj][m][n] = __builtin_amdgcn_mfma_f32_16x16x32_bf16(Bt[n][k], At[m][k], acc[ai][bj][m][n], 0, 0, 0); } \
        __builtin_amdgcn_s_setprio(0); } while (0)
#define PG8_WAIT_V(n) asm volatile("s_waitcnt vmcnt(" #n ")" ::: "memory")
#define PG8_WAIT_L(n) asm volatile("s_waitcnt lgkmcnt(" #n ")" ::: "memory")
#define PG8_BAR __builtin_amdgcn_s_barrier()
#define PG8_SCHED __builtin_amdgcn_sched_barrier(0)
    Unit cur, nxt; int ui = 0;
    if (!S.next(0, cur)) return;
    f32x4 acc[2][2][4][2];
#pragma unroll
    for (int a = 0; a < 2; ++a)
#pragma unroll
        for (int b = 0; b < 2; ++b)
#pragma unroll
            for (int m = 0; m < 4; ++m)
#pragma unroll
                for (int n = 0; n < 2; ++n) acc[a][b][m][n] = (f32x4){0.f, 0.f, 0.f, 0.f};
    bf16x8 At[4][2], B0[2][2], B1[2][2]; i32x8 At8[4], B08[2], B18[2];
    unsigned vA[2][2], vN[2][2];
#pragma unroll
    for (int h = 0; h < 2; ++h)
#pragma unroll
        for (int i = 0; i < 2; ++i) vA[h][i] = S.a_row(cur, h * HALF + Rr[i]) * (unsigned)lda + (unsigned)Cc[i] * 2u;
    const char* cB = S.b_base(cur);
    PG8_STAGEB(PG8_SB(0, 0), cB); PG8_STAGEB(PG8_SB(0, 1), cB + hstepB); PG8_STAGEA(PG8_SA(0, 0), gA, vA[0][0], vA[0][1]); PG8_STAGEA(PG8_SA(0, 1), gA, vA[1][0], vA[1][1]);
    if (wr == 1) PG8_BAR;
    PG8_WAIT_V(2); PG8_BAR;
    PG8_STAGEB(PG8_SB(1, 0), cB + kstep); PG8_STAGEA(PG8_SA(1, 0), gA + kstep, vA[0][0], vA[0][1]); PG8_STAGEB(PG8_SB(1, 1), cB + hstepB + kstep);
    PG8_WAIT_V(6); PG8_BAR;
    for (;;) {
        const bool has_next = S.next(ui + 1, nxt);
        const char* nB = has_next ? S.b_base(nxt) : cB;
#pragma unroll
        for (int h = 0; h < 2; ++h)
#pragma unroll
            for (int i = 0; i < 2; ++i) vN[h][i] = has_next ? S.a_row(nxt, h * HALF + Rr[i]) * (unsigned)lda + (unsigned)Cc[i] * 2u : vA[h][i];
#pragma unroll 1
        for (int t = 0; t < nt; t += 2) {
            const bool last = (t == nt - 2);
            const char* a1 = gA + (size_t)(t + 1) * kstep;
            const char* a2 = gA + (last ? (size_t)0 : (size_t)(t + 2) * kstep); const char* b2 = last ? nB : cB + (size_t)(t + 2) * kstep;
            const char* a3 = a2 + kstep; const char* b3 = b2 + kstep;
            PG8_LDB(B0, 0, 0); PG8_LDB(B1, 0, 1); PG8_SCHED; PG8_LDA(At, 0, 0); PG8_STAGEA(PG8_SA(1, 1), a1, vA[1][0], vA[1][1]);
            if (last) {
#pragma unroll
                for (int h = 0; h < 2; ++h)
#pragma unroll
                    for (int i = 0; i < 2; ++i) vA[h][i] = vN[h][i]; }
            PG8_WAIT_V(8); PG8_WAIT_L(0); PG8_BAR; PG8_MMA(0, 0, At, B0); PG8_MMA(0, 1, At, B1); PG8_BAR; PG8_SCHED;
            PG8_LDA(At, 0, 1); PG8_STAGEB(PG8_SB(0, 0), b2); PG8_STAGEB(PG8_SB(0, 1), b2 + hstepB); PG8_STAGEA(PG8_SA(0, 0), a2, vA[0][0], vA[0][1]);
            PG8_WAIT_V(8); PG8_WAIT_L(0); PG8_BAR; PG8_MMA(1, 0, At, B0); PG8_MMA(1, 1, At, B1); PG8_BAR; PG8_SCHED;
            PG8_LDB(B0, 1, 0); PG8_LDB(B1, 1, 1); PG8_SCHED; PG8_LDA(At, 1, 0); PG8_STAGEA(PG8_SA(0, 1), a2, vA[1][0], vA[1][1]);
            PG8_WAIT_V(8); PG8_WAIT_L(0); PG8_BAR; PG8_MMA(0, 0, At, B0); PG8_MMA(0, 1, At, B1); PG8_BAR; PG8_SCHED;
            PG8_LDA(At, 1, 1); PG8_STAGEB(PG8_SB(1, 0), b3); PG8_STAGEB(PG8_SB(1, 1), b3 + hstepB); PG8_STAGEA(PG8_SA(1, 0), a3, vA[0][0], vA[0][1]);
            PG8_WAIT_V(8); PG8_WAIT_L(0); PG8_BAR; PG8_MMA(1, 0, At, B0); PG8_MMA(1, 1, At, B1); PG8_BAR; PG8_SCHED;
        }
        if constexpr (ALIGN_EPI) { if (wr == 0) PG8_BAR; }
        E(acc, cur, wr, wc, fr, fq);
        if (!has_next) break;
#pragma unroll
        for (int a = 0; a < 2; ++a)
#pragma unroll
            for (int b = 0; b < 2; ++b)
#pragma unroll
                for (int m = 0; m < 4; ++m)
#pragma unroll
                    for (int n = 0; n < 2; ++n) acc[a][b][m][n] = (f32x4){0.f, 0.f, 0.f, 0.f};
        cur = nxt; cB = nB; ++ui;
        if constexpr (ALIGN_EPI) { if (wr == 1) PG8_BAR; }
    }
    PG8_WAIT_V(0);
    if constexpr (!ALIGN_EPI) { if (wr == 0) PG8_BAR; }
    PG8_BAR;
#undef PG8_SA
#undef PG8_SB
#undef PG8_STAGEA
#undef PG8_STAGEB
#undef PG8_LDA
#undef PG8_LDB
#undef PG8_MMA
#undef PG8_LD8
#undef PG8_WAIT_V
#undef PG8_WAIT_L
#undef PG8_BAR
#undef PG8_SCHED
}
}

struct Params {
    const float* in[26];
    float* out; unsigned char* ws;
    int ph_lo, ph_hi;
};
enum { I_X = 0, I_C, I_ADAW, I_ADAB, I_NORMG, I_FINALG, I_SBWIN, I_SBWOUT, I_GLAWIN, I_GLAGU, I_GLABG, I_GLANG, I_GLAWOUT, I_CONVWIN, I_CONVW, I_CONVB, I_CONVWOUT,
       I_DILWIN, I_DILWOUT, I_MGRPW, I_MGRPB, I_MEXPW, I_MEXPB, I_MWG, I_MWU, I_MWD };
struct ParamsG { const GAS float* in[26]; GAS float* out; GAS unsigned char* ws; int ph_lo, ph_hi; };
static_assert(sizeof(ParamsG) == sizeof(Params), "ParamsG mirrors Params");
typedef __attribute__((address_space(4))) ParamsG KParams;
#define PIN(i) ((const float*)P.in[(i)])
struct Ctx {
    LAS unsigned char* lds; volatile LAS unsigned* MISC;
    int tid, lane, wave, G, bid;
    const KParams* p; unsigned char* ws;
};

DI void transpose_item(const float* W, int ldw  , int k0, int n0, bf16* WT, size_t drow0, int ldk  , LAS float* scr, int lane) {
    float tv[32];
#pragma unroll
    for (int i = 0; i < 32; ++i) tv[i] = __builtin_nontemporal_load(W + (size_t)(k0 + 2 * i + (lane >> 5)) * ldw + n0 + (lane & 31));
#pragma unroll
    for (int i = 0; i < 32; ++i) scr[(2 * i + (lane >> 5)) * 33 + (lane & 31)] = tv[i];
    LDS_WAIT();
    const int c = lane & 7;
#pragma unroll
    for (int j = 0; j < 4; ++j) { const int n = (lane >> 3) + 8 * j; const LAS float* s = scr + (8 * c) * 33 + n;
        u32x4 o; o.x = pk2(s[0 * 33], s[1 * 33]); o.y = pk2(s[2 * 33], s[3 * 33]); o.z = pk2(s[4 * 33], s[5 * 33]); o.w = pk2(s[6 * 33], s[7 * 33]);
        *(u32x4*)(WT + (drow0 + n) * (size_t)ldk + k0 + 8 * c) = o; }
    LDS_WAIT();
}
DI void transpose_matrix_fp8(Ctx& F, const float* W, int K, int N, int ldw, unsigned char* WT, float scale, int gw, int NGW);
DI void transpose_matrix(Ctx& F, const float* W, int K, int N, int ldw, int ncol0, bf16* WT, int gw, int NGW) {
    LAS float* scr = (LAS float*)(F.lds + F.wave * 16384);
    const int nblk = N / 32, nitems = (K / 64) * nblk;
    for (int it = gw; it < nitems; it += NGW) { const int kb = it / nblk, nb = it % nblk;
        transpose_item(W, ldw, 64 * kb, ncol0 + 32 * nb, WT, (size_t)(32 * nb), K, scr, F.lane); }
}

DI void ph_prologue(Ctx& F) {
    const KParams& P = *F.p; unsigned char* ws = F.ws;
    const int gw = F.bid * NWAVES + F.wave, NGW = F.G * NWAVES;
    if (in_fp8(0)) transpose_matrix_fp8(F, PIN(I_SBWIN), D, 3072, 3072, ws + W_SBIN, pg8::MOE_S_W1, gw, NGW); else transpose_matrix(F, PIN(I_SBWIN), D, 3072, 3072, 0, (bf16*)(ws + W_SBIN), gw, NGW);
    if (out_fp8(0)) transpose_matrix_fp8(F, PIN(I_SBWOUT), D, D, D, ws + W_SBOUT, pg8::MOE_S_W1, gw, NGW); else transpose_matrix(F, PIN(I_SBWOUT), D, D, D, 0, (bf16*)(ws + W_SBOUT), gw, NGW);
    if (in_fp8(1)) transpose_matrix_fp8(F, PIN(I_GLAWIN), D, 3072, 3088, ws + W_GLAIN, pg8::MOE_S_W1, gw, NGW); else transpose_matrix(F, PIN(I_GLAWIN), D, 3072, 3088, 0, (bf16*)(ws + W_GLAIN), gw, NGW);
    if (out_fp8(1)) transpose_matrix_fp8(F, PIN(I_GLAWOUT), D, D, D, ws + W_GLAOUT, pg8::MOE_S_W1, gw, NGW); else transpose_matrix(F, PIN(I_GLAWOUT), D, D, D, 0, (bf16*)(ws + W_GLAOUT), gw, NGW);
    if (in_fp8(2)) transpose_matrix_fp8(F, PIN(I_CONVWIN), D, 3072, 3072, ws + W_CONVIN, pg8::MOE_S_W1, gw, NGW); else transpose_matrix(F, PIN(I_CONVWIN), D, 3072, 3072, 0, (bf16*)(ws + W_CONVIN), gw, NGW);
    if (out_fp8(2)) transpose_matrix_fp8(F, PIN(I_CONVWOUT), D, D, D, ws + W_CONVOUT, pg8::MOE_S_W1, gw, NGW); else transpose_matrix(F, PIN(I_CONVWOUT), D, D, D, 0, (bf16*)(ws + W_CONVOUT), gw, NGW);
    if (in_fp8(3)) transpose_matrix_fp8(F, PIN(I_DILWIN), D, 4608, 4608, ws + W_DILIN, pg8::MOE_S_W1, gw, NGW); else transpose_matrix(F, PIN(I_DILWIN), D, 4608, 4608, 0, (bf16*)(ws + W_DILIN), gw, NGW);
    if (out_fp8(3)) transpose_matrix_fp8(F, PIN(I_DILWOUT), 512, D, D, ws + W_DILOUT, pg8::MOE_S_W1, gw, NGW); else transpose_matrix(F, PIN(I_DILWOUT), 512, D, D, 0, (bf16*)(ws + W_DILOUT), gw, NGW);
    const float* c = PIN(I_C); const float* aw = PIN(I_ADAW); float* modp = (float*)(ws + WS_MODP);
    LAS float* scond = (LAS float*)(F.lds + 126976);
    for (int i = F.tid; i < NB * D; i += NTHR) { const float cv = c[i]; scond[i] = cv / (1.f + __expf(-cv)); }
    __syncthreads();
    for (int it = gw; it < DEPTH * 96 * KSPLIT; it += NGW) {
        const int ks = it % KSPLIT, jb = (it / KSPLIT) % 96, l = it / (KSPLIT * 96);
        const int j = jb * 64 + F.lane; const int k0 = ks * (D / KSPLIT);
        float a[NB];
#pragma unroll
        for (int b = 0; b < NB; ++b) a[b] = 0.f;
        const float* wp = aw + ((size_t)l * D + k0) * 6144 + j;
#pragma unroll 16
        for (int k = 0; k < D / KSPLIT; ++k) { const float w = __builtin_nontemporal_load(wp + (size_t)k * 6144);
#pragma unroll
            for (int b = 0; b < NB; ++b) a[b] += scond[b * D + k0 + k] * w; }
#pragma unroll
        for (int b = 0; b < NB; ++b) modp[(((size_t)ks * DEPTH + l) * NB + b) * 6144 + j] = a[b];
    }
}
DI float mod_sum(const float* modp, const float* adab, int l, int b, int j) {
    float s = adab[l * 6144 + j];
#pragma unroll
    for (int ks = 0; ks < KSPLIT; ++ks) s += modp[(((size_t)ks * DEPTH + l) * NB + b) * 6144 + j];
    return s;
}

DI void mod_vec(const float* modp, const float* adab, int l, int b, int chunk, int lane, f32x4 (&out)[4]) {
#pragma unroll
    for (int j = 0; j < 4; ++j) out[j] = *(const f32x4*)(adab + l * 6144 + chunk * D + 4 * lane + 256 * j);
#pragma unroll 1
    for (int ks = 0; ks < KSPLIT; ++ks) { const float* p = modp + (((size_t)ks * DEPTH + l) * NB + b) * 6144 + chunk * D + 4 * lane;
#pragma unroll
        for (int j = 0; j < 4; ++j) out[j] = out[j] + *(const f32x4*)(p + 256 * j); }
}
DI void mod_vec_f(const float* modf, int l, int b, int chunk, int lane, f32x4 (&out)[4]) {
    const float* p = modf + ((size_t)l * NB + b) * 6144 + chunk * D + 4 * lane;
#pragma unroll
    for (int j = 0; j < 4; ++j) out[j] = *(const f32x4*)(p + 256 * j);
}
DI void row_load(const float* row, int lane, f32x4 (&v)[4]) {
#pragma unroll
    for (int j = 0; j < 4; ++j) v[j] = *(const f32x4*)(row + 4 * lane + 256 * j);
}
DI void row_load_bf16(const bf16* row, int lane, f32x4 (&v)[4]) {
#pragma unroll
    for (int j = 0; j < 4; ++j) { const u32x2 w = *(const u32x2*)(row + 4 * lane + 256 * j); v[j] = (f32x4){bflo(w.x), bfhi(w.x), bflo(w.y), bfhi(w.y)}; }
}
DI void row_store_bf16(bf16* row, int lane, const f32x4 (&v)[4]) {
#pragma unroll
    for (int j = 0; j < 4; ++j) { u32x2 w; w.x = pk2(v[j][0], v[j][1]); w.y = pk2(v[j][2], v[j][3]); *(u32x2*)(row + 4 * lane + 256 * j) = w; }
}
DI float row_rstd(const f32x4 (&v)[4]) {
    float s = 0.f;
#pragma unroll
    for (int j = 0; j < 4; ++j) s += (v[j][0] * v[j][0] + v[j][1] * v[j][1]) + (v[j][2] * v[j][2] + v[j][3] * v[j][3]);
    return 1.f / sqrtf(wave_sum(s) * (1.f / D) + RMS_EPS);
}
DI void moe_combine_row(Ctx& F, int row, const f32x4 (&g2)[4], f32x4 (&v)[4]) {
    unsigned char* ws = F.ws;
    const int* ts = (const int*)(ws + WS_TOKS); const float* tw = (const float*)(ws + WS_TOKW); const bf16* yb = (const bf16*)(ws + WS_YB);
    const int s0 = __hip_atomic_load(ts + row * 2, __ATOMIC_RELAXED, __HIP_MEMORY_SCOPE_AGENT), s1 = __hip_atomic_load(ts + row * 2 + 1, __ATOMIC_RELAXED, __HIP_MEMORY_SCOPE_AGENT);
    const float w0 = __hip_atomic_load(tw + row * 2, __ATOMIC_RELAXED, __HIP_MEMORY_SCOPE_AGENT), w1 = __hip_atomic_load(tw + row * 2 + 1, __ATOMIC_RELAXED, __HIP_MEMORY_SCOPE_AGENT);
#pragma unroll
    for (int j = 0; j < 4; ++j) { const u32x2 a = *(const u32x2*)(yb + (size_t)s0 * D + 4 * F.lane + 256 * j), b = *(const u32x2*)(yb + (size_t)s1 * D + 4 * F.lane + 256 * j);
        f32x4 y; y[0] = w0 * bflo(a.x) + w1 * bflo(b.x); y[1] = w0 * bfhi(a.x) + w1 * bfhi(b.x); y[2] = w0 * bflo(a.y) + w1 * bflo(b.y); y[3] = w0 * bfhi(a.y) + w1 * bfhi(b.y);
        v[j] = v[j] + g2[j] * y; }
}
struct RowIn { f32x4 x[4]; unsigned ya[4], yb[4]; };
template <bool COMB, bool XF32> DI void rowin_load(RowIn& R, const void* xrow, const unsigned char* ybase, int s0, int s1, int lane) {
#pragma unroll
    for (int j = 0; j < 4; ++j) { if (XF32) R.x[j] = *(const f32x4*)((const float*)xrow + 4 * lane + 256 * j);
        else { const u32x2 w = *(const u32x2*)((const bf16*)xrow + 4 * lane + 256 * j); R.x[j] = (f32x4){bflo(w.x), bfhi(w.x), bflo(w.y), bfhi(w.y)}; } }
    if (COMB) {
#pragma unroll
        for (int j = 0; j < 4; ++j) { R.ya[j] = *(const unsigned*)(ybase + (size_t)s0 * D + 4 * lane + 256 * j); R.yb[j] = *(const unsigned*)(ybase + (size_t)s1 * D + 4 * lane + 256 * j); }
    }
}
DI void rowin_combine(const RowIn& R, float w0, float w1, const f32x4 (&g2)[4], f32x4 (&v)[4]) {
#pragma unroll
    for (int j = 0; j < 4; ++j) { const int a = (int)R.ya[j], b = (int)R.yb[j];
        const f32x2 a01 = __builtin_amdgcn_cvt_pk_f32_fp8(a, false), a23 = __builtin_amdgcn_cvt_pk_f32_fp8(a, true), b01 = __builtin_amdgcn_cvt_pk_f32_fp8(b, false), b23 = __builtin_amdgcn_cvt_pk_f32_fp8(b, true);
        f32x4 y; y[0] = w0 * a01[0] + w1 * b01[0]; y[1] = w0 * a01[1] + w1 * b01[1]; y[2] = w0 * a23[0] + w1 * b23[0]; y[3] = w0 * a23[1] + w1 * b23[1];
        v[j] = R.x[j] + g2[j] * y; }
}
DI int rdlane_i(int v, int l) { return __builtin_amdgcn_readlane(v, l); }
DI void transpose_item_fp8(const float* W, int ldw, int k0, int n0, unsigned char* WT, size_t drow0, int ldk  , float scale, LAS float* scr, int lane) {
    float tv[32];
#pragma unroll
    for (int i = 0; i < 32; ++i) tv[i] = __builtin_nontemporal_load(W + (size_t)(k0 + 2 * i + (lane >> 5)) * ldw + n0 + (lane & 31));
#pragma unroll
    for (int i = 0; i < 32; ++i) scr[(2 * i + (lane >> 5)) * 33 + (lane & 31)] = tv[i] * scale;
    LDS_WAIT();
    const int n = lane >> 1, half = lane & 1; const LAS float* sp = scr + (32 * half) * 33 + n;
    u32x4 o0, o1;
#pragma unroll
    for (int q = 0; q < 4; ++q) { o0[q] = pk4_fp8(sp[(4 * q) * 33], sp[(4 * q + 1) * 33], sp[(4 * q + 2) * 33], sp[(4 * q + 3) * 33]);
        o1[q] = pk4_fp8(sp[(16 + 4 * q) * 33], sp[(16 + 4 * q + 1) * 33], sp[(16 + 4 * q + 2) * 33], sp[(16 + 4 * q + 3) * 33]); }
    unsigned char* dst = WT + (drow0 + n) * (size_t)ldk + k0 + 32 * half;
    *(u32x4*)dst = o0; *(u32x4*)(dst + 16) = o1;
    LDS_WAIT();
}
DI void transpose_matrix_fp8(Ctx& F, const float* W, int K, int N, int ldw, unsigned char* WT, float scale, int gw, int NGW) {
    LAS float* scr = (LAS float*)(F.lds + F.wave * 16384);
    const int nblk = N / 32, nitems = (K / 64) * nblk;
    for (int it = gw; it < nitems; it += NGW) { const int kb = it / nblk, nb = it % nblk;
        transpose_item_fp8(W, ldw, 64 * kb, 32 * nb, WT, (size_t)(32 * nb), K, scale, scr, F.lane); }
}
DI void moe_weight_convert(Ctx& F, int l, int gw, int NGW) {
    const KParams& P = *F.p; unsigned char* ws = F.ws;
    LAS float* scr = (LAS float*)(F.lds + F.wave * 16384);
    unsigned char* W1T = ws + WS_W1T; unsigned char* W2T = ws + WS_W2T;
    const int per_e = 256, n1 = MOE_E * 2 * per_e;
    for (int it = gw; it < n1; it += NGW) { const int e = it / (2 * per_e), r = it % (2 * per_e), half = r / per_e, q = r % per_e, kb = q / 16, nb = q % 16;
        const float* W = (half ? PIN(I_MWU) : PIN(I_MWG)) + ((size_t)l * MOE_E + e) * D * MOE_FF;
        const int n0 = 32 * nb; const size_t drow0 = (size_t)e * 1024 + (size_t)(n0 / 128) * 256 + half * 128 + (n0 % 128);
        transpose_item_fp8(W, MOE_FF, 64 * kb, n0, W1T, drow0, D, pg8::MOE_S_W1, scr, F.lane); }
    for (int it = gw; it < MOE_E * per_e; it += NGW) { const int e = it / per_e, q = it % per_e, kb = q / 32, nb = q % 32;
        const float* W = PIN(I_MWD) + ((size_t)l * MOE_E + e) * MOE_FF * D;
        transpose_item_fp8(W, D, 64 * kb, 32 * nb, W2T, (size_t)e * 1024 + 32 * nb, MOE_FF, pg8::MOE_S_W2, scr, F.lane); }
}

DI void ph_norm1(Ctx& F, int l) {
    const KParams& P = *F.p; unsigned char* ws = F.ws;
    const int gw = F.bid * NWAVES + F.wave, NGW = F.G * NWAVES;
    const float* modp = (const float*)(ws + WS_MODP); float* modf = (float*)(ws + WS_MODF);
    if (l == 0) {
        for (int i = F.bid * NTHR + F.tid; i < DEPTH * NB * 6144; i += F.G * NTHR) { const int j = i % 6144, b = (i / 6144) % NB, ll = i / (6144 * NB); modf[i] = mod_sum(modp, PIN(I_ADAB), ll, b, j); }
    }
    const bool gla = (l == 1);
    LAS float* wgd = (LAS float*)F.lds;
    if (gla) { const float* w = PIN(I_GLAWIN);
        for (int idx = F.tid; idx < 16 * D; idx += NTHR) { const int c = idx & (D - 1), o = idx >> 10; wgd[idx] = w[(size_t)c * 3088 + 3072 + o]; }
        __syncthreads(); }
    const float* xin0 = PIN(I_X); bf16* XB = (bf16*)(ws + WS_XB);
    unsigned char* HO8 = ws + WS_HO; float* gdn = (float*)(ws + WS_GDOWN);
    const float* ng = PIN(I_NORMG) + (size_t)(l * 2 + 0) * D;
    for (int blk = gw; blk < T / 32; blk += NGW) {
        const int row0 = blk * 32, b = row0 / SEQ;
        f32x4 gm[4], sh[4], g2[4];
        if (l == 0) { mod_vec(modp, PIN(I_ADAB), l, b, 0, F.lane, sh); mod_vec(modp, PIN(I_ADAB), l, b, 1, F.lane, gm); }
        else { mod_vec_f(modf, l, b, 0, F.lane, sh); mod_vec_f(modf, l, b, 1, F.lane, gm); }
#pragma unroll
        for (int j = 0; j < 4; ++j) gm[j] = *(const f32x4*)(ng + 4 * F.lane + 256 * j) * (gm[j] + 1.f);
        if (l > 0) mod_vec_f(modf, l - 1, b, 5, F.lane, g2);
        else {
#pragma unroll
            for (int j = 0; j < 4; ++j) g2[j] = (f32x4){0.f, 0.f, 0.f, 0.f}; }
        const int* ts = (const int*)(ws + WS_TOKS); const float* tw = (const float*)(ws + WS_TOKW); const unsigned char* ybp = ws + WS_YB;
        int sl0 = 0, sl1 = 0; float wl0 = 0.f, wl1 = 0.f;
        if (l > 0) { const int rw = row0 + (F.lane & 31);
            sl0 = __hip_atomic_load(ts + rw * 2, __ATOMIC_RELAXED, __HIP_MEMORY_SCOPE_AGENT); sl1 = __hip_atomic_load(ts + rw * 2 + 1, __ATOMIC_RELAXED, __HIP_MEMORY_SCOPE_AGENT);
            wl0 = __hip_atomic_load(tw + rw * 2, __ATOMIC_RELAXED, __HIP_MEMORY_SCOPE_AGENT); wl1 = __hip_atomic_load(tw + rw * 2 + 1, __ATOMIC_RELAXED, __HIP_MEMORY_SCOPE_AGENT); }
        RowIn Rn, Rn2;
#define N1_LOAD(R, rr_) do { if (l > 0) rowin_load<true, false>(R, XB + (size_t)(row0 + (rr_)) * D, ybp, rdlane_i(sl0, (rr_)), rdlane_i(sl1, (rr_)), F.lane); else rowin_load<false, true>(R, xin0 + (size_t)(row0 + (rr_)) * D, ybp, 0, 0, F.lane); } while (0)
        N1_LOAD(Rn, 0); N1_LOAD(Rn2, 1);
        for (int r = 0; r < 32; ++r) { const int row = row0 + r;
            RowIn Rc = Rn; Rn = Rn2;
            if (r + 2 < 32) N1_LOAD(Rn2, r + 2);
            f32x4 v[4];
            if (l > 0) { rowin_combine(Rc, rdlane(wl0, r) * (1.f / pg8::MOE_S_Y), rdlane(wl1, r) * (1.f / pg8::MOE_S_Y), g2, v); row_store_bf16(XB + (size_t)row * D, F.lane, v); }
            else {
#pragma unroll
                for (int j = 0; j < 4; ++j) v[j] = Rc.x[j]; }
            const float rstd = row_rstd(v);
#pragma unroll
            for (int j = 0; j < 4; ++j) v[j] = v[j] * rstd * gm[j] + sh[j];
            if (in_fp8(l)) { unsigned* hrow = (unsigned*)(HO8 + (size_t)row * D);
#pragma unroll
              for (int j = 0; j < 4; ++j) hrow[F.lane + 64 * j] = pk4_fp8(v[j][0], v[j][1], v[j][2], v[j][3]); }
            else row_store_bf16((bf16*)HO8 + (size_t)row * D, F.lane, v);
            if (gla) {
                float ga[16];
#pragma unroll
                for (int o = 0; o < 16; ++o) { float s = 0.f;
#pragma unroll
                    for (int j = 0; j < 4; ++j) { const f32x4 w = *(const LAS f32x4*)(wgd + o * D + 4 * F.lane + 256 * j); s += (v[j][0] * w[0] + v[j][1] * w[1]) + (v[j][2] * w[2] + v[j][3] * w[3]); }
                    ga[o] = s; if (o & 1) __builtin_amdgcn_sched_barrier(0); }
                const float gk = halving_reduce<16>(ga, F.lane);
                if ((F.lane & 3) == 0) gdn[(size_t)row * 16 + (F.lane >> 2)] = gk;
            }
        }
    }
    __syncthreads();
    moe_weight_convert(F, l, gw, NGW);
}

#define MFMA32(a, b, c) __builtin_amdgcn_mfma_f32_32x32x16_bf16((a), (b), (c), 0, 0, 0)
DI bf16x8 ldg8(const bf16* p) { return *(const bf16x8*)p; }
DI bf16x8 pack8(float a0, float a1, float a2, float a3, float a4, float a5, float a6, float a7) {
    u32x4 p; p.x = pk2(a0, a1); p.y = pk2(a2, a3); p.z = pk2(a4, a5); p.w = pk2(a6, a7); return __builtin_bit_cast(bf16x8, p);
}
DI bf16x8 pack_step(const f32x16& x, int s) { return s == 0 ? pack8(x[0], x[1], x[2], x[3], x[4], x[5], x[6], x[7]) : pack8(x[8], x[9], x[10], x[11], x[12], x[13], x[14], x[15]); }
DI f32x16 zero16() { f32x16 z; for (int i = 0; i < 16; ++i) z[i] = 0.f; return z; }
DI bf16x8 tr_read2(unsigned a_lo, unsigned a_hi) {
    s16x4 lo, hi;
    asm volatile("ds_read_b64_tr_b16 %0, %2\n\tds_read_b64_tr_b16 %1, %3\n\ts_waitcnt lgkmcnt(0)" : "=&v"(lo), "=&v"(hi) : "v"(a_lo), "v"(a_hi) : "memory");
    return __builtin_shufflevector(lo, hi, 0, 1, 2, 3, 4, 5, 6, 7);
}
constexpr int VPITCH = 144;
DI bf16x8 vt_frag(unsigned vbase, int lane, int dblk, int s) {
    const int i16 = lane & 15, q = i16 >> 2, p = i16 & 3, blk = (lane >> 4) & 1, h2 = lane >> 5;
    const unsigned col = (unsigned)((32 * dblk + 16 * blk) * 2 + 8 * p);
    return tr_read2(vbase + (unsigned)((16 * s + 4 * h2 + q) * VPITCH) + col, vbase + (unsigned)((16 * s + 8 + 4 * h2 + q) * VPITCH) + col);
}

DI void vt_frags4(unsigned vbase, int lane, bf16x8& v00, bf16x8& v01, bf16x8& v10, bf16x8& v11) {
    const int i16 = lane & 15, q = i16 >> 2, p = i16 & 3, blk = (lane >> 4) & 1, h2 = lane >> 5;
    const unsigned a0 = vbase + (unsigned)((4 * h2 + q) * VPITCH) + (unsigned)(32 * blk + 8 * p);
    s16x4 r0, r1, r2, r3, r4, r5, r6, r7;
    asm volatile("ds_read_b64_tr_b16 %0, %8\n\tds_read_b64_tr_b16 %1, %8 offset:1152\n\tds_read_b64_tr_b16 %2, %8 offset:2304\n\tds_read_b64_tr_b16 %3, %8 offset:3456\n\t"
                 "ds_read_b64_tr_b16 %4, %8 offset:64\n\tds_read_b64_tr_b16 %5, %8 offset:1216\n\tds_read_b64_tr_b16 %6, %8 offset:2368\n\tds_read_b64_tr_b16 %7, %8 offset:3520\n\ts_waitcnt lgkmcnt(0)"
                 : "=&v"(r0), "=&v"(r1), "=&v"(r2), "=&v"(r3), "=&v"(r4), "=&v"(r5), "=&v"(r6), "=&v"(r7) : "v"(a0) : "memory");
    v00 = __builtin_shufflevector(r0, r1, 0, 1, 2, 3, 4, 5, 6, 7); v01 = __builtin_shufflevector(r2, r3, 0, 1, 2, 3, 4, 5, 6, 7);
    v10 = __builtin_shufflevector(r4, r5, 0, 1, 2, 3, 4, 5, 6, 7); v11 = __builtin_shufflevector(r6, r7, 0, 1, 2, 3, 4, 5, 6, 7);
}
static_assert(VPITCH == 144, "vt_frags4 offsets assume a 144-byte row pitch: 8 rows = 1152 B");

DI void ph_sb_attn(Ctx& F) {
    unsigned char* ws = F.ws; bf16* proj = (bf16*)(ws + WS_BIG);
    const int lane = F.lane, r = lane & 31, h2 = lane >> 5;
    LAS unsigned char* vl = F.lds + F.wave * (64 * VPITCH); LAS unsigned char* kl = vl + 32 * VPITCH;
    const unsigned vbase = (unsigned)(size_t)vl;
    const int vcu = (F.G % 8 == 0) ? (F.bid % 8) * (F.G / 8) + F.bid / 8 : F.bid;
    for (int it2 = vcu; it2 < NB * 256 * 2; it2 += F.G) {
        const int it = it2 >> 1, hd = F.wave + 8 * (it2 & 1);
        const int b = it >> 8, qt = it & 255;
        const int q0 = qt * 32; const size_t rowbase = (size_t)b * SEQ;
        const bf16* qp = proj + (rowbase + q0 + r) * 3072 + hd * 64;
        bf16x8 Qf[4];
#pragma unroll
        for (int kk = 0; kk < 4; ++kk) Qf[kk] = ldg8(qp + 16 * kk + 8 * h2);
        f32x16 o0 = zero16(), o1 = zero16(); float carry = 0.f;
        const int qpos = q0 + r;
        u32x4 kv[4], vv[4];
        { const bf16* tp = proj + (rowbase + (q0 >> 5) * 32 + (lane >> 3)) * 3072 + hd * 64 + (lane & 7) * 8;
#pragma unroll
          for (int i = 0; i < 4; ++i) { kv[i] = *(const u32x4*)(tp + (size_t)(8 * i) * 3072 + 1024); vv[i] = *(const u32x4*)(tp + (size_t)(8 * i) * 3072 + 2048); } }
        for (int kt = q0 >> 5; kt >= 0; --kt) {
#pragma unroll
            for (int i = 0; i < 4; ++i) { *(LAS u32x4*)(kl + (8 * i + (lane >> 3)) * VPITCH + (lane & 7) * 16) = kv[i]; *(LAS u32x4*)(vl + (8 * i + (lane >> 3)) * VPITCH + (lane & 7) * 16) = vv[i]; }
            if (kt > 0) { const bf16* tp = proj + (rowbase + (kt - 1) * 32 + (lane >> 3)) * 3072 + hd * 64 + (lane & 7) * 8;
#pragma unroll
                for (int i = 0; i < 4; ++i) { kv[i] = *(const u32x4*)(tp + (size_t)(8 * i) * 3072 + 1024); vv[i] = *(const u32x4*)(tp + (size_t)(8 * i) * 3072 + 2048); } }
            LDS_WAIT();
            bf16x8 Kf[4];
#pragma unroll
            for (int kk = 0; kk < 4; ++kk) Kf[kk] = *(const LAS bf16x8*)(kl + r * VPITCH + (16 * kk + 8 * h2) * 2);
            f32x16 st = zero16();
#pragma unroll
            for (int kk = 0; kk < 4; ++kk) st = MFMA32(Kf[kk], Qf[kk], st);
            const bool diag = (kt == (q0 >> 5));
            float Lv[16]; float sg[4], pg[4];
            const int kbase = kt * 32 + 4 * h2;
#pragma unroll
            for (int i = 0; i < 16; ++i) { const int kpos = kbase + (i & 3) + 8 * (i >> 2); const float z = st[i];
                const float sp = fmaxf(z, 0.f) + flog2(1.f + fexp2(-fabsf(z)));
                Lv[i] = (!diag || kpos < qpos) ? -sp : 0.f; }
#pragma unroll
            for (int g = 0; g < 4; ++g) { sg[g] = (Lv[4 * g] + Lv[4 * g + 1]) + (Lv[4 * g + 2] + Lv[4 * g + 3]); pg[g] = __shfl_xor(sg[g], 32); }
            float after = carry; float a[16];
#pragma unroll
            for (int g = 3; g >= 0; --g) {
                float run = after + (h2 == 0 ? pg[g] : 0.f);
#pragma unroll
                for (int k = 3; k >= 0; --k) { const int i = 4 * g + k; run += Lv[i]; const int kpos = kbase + k + 8 * g;
                    a[i] = (!diag || kpos < qpos) ? fexp2(st[i] + run) : 0.f; }
                after += sg[g] + pg[g];
            }
            carry = after;
            const bf16x8 P0 = pack8(a[0], a[1], a[2], a[3], a[4], a[5], a[6], a[7]), P1 = pack8(a[8], a[9], a[10], a[11], a[12], a[13], a[14], a[15]);
            LDS_WAIT();
            bf16x8 v00, v01, v10, v11; vt_frags4(vbase, lane, v00, v01, v10, v11);
            o0 = MFMA32(v00, P0, o0); o0 = MFMA32(v01, P1, o0); o1 = MFMA32(v10, P0, o1); o1 = MFMA32(v11, P1, o1);
            if (__all(carry < -126.f)) break;
        }
        if (out_fp8(0)) { unsigned char* op8 = ws + WS_HO + (rowbase + q0 + r) * D + hd * 64 + 4 * h2;
#pragma unroll
            for (int g = 0; g < 4; ++g) { *(unsigned*)(op8 + 8 * g) = pk4_fp8(o0[4 * g], o0[4 * g + 1], o0[4 * g + 2], o0[4 * g + 3]); *(unsigned*)(op8 + 32 + 8 * g) = pk4_fp8(o1[4 * g], o1[4 * g + 1], o1[4 * g + 2], o1[4 * g + 3]); } }
        else {
        bf16* op = proj + (rowbase + q0 + r) * 3072 + hd * 64 + 4 * h2;
#pragma unroll
        for (int g = 0; g < 4; ++g) { u32x2 w; w.x = pk2(o0[4 * g], o0[4 * g + 1]); w.y = pk2(o0[4 * g + 2], o0[4 * g + 3]); *(u32x2*)(op + 8 * g) = w;
            u32x2 w1; w1.x = pk2(o1[4 * g], o1[4 * g + 1]); w1.y = pk2(o1[4 * g + 2], o1[4 * g + 3]); *(u32x2*)(op + 32 + 8 * g) = w1; } }
    }
}

DI void ph_dil_attn(Ctx& F) {
    unsigned char* ws = F.ws; bf16* proj = (bf16*)(ws + WS_BIG); float* lse = (float*)(ws + WS_LSE);
    const int lane = F.lane, r = lane & 31, h2 = lane >> 5;
    LAS unsigned char* vl = F.lds + F.wave * (64 * VPITCH); LAS unsigned char* kl = vl + 32 * VPITCH;
    const unsigned vbase = (unsigned)(size_t)vl;
    const int vcu = (F.G % 8 == 0) ? (F.bid % 8) * (F.G / 8) + F.bid / 8 : F.bid;
    for (int it = vcu; it < 3 * NB * 256; it += F.G) {
        const int mt_all = it & 255, b = (it >> 8) & 7, g = it >> 11, hd = F.wave;
        const int lr = 2 * g, rr = 1 << lr;
        const int tiles_per_class = 256 >> lr;
        const int rho = mt_all / tiles_per_class, mt = mt_all % tiles_per_class;
        const size_t rowbase = (size_t)b * SEQ + rho; const int cq = g * 1536 + hd * 64;
        const int m0 = mt * 32;
        const bf16* qp = proj + (rowbase + (size_t)(m0 + r) * rr) * 4608 + cq;
        bf16x8 Qf[4];
#pragma unroll
        for (int kk = 0; kk < 4; ++kk) Qf[kk] = ldg8(qp + 16 * kk + 8 * h2);
        f32x16 o0 = zero16(), o1 = zero16(); float mrun = -__builtin_inff(), lrun = 0.f;
        const int mq = m0 + r;
        const int ktb = (mt >= 4 ? mt - 4 : 0);
        u32x4 kv[4], vv[4];
        { const bf16* tp = proj + (rowbase + (size_t)(ktb * 32 + (lane >> 3)) * rr) * 4608 + cq + (lane & 7) * 8;
#pragma unroll
          for (int i = 0; i < 4; ++i) { kv[i] = *(const u32x4*)(tp + (size_t)(8 * i * rr) * 4608 + 512); vv[i] = *(const u32x4*)(tp + (size_t)(8 * i * rr) * 4608 + 1024); } }
        for (int kt = ktb; kt <= mt; ++kt) {
#pragma unroll
            for (int i = 0; i < 4; ++i) { *(LAS u32x4*)(kl + (8 * i + (lane >> 3)) * VPITCH + (lane & 7) * 16) = kv[i]; *(LAS u32x4*)(vl + (8 * i + (lane >> 3)) * VPITCH + (lane & 7) * 16) = vv[i]; }
            if (kt < mt) { const bf16* tp = proj + (rowbase + (size_t)((kt + 1) * 32 + (lane >> 3)) * rr) * 4608 + cq + (lane & 7) * 8;
#pragma unroll
                for (int i = 0; i < 4; ++i) { kv[i] = *(const u32x4*)(tp + (size_t)(8 * i * rr) * 4608 + 512); vv[i] = *(const u32x4*)(tp + (size_t)(8 * i * rr) * 4608 + 1024); } }
            LDS_WAIT();
            bf16x8 Kf[4];
#pragma unroll
            for (int kk = 0; kk < 4; ++kk) Kf[kk] = *(const LAS bf16x8*)(kl + r * VPITCH + (16 * kk + 8 * h2) * 2);
            f32x16 st = zero16();
#pragma unroll
            for (int kk = 0; kk < 4; ++kk) st = MFMA32(Kf[kk], Qf[kk], st);
            const int kbase = kt * 32 + 4 * h2;
            float mx = -__builtin_inff();
            if (kt == mt || kt + 4 == mt) {
#pragma unroll
                for (int i = 0; i < 16; ++i) { const int mk = kbase + (i & 3) + 8 * (i >> 2); const bool valid = (mk <= mq) && (mq - mk <= 128);
                    st[i] = valid ? st[i] : -__builtin_inff(); } }
#pragma unroll
            for (int i = 0; i < 16; ++i) mx = fmaxf(mx, st[i]);
            mx = fmaxf(mx, __shfl_xor(mx, 32));
            const float mnew = fmaxf(mrun, mx);
            const float alpha = fexp2(mrun - mnew);
            float a[16]; float ps = 0.f;
#pragma unroll
            for (int i = 0; i < 16; ++i) { a[i] = fexp2(st[i] - mnew); ps += a[i]; }
            ps += __shfl_xor(ps, 32);
            lrun = lrun * alpha + ps; mrun = mnew;
#pragma unroll
            for (int i = 0; i < 16; ++i) { o0[i] *= alpha; o1[i] *= alpha; }
            const bf16x8 P0 = pack8(a[0], a[1], a[2], a[3], a[4], a[5], a[6], a[7]), P1 = pack8(a[8], a[9], a[10], a[11], a[12], a[13], a[14], a[15]);
            LDS_WAIT();
            bf16x8 v00, v01, v10, v11; vt_frags4(vbase, lane, v00, v01, v10, v11);
            o0 = MFMA32(v00, P0, o0); o0 = MFMA32(v01, P1, o0); o1 = MFMA32(v10, P0, o1); o1 = MFMA32(v11, P1, o1);
        }
        const float inv = 1.f / lrun;
        const size_t orow = rowbase + (size_t)(m0 + r) * rr;
        bf16* op = proj + orow * 4608 + cq + 4 * h2;
#pragma unroll
        for (int gq = 0; gq < 4; ++gq) { u32x2 w; w.x = pk2(o0[4 * gq] * inv, o0[4 * gq + 1] * inv); w.y = pk2(o0[4 * gq + 2] * inv, o0[4 * gq + 3] * inv); *(u32x2*)(op + 8 * gq) = w;
            u32x2 w1; w1.x = pk2(o1[4 * gq] * inv, o1[4 * gq + 1] * inv); w1.y = pk2(o1[4 * gq + 2] * inv, o1[4 * gq + 3] * inv); *(u32x2*)(op + 32 + 8 * gq) = w1; }
        if (h2 == 0) lse[((size_t)g * T + orow) * 8 + hd] = mrun + flog2(lrun);
    }
}
DI void ph_dil_combine(Ctx& F) {
    unsigned char* ws = F.ws; const bf16* proj = (const bf16*)(ws + WS_BIG); const float* lse = (const float*)(ws + WS_LSE); bf16* HO = (bf16*)(ws + WS_HO);
    const int gw = F.bid * NWAVES + F.wave, NGW = F.G * NWAVES; const int lane = F.lane, hd = lane >> 3;
    for (int row = gw; row < T; row += NGW) {
        const float l0 = lse[((size_t)0 * T + row) * 8 + hd], l1 = lse[((size_t)1 * T + row) * 8 + hd], l2 = lse[((size_t)2 * T + row) * 8 + hd];
        const float m = fmaxf(l0, fmaxf(l1, l2)); float w0 = fexp2(l0 - m), w1 = fexp2(l1 - m), w2 = fexp2(l2 - m); const float inv = 1.f / (w0 + w1 + w2); w0 *= inv; w1 *= inv; w2 *= inv;
        const bf16* p = proj + (size_t)row * 4608 + 8 * lane;
        const u32x4 a = *(const u32x4*)p, b = *(const u32x4*)(p + 1536), c = *(const u32x4*)(p + 3072);
        u32x4 o; float f[8];
#pragma unroll
        for (int e = 0; e < 4; ++e) { const float lo = w0 * bflo(a[e]) + w1 * bflo(b[e]) + w2 * bflo(c[e]), hi = w0 * bfhi(a[e]) + w1 * bfhi(b[e]) + w2 * bfhi(c[e]); o[e] = pk2(lo, hi); f[2 * e] = lo; f[2 * e + 1] = hi; }
        if (out_fp8(3)) { u32x2 q8; q8.x = pk4_fp8(f[0], f[1], f[2], f[3]); q8.y = pk4_fp8(f[4], f[5], f[6], f[7]); *(u32x2*)((unsigned char*)HO + (size_t)row * 512 + 8 * lane) = q8; }
        else *(u32x4*)(HO + (size_t)row * 512 + 8 * lane) = o;
    }
}

DI void ph_conv(Ctx& F) {
    const KParams& P = *F.p; unsigned char* ws = F.ws; const bf16* proj = (const bf16*)(ws + WS_BIG); bf16* HO = (bf16*)(ws + WS_HO);
    const int gw = F.bid * NWAVES + F.wave, NGW = F.G * NWAVES; const int lane = F.lane;
    const float* cw = PIN(I_CONVW); const float* cb = PIN(I_CONVB);
    f32x4 w0[4], w1[4], w2[4], bb[4];
#pragma unroll
    for (int j = 0; j < 4; ++j) { const int col = 4 * lane + 256 * j; w0[j] = *(const f32x4*)(cw + col); w1[j] = *(const f32x4*)(cw + D + col); w2[j] = *(const f32x4*)(cw + 2 * D + col); bb[j] = *(const f32x4*)(cb + col); }
    for (int blk = gw; blk < T / 32; blk += NGW) {
        const int row0 = blk * 32, pos0 = row0 % SEQ;
        f32x4 um1[4], um2[4];
#pragma unroll
        for (int j = 0; j < 4; ++j) { um1[j] = (f32x4){0.f, 0.f, 0.f, 0.f}; um2[j] = um1[j]; }
        if (pos0 >= 2) {
#pragma unroll
            for (int j = 0; j < 4; ++j) { const int col = 4 * lane + 256 * j;
                const u32x2 c1 = *(const u32x2*)(proj + (size_t)(row0 - 1) * 3072 + 1024 + col), u1 = *(const u32x2*)(proj + (size_t)(row0 - 1) * 3072 + 2048 + col);
                const u32x2 c2 = *(const u32x2*)(proj + (size_t)(row0 - 2) * 3072 + 1024 + col), u2 = *(const u32x2*)(proj + (size_t)(row0 - 2) * 3072 + 2048 + col);
                um1[j] = (f32x4){bflo(c1.x) * bflo(u1.x), bfhi(c1.x) * bfhi(u1.x), bflo(c1.y) * bflo(u1.y), bfhi(c1.y) * bfhi(u1.y)};
                um2[j] = (f32x4){bflo(c2.x) * bflo(u2.x), bfhi(c2.x) * bfhi(u2.x), bflo(c2.y) * bflo(u2.y), bfhi(c2.y) * bfhi(u2.y)}; }
        }
        u32x2 ngb[4], nc0[4], nu0[4];
#pragma unroll
        for (int j = 0; j < 4; ++j) { const int col = 4 * lane + 256 * j; const bf16* p = proj + (size_t)row0 * 3072 + col; ngb[j] = *(const u32x2*)p; nc0[j] = *(const u32x2*)(p + 1024); nu0[j] = *(const u32x2*)(p + 2048); }
        for (int rr = 0; rr < 32; ++rr) { const size_t row = (size_t)row0 + rr;
            u32x2 gbv_[4], c0v[4], u0v[4];
#pragma unroll
            for (int j = 0; j < 4; ++j) { gbv_[j] = ngb[j]; c0v[j] = nc0[j]; u0v[j] = nu0[j]; }
            if (rr + 1 < 32) {
#pragma unroll
                for (int j = 0; j < 4; ++j) { const int col = 4 * lane + 256 * j; const bf16* p = proj + (row + 1) * 3072 + col; ngb[j] = *(const u32x2*)p; nc0[j] = *(const u32x2*)(p + 1024); nu0[j] = *(const u32x2*)(p + 2048); } }
#pragma unroll
            for (int j = 0; j < 4; ++j) { const int col = 4 * lane + 256 * j;
                const u32x2 gb = gbv_[j], c0 = c0v[j], u0 = u0v[j];
                const f32x4 uc = (f32x4){bflo(c0.x) * bflo(u0.x), bfhi(c0.x) * bfhi(u0.x), bflo(c0.y) * bflo(u0.y), bfhi(c0.y) * bfhi(u0.y)};
                const f32x4 y = w0[j] * um2[j] + w1[j] * um1[j] + w2[j] * uc + bb[j];
                const f32x4 gbv = (f32x4){bflo(gb.x), bfhi(gb.x), bflo(gb.y), bfhi(gb.y)};
                const f32x4 z = gbv * y;
                if (out_fp8(2)) *(unsigned*)((unsigned char*)HO + row * D + col) = pk4_fp8(z[0], z[1], z[2], z[3]);
                else { u32x2 o; o.x = pk2(z[0], z[1]); o.y = pk2(z[2], z[3]); *(u32x2*)(HO + row * D + col) = o; }
                um2[j] = um1[j]; um1[j] = uc; }
        }
    }
}

constexpr int G1_GD = 0, G1_QIN = 4096, G1_PITCH = 1040, G1_KIN = G1_QIN + 64 * G1_PITCH;
DI void ph_gla_g1(Ctx& F) {
    const KParams& P = *F.p; unsigned char* ws = F.ws; bf16* proj = (bf16*)(ws + WS_BIG);
    const float* gdn = (const float*)(ws + WS_GDOWN); float* decay = (float*)(ws + WS_DECAY);
    bf16* kst = (bf16*)(ws + WS_KST); bf16* vT = (bf16*)(ws + WS_VT); bf16* sc = (bf16*)(ws + WS_SC);
    LAS float* GD = (LAS float*)(F.lds + G1_GD); LAS unsigned char* QIN = F.lds + G1_QIN; LAS unsigned char* KIN = F.lds + G1_KIN;
    const int tid = F.tid, ch = tid, lane = F.lane, r = lane & 31, h2 = lane >> 5;
    float wup[16];
#pragma unroll
    for (int o = 0; o < 16; ++o) wup[o] = PIN(I_GLAGU)[o * 512 + ch];
    const float bg = PIN(I_GLABG)[ch];
    for (int item = F.bid; item < T / 64; item += F.G) {
        const size_t row0 = (size_t)item * 64;
        __syncthreads();
        if (tid < 256) *(LAS f32x4*)(GD + tid * 4) = *(const f32x4*)(gdn + row0 * 16 + tid * 4);
#pragma unroll
        for (int p = 0; p < 8; ++p) { const int piece = tid + 512 * p, row = piece >> 6, c16 = piece & 63; const bf16* src = proj + (row0 + row) * 3072 + c16 * 8;
            *(LAS u32x4*)(QIN + row * G1_PITCH + c16 * 16) = *(const u32x4*)src; *(LAS u32x4*)(KIN + row * G1_PITCH + c16 * 16) = *(const u32x4*)(src + 512); }
#pragma unroll
        for (int q = 0; q < 2; ++q) { const int blk = tid + 512 * q, to = blk & 7, co = blk >> 3;
            u32x4 rw[8];
#pragma unroll
            for (int t = 0; t < 8; ++t) rw[t] = *(const u32x4*)(proj + (row0 + 8 * to + t) * 3072 + 1024 + 8 * co);
#pragma unroll
            for (int c = 0; c < 8; ++c) { const unsigned sel = (c & 1) ? 0x07060302u : 0x05040100u; u32x4 o;
                o.x = __builtin_amdgcn_perm(rw[1][c >> 1], rw[0][c >> 1], sel); o.y = __builtin_amdgcn_perm(rw[3][c >> 1], rw[2][c >> 1], sel);
                o.z = __builtin_amdgcn_perm(rw[5][c >> 1], rw[4][c >> 1], sel); o.w = __builtin_amdgcn_perm(rw[7][c >> 1], rw[6][c >> 1], sel);
                *(u32x4*)(vT + ((size_t)item * 1024 + 8 * co + c) * 64 + 8 * to) = o; } }
        __syncthreads();
        float bs[64]; float bc = 0.f;
#pragma unroll
        for (int i = 0; i < 64; ++i) {
            float u = bg;
#pragma unroll
            for (int q4 = 0; q4 < 4; ++q4) { const f32x4 g = *(const LAS f32x4*)(GD + i * 16 + q4 * 4); u += (g[0] * wup[q4 * 4] + g[1] * wup[q4 * 4 + 1]) + (g[2] * wup[q4 * 4 + 2] + g[3] * wup[q4 * 4 + 3]); }
            const float u2 = u * LOG2E;
            const float ls2 = -(fmaxf(-u2, 0.f) + flog2(1.f + fexp2(-fabsf(u2))));
            bc += ls2 * (1.f / 16.f); bs[i] = bc;
        }
        unsigned kp[32];
#pragma unroll
        for (int i = 0; i < 64; ++i) {
            LAS unsigned short* qp = (LAS unsigned short*)(QIN + i * G1_PITCH + ch * 2); LAS unsigned short* kq = (LAS unsigned short*)(KIN + i * G1_PITCH + ch * 2);
            const float qv = bf2f(*qp), kv = bf2f(*kq);
            const float qin = qv * fexp2(bs[i]), kin = kv * fexp2(-bs[i]), kstv = kv * fexp2(bs[63] - bs[i]);
            *qp = (unsigned short)f2bf(qin); *kq = (unsigned short)f2bf(kin);
            if (i & 1) kp[i >> 1] |= f2bf(kstv) << 16; else kp[i >> 1] = f2bf(kstv);
        }
        { u32x4* dst = (u32x4*)(kst + ((size_t)item * 512 + ch) * 64);
#pragma unroll
          for (int q8 = 0; q8 < 8; ++q8) dst[q8] = (u32x4){kp[4 * q8], kp[4 * q8 + 1], kp[4 * q8 + 2], kp[4 * q8 + 3]}; }
        decay[(size_t)item * 512 + ch] = fexp2(bs[63]);
        __syncthreads();
#pragma unroll
        for (int p = 0; p < 8; ++p) { const int piece = tid + 512 * p, row = piece >> 6, c16 = piece & 63;
            *(u32x4*)(proj + (row0 + row) * 3072 + c16 * 8) = *(const LAS u32x4*)(QIN + row * G1_PITCH + c16 * 16); }
        { const int shd = F.wave >> 1, jt = F.wave & 1;
#pragma unroll
          for (int itile = 0; itile < 2; ++itile) {
            f32x16 st = zero16();
            if (jt <= itile) {
#pragma unroll
                for (int s = 0; s < 8; ++s) { const bf16x8 kf = *(const LAS bf16x8*)(KIN + (jt * 32 + r) * G1_PITCH + (shd * 128 + 16 * s + 8 * h2) * 2);
                    const bf16x8 qf = *(const LAS bf16x8*)(QIN + (itile * 32 + r) * G1_PITCH + (shd * 128 + 16 * s + 8 * h2) * 2);
                    st = MFMA32(kf, qf, st); }
            }
            const int iq = itile * 32 + r;
            bf16* dst = sc + (((size_t)item * 4 + shd) * 64 + iq) * 64 + jt * 32 + 4 * h2;
#pragma unroll
            for (int g = 0; g < 4; ++g) { float v[4];
#pragma unroll
                for (int k = 0; k < 4; ++k) { const int j = jt * 32 + 8 * g + 4 * h2 + k; v[k] = (j <= iq) ? st[4 * g + k] : 0.f; }
                u32x2 w; w.x = pk2(v[0], v[1]); w.y = pk2(v[2], v[3]); *(u32x2*)(dst + 8 * g) = w; }
          } }
    }
}
constexpr int G2_SC = 0, G2_QI = 9216, G2_KS = G2_QI + 17408, G2_DC = G2_KS + 18432, G2_BUF = G2_DC + 512;
constexpr int NSEG = 8, SEGC = (SEQ / 64) / NSEG;
template <int MODE> DI void ph_gla_g2(Ctx& F) {
    unsigned char* ws = F.ws; const bf16* proj = (const bf16*)(ws + WS_BIG); const float* decay = (const float*)(ws + WS_DECAY);
    const bf16* kst = (const bf16*)(ws + WS_KST); const bf16* vT = (const bf16*)(ws + WS_VT); const bf16* sc = (const bf16*)(ws + WS_SC); bf16* oraw = (bf16*)(ws + WS_HO);
    float* send = (float*)(ws + WS_SEND); float* dseg = (float*)(ws + WS_DSEG);
    const int tid = F.tid, lane = F.lane, r = lane & 31, h2 = lane >> 5, dvs = F.wave;
    for (int item = F.bid; item < NB * 4 * NSEG; item += F.G) {
        const int seg = item & (NSEG - 1), hd = (item >> 3) & 3, b = item >> 5;
        if (MODE == 0 && seg == NSEG - 1) continue;
        const size_t ci0 = (size_t)b * (SEQ / 64) + seg * SEGC;
        const int sc_row = tid >> 3, sc_c = tid & 7;
        const int qi_row0 = tid >> 4, qi_c = tid & 15;
        const int ks_row0 = tid >> 3, ks_c = tid & 7;
        u32x4 st_sc, st_q0, st_q1, st_k0, st_k1; f32x4 st_d = (f32x4){0.f, 0.f, 0.f, 0.f};
        bf16x8 Vf[4], VfN[4];
#define G2_LOAD(ci) do { \
            if (MODE == 1) { st_sc = *(const u32x4*)(sc + (((ci) * 4 + hd) * 64 + sc_row) * 64 + sc_c * 8); \
                st_q0 = *(const u32x4*)(proj + ((ci) * 64 + qi_row0) * 3072 + hd * 128 + qi_c * 8); st_q1 = *(const u32x4*)(proj + ((ci) * 64 + qi_row0 + 32) * 3072 + hd * 128 + qi_c * 8); } \
            st_k0 = *(const u32x4*)(kst + (((ci) * 4 + hd) * 128 + ks_row0) * 64 + ks_c * 8); st_k1 = *(const u32x4*)(kst + (((ci) * 4 + hd) * 128 + ks_row0 + 64) * 64 + ks_c * 8); \
            if (tid < 32) st_d = *(const f32x4*)(decay + (ci) * 512 + hd * 128 + tid * 4); \
            { const bf16* vrow_ = vT + ((ci) * 1024 + hd * 256 + dvs * 32 + r) * 64 + 8 * h2; _Pragma("unroll") for (int s_ = 0; s_ < 4; ++s_) VfN[s_] = ldg8(vrow_ + 16 * s_); } } while (0)
#define G2_STORE(bufp) do { \
            if (MODE == 1) { *(LAS u32x4*)((bufp) + G2_SC + sc_row * 144 + sc_c * 16) = st_sc; \
                *(LAS u32x4*)((bufp) + G2_QI + qi_row0 * 272 + qi_c * 16) = st_q0; *(LAS u32x4*)((bufp) + G2_QI + (qi_row0 + 32) * 272 + qi_c * 16) = st_q1; } \
            *(LAS u32x4*)((bufp) + G2_KS + ks_row0 * 144 + ks_c * 16) = st_k0; *(LAS u32x4*)((bufp) + G2_KS + (ks_row0 + 64) * 144 + ks_c * 16) = st_k1; \
            if (tid < 32) *(LAS f32x4*)((bufp) + G2_DC + tid * 16) = st_d; } while (0)
        __syncthreads();
        G2_LOAD(ci0);
        f32x16 S[4];
#pragma unroll
        for (int mt = 0; mt < 4; ++mt) S[mt] = zero16();
        if (MODE == 1) {
            for (int sp = 0; sp < seg; ++sp) {
                const float* dp = dseg + (size_t)(item - seg + sp) * 128 + 4 * h2;
                const float* sp_ = send + ((size_t)(item - seg + sp) * NWAVES + dvs) * 4096 + lane * 4;
#pragma unroll
                for (int mt = 0; mt < 4; ++mt)
#pragma unroll
                    for (int g = 0; g < 4; ++g) { const f32x4 dv = *(const f32x4*)(dp + 32 * mt + 8 * g), sv = *(const f32x4*)(sp_ + (mt * 4 + g) * 256);
#pragma unroll
                        for (int k = 0; k < 4; ++k) S[mt][4 * g + k] = S[mt][4 * g + k] * dv[k] + sv[k]; }
            }
        } else if (tid < 128) {
            float pr = 1.f;
            for (int n = 0; n < SEGC; ++n) pr *= decay[(ci0 + n) * 512 + hd * 128 + tid];
            dseg[(size_t)item * 128 + tid] = pr;
        }
        G2_STORE(F.lds);
#pragma unroll
        for (int s = 0; s < 4; ++s) Vf[s] = VfN[s];
        __syncthreads();
        for (int n = 0; n < SEGC; ++n) {
            const size_t ci = ci0 + n;
            LAS unsigned char* buf = F.lds + (n & 1) * G2_BUF; LAS unsigned char* nbuf = F.lds + ((n + 1) & 1) * G2_BUF;
            if (n + 1 < SEGC) G2_LOAD(ci + 1);
            if (MODE == 1) {
                bf16x8 Sb[4][2];
#pragma unroll
                for (int mt = 0; mt < 4; ++mt) { Sb[mt][0] = pack_step(S[mt], 0); Sb[mt][1] = pack_step(S[mt], 1); }
#pragma unroll
                for (int itile = 0; itile < 2; ++itile) {
                    f32x16 o = zero16();
                    const LAS unsigned char* scrow = buf + G2_SC + (itile * 32 + r) * 144 + 16 * h2;
#pragma unroll
                    for (int s = 0; s < 4; ++s) o = MFMA32(Vf[s], *(const LAS bf16x8*)(scrow + 32 * s), o);
                    const LAS unsigned char* qrow = buf + G2_QI + (itile * 32 + r) * 272 + 8 * h2;
#pragma unroll
                    for (int mt = 0; mt < 4; ++mt)
#pragma unroll
                        for (int s2 = 0; s2 < 2; ++s2) { const u32x2 lo = *(const LAS u32x2*)(qrow + 64 * mt + 32 * s2), hi = *(const LAS u32x2*)(qrow + 64 * mt + 32 * s2 + 16);
                            const u32x4 fr = (u32x4){lo.x, lo.y, hi.x, hi.y};
                            o = MFMA32(Sb[mt][s2], __builtin_bit_cast(bf16x8, fr), o); }
                    bf16* op = oraw + (ci * 64 + itile * 32 + r) * 1024 + hd * 256 + dvs * 32 + 4 * h2;
#pragma unroll
                    for (int g = 0; g < 4; ++g) { u32x2 w; w.x = pk2(o[4 * g], o[4 * g + 1]); w.y = pk2(o[4 * g + 2], o[4 * g + 3]); *(u32x2*)(op + 8 * g) = w; }
                }
            }
#pragma unroll
            for (int mt = 0; mt < 4; ++mt) {
                const LAS unsigned char* dp = buf + G2_DC + (32 * mt + 4 * h2) * 4;
#pragma unroll
                for (int g = 0; g < 4; ++g) { const f32x4 dv = *(const LAS f32x4*)(dp + 32 * g);
#pragma unroll
                    for (int k = 0; k < 4; ++k) S[mt][4 * g + k] *= dv[k]; }
                const LAS unsigned char* krow = buf + G2_KS + (32 * mt + r) * 144 + 16 * h2;
#pragma unroll
                for (int s = 0; s < 4; ++s) S[mt] = MFMA32(*(const LAS bf16x8*)(krow + 32 * s), Vf[s], S[mt]);
            }
            if (n + 1 < SEGC) { G2_STORE(nbuf);
#pragma unroll
                for (int s = 0; s < 4; ++s) Vf[s] = VfN[s]; }
            asm volatile("s_waitcnt lgkmcnt(0)" ::: "memory"); __builtin_amdgcn_s_barrier(); asm volatile("" ::: "memory");
        }
        if (MODE == 1) {
            asm volatile("s_waitcnt vmcnt(0)" ::: "memory"); __syncthreads();
            const float* gng = (const float*)F.p->in[I_GLANG]; const int cl = (lane & 15) * 16;
            float gn[16];
#pragma unroll
            for (int e = 0; e < 16; ++e) gn[e] = gng[cl + e];
            u32x4 na0, na1, nr0, nr1;
            { const size_t row = ci0 * 64 + (size_t)F.wave * 4 + (lane >> 4); const bf16* op = oraw + row * D + hd * 256 + cl; const bf16* rp = proj + row * 3072 + 2048 + hd * 256 + cl;
              na0 = *(const u32x4*)op; na1 = *(const u32x4*)(op + 8); nr0 = *(const u32x4*)rp; nr1 = *(const u32x4*)(rp + 8); }
            for (int q = F.wave; q < SEGC * 16; q += NWAVES) {
                const size_t row = ci0 * 64 + (size_t)q * 4 + (lane >> 4);
                bf16* op = oraw + row * D + hd * 256 + cl;
                const u32x4 a0 = na0, a1 = na1, r0 = nr0, r1 = nr1;
                if (q + NWAVES < SEGC * 16) { const size_t rown = row + 4 * NWAVES; const bf16* opn = oraw + rown * D + hd * 256 + cl; const bf16* rpn = proj + rown * 3072 + 2048 + hd * 256 + cl;
                    na0 = *(const u32x4*)opn; na1 = *(const u32x4*)(opn + 8); nr0 = *(const u32x4*)rpn; nr1 = *(const u32x4*)(rpn + 8); }
                float v[16], rv[16];
#pragma unroll
                for (int e = 0; e < 4; ++e) { v[2 * e] = bflo(a0[e]); v[2 * e + 1] = bfhi(a0[e]); v[8 + 2 * e] = bflo(a1[e]); v[8 + 2 * e + 1] = bfhi(a1[e]);
                    rv[2 * e] = bflo(r0[e]); rv[2 * e + 1] = bfhi(r0[e]); rv[8 + 2 * e] = bflo(r1[e]); rv[8 + 2 * e + 1] = bfhi(r1[e]); }
                float ss = 0.f;
#pragma unroll
                for (int e = 0; e < 16; ++e) ss += v[e] * v[e];
                ss += __shfl_xor(ss, 1); ss += __shfl_xor(ss, 2); ss += __shfl_xor(ss, 4); ss += __shfl_xor(ss, 8);
                const float rstd = 1.f / sqrtf(ss * (1.f / 256.f) + RMS_EPS);
                float o[16];
#pragma unroll
                for (int e = 0; e < 16; ++e) { const float rr = rv[e]; o[e] = v[e] * rstd * gn[e] * (rr / (1.f + __expf(-rr))); }
                if (out_fp8(1)) { u32x4 q8;
#pragma unroll
                    for (int e = 0; e < 4; ++e) q8[e] = pk4_fp8(o[4 * e], o[4 * e + 1], o[4 * e + 2], o[4 * e + 3]);
                    *(u32x4*)(ws + WS_KST + row * D + hd * 256 + cl) = q8; }
                else { u32x4 w0, w1;
#pragma unroll
                    for (int e = 0; e < 4; ++e) { w0[e] = pk2(o[2 * e], o[2 * e + 1]); w1[e] = pk2(o[8 + 2 * e], o[8 + 2 * e + 1]); }
                    *(u32x4*)op = w0; *(u32x4*)(op + 8) = w1; }
            }
        }
        if (MODE == 0) {
            float* sp_ = send + ((size_t)item * NWAVES + dvs) * 4096 + lane * 4;
#pragma unroll
            for (int mt = 0; mt < 4; ++mt)
#pragma unroll
                for (int g = 0; g < 4; ++g) *(f32x4*)(sp_ + (mt * 4 + g) * 256) = (f32x4){S[mt][4 * g], S[mt][4 * g + 1], S[mt][4 * g + 2], S[mt][4 * g + 3]};
        }
#undef G2_LOAD
#undef G2_STORE
    }
}
DI void ph_gla_g3(Ctx& F) {
    const KParams& P = *F.p; unsigned char* ws = F.ws; const bf16* proj = (const bf16*)(ws + WS_BIG); bf16* HO = (bf16*)(ws + WS_HO);
    const int gw = F.bid * NWAVES + F.wave, NGW = F.G * NWAVES; const int lane = F.lane;
    float gn[16];
#pragma unroll
    for (int e = 0; e < 16; ++e) gn[e] = PIN(I_GLANG)[(16 * lane + e) & 255];
    for (int row = gw; row < T; row += NGW) {
        bf16* op = HO + (size_t)row * D + 16 * lane; const bf16* rp = proj + (size_t)row * 3072 + 2048 + 16 * lane;
        const u32x4 a0 = *(const u32x4*)op, a1 = *(const u32x4*)(op + 8), r0 = *(const u32x4*)rp, r1 = *(const u32x4*)(rp + 8);
        float v[16], rv[16];
#pragma unroll
        for (int e = 0; e < 4; ++e) { v[2 * e] = bflo(a0[e]); v[2 * e + 1] = bfhi(a0[e]); v[8 + 2 * e] = bflo(a1[e]); v[8 + 2 * e + 1] = bfhi(a1[e]);
            rv[2 * e] = bflo(r0[e]); rv[2 * e + 1] = bfhi(r0[e]); rv[8 + 2 * e] = bflo(r1[e]); rv[8 + 2 * e + 1] = bfhi(r1[e]); }
        float ss = 0.f;
#pragma unroll
        for (int e = 0; e < 16; ++e) ss += v[e] * v[e];
        ss += __shfl_xor(ss, 1); ss += __shfl_xor(ss, 2); ss += __shfl_xor(ss, 4); ss += __shfl_xor(ss, 8);
        const float rstd = 1.f / sqrtf(ss * (1.f / 256.f) + RMS_EPS);
        float o[16];
#pragma unroll
        for (int e = 0; e < 16; ++e) { const float rr = rv[e]; o[e] = v[e] * rstd * gn[e] * (rr / (1.f + __expf(-rr))); }
        if (out_fp8(1)) { u32x4 q8;
#pragma unroll
            for (int e = 0; e < 4; ++e) q8[e] = pk4_fp8(o[4 * e], o[4 * e + 1], o[4 * e + 2], o[4 * e + 3]);
            *(u32x4*)(ws + WS_KST + (size_t)row * D + 16 * lane) = q8; }
        else {
        u32x4 w0, w1;
#pragma unroll
        for (int e = 0; e < 4; ++e) { w0[e] = pk2(o[2 * e], o[2 * e + 1]); w1[e] = pk2(o[8 + 2 * e], o[8 + 2 * e + 1]); }
        *(u32x4*)op = w0; *(u32x4*)(op + 8) = w1; }
    }
}

constexpr int N2_PITCH = 2064, N2_GM = 37 * N2_PITCH + 432  , N2_SH = N2_GM + 4096;
DI bool n2_better(float va, int ia, float vb, int ib) { return va > vb || (va == vb && ia < ib); }
DI void ph_norm2(Ctx& F, int l) {
    const KParams& P = *F.p; unsigned char* ws = F.ws;
    const float* modf = (const float*)(ws + WS_MODF);
    LAS unsigned char* WTb = F.lds;
    LAS float* GM = (LAS float*)(F.lds + N2_GM); LAS float* SH = (LAS float*)(F.lds + N2_SH);
    volatile LAS unsigned* hist = F.MISC + 32;
    const float* wg = PIN(I_MGRPW) + (size_t)l * D * 4; const float* we = PIN(I_MEXPW) + (size_t)l * D * 32;
    const float* bgp = PIN(I_MGRPB) + l * 4; const float* bep = PIN(I_MEXPB) + l * 32;
    __syncthreads();
    for (int c = F.tid; c < D; c += NTHR) { const f32x4 w = *(const f32x4*)(wg + c * 4);
#pragma unroll
        for (int e = 0; e < 4; ++e) *(LAS unsigned short*)(WTb + (32 + e) * N2_PITCH + c * 2) = (unsigned short)f2bf(w[e]);
        *(LAS unsigned short*)(WTb + 36 * N2_PITCH + c * 2) = 0; }
    for (int idx = F.tid; idx < D * 8; idx += NTHR) { const int c = idx >> 3, part = idx & 7; const f32x4 w = *(const f32x4*)(we + c * 32 + part * 4);
#pragma unroll
        for (int e = 0; e < 4; ++e) *(LAS unsigned short*)(WTb + (part * 4 + e) * N2_PITCH + c * 2) = (unsigned short)f2bf(w[e]); }
    const bf16* X = (const bf16*)(ws + WS_XB); unsigned char* HO8 = ws + WS_HO;
    int* tok_e = (int*)(ws + WS_TOKE); float* tok_w = (float*)(ws + WS_TOKW); int* hist_g = (int*)(ws + WS_HIST);
    const float* ng = PIN(I_NORMG) + (size_t)(l * 2 + 1) * D;
    const int lane = F.lane, r = lane & 31, h2 = lane >> 5;
    for (int vb = F.bid; vb < T / 256; vb += F.G) {
        __syncthreads();
        if (F.tid < 32) hist[F.tid] = 0u;
        const int b = (vb * 256) / SEQ;
        if (F.tid < 256) { const float* mp = modf + ((size_t)l * NB + b) * 6144; const f32x4 shv = *(const f32x4*)(mp + 3 * D + 4 * F.tid), scv = *(const f32x4*)(mp + 4 * D + 4 * F.tid), gv = *(const f32x4*)(ng + 4 * F.tid);
            *(LAS f32x4*)(GM + 4 * F.tid) = gv * (scv + 1.f); *(LAS f32x4*)(SH + 4 * F.tid) = shv; }
        __syncthreads();
        const int row = vb * 256 + F.wave * 32 + r;
        const bf16* xrow = X + (size_t)row * D + 512 * h2;
        float ss = 0.f;
        { const float* sp = (const float*)(ws + WS_SSP) + (size_t)row * 16;
#pragma unroll
          for (int q = 0; q < 4; ++q) { const f32x4 pq = *(const f32x4*)(sp + 4 * q); ss += (pq[0] + pq[1]) + (pq[2] + pq[3]); } }
        const float rstd = 1.f / sqrtf(ss * (1.f / D) + RMS_EPS);
        f32x16 accE = zero16(), accG = zero16();
        const LAS unsigned char* aE = WTb + r * N2_PITCH + 1024 * h2; const LAS unsigned char* aG = WTb + (r < 4 ? 32 + r : 36) * N2_PITCH + 1024 * h2;
        const LAS float* gmp = GM + 512 * h2; const LAS float* shp = SH + 512 * h2;
        unsigned char* hrow = HO8 + (size_t)row * D + 512 * h2;
        for (int s8 = 0; s8 < 64; s8 += 8) {
            u32x4 wv[8];
#pragma unroll
            for (int q = 0; q < 8; ++q) wv[q] = *(const u32x4*)(xrow + 8 * (s8 + q));
#pragma unroll
            for (int q = 0; q < 8; q += 2) {
                u32x4 st8;
#pragma unroll
                for (int q2 = 0; q2 < 2; ++q2) { const int s2 = s8 + q + q2; const u32x4 w = wv[q + q2];
                    const f32x4 g0 = *(const LAS f32x4*)(gmp + 8 * s2), g1 = *(const LAS f32x4*)(gmp + 8 * s2 + 4), s0 = *(const LAS f32x4*)(shp + 8 * s2), s1 = *(const LAS f32x4*)(shp + 8 * s2 + 4);
                    float h[8];
                    h[0] = bflo(w.x) * rstd * g0[0] + s0[0]; h[1] = bfhi(w.x) * rstd * g0[1] + s0[1]; h[2] = bflo(w.y) * rstd * g0[2] + s0[2]; h[3] = bfhi(w.y) * rstd * g0[3] + s0[3];
                    h[4] = bflo(w.z) * rstd * g1[0] + s1[0]; h[5] = bfhi(w.z) * rstd * g1[1] + s1[1]; h[6] = bflo(w.w) * rstd * g1[2] + s1[2]; h[7] = bfhi(w.w) * rstd * g1[3] + s1[3];
                    st8[2 * q2] = pk4_fp8(h[0], h[1], h[2], h[3]); st8[2 * q2 + 1] = pk4_fp8(h[4], h[5], h[6], h[7]);
                    const bf16x8 hb = pack8(h[0], h[1], h[2], h[3], h[4], h[5], h[6], h[7]);
                    accE = MFMA32(*(const LAS bf16x8*)(aE + 16 * s2), hb, accE);
                    accG = MFMA32(*(const LAS bf16x8*)(aG + 16 * s2), hb, accG); }
                *(u32x4*)(hrow + 8 * (s8 + q)) = st8;
            }
        }
        float gl[4];
#pragma unroll
        for (int o = 0; o < 4; ++o) gl[o] = accG[o] + bgp[o];
        int grp = 0; float gmax = gl[0];
#pragma unroll
        for (int o = 1; o < 4; ++o) if (gl[o] > gmax) { gmax = gl[o]; grp = o; }
        float gden = 0.f;
#pragma unroll
        for (int o = 0; o < 4; ++o) gden += __expf(gl[o] - gmax);
        float pgrp = 1.f / gden;
        grp = __shfl(grp, r); pgrp = __shfl(pgrp, r);
        float cv[4];
#pragma unroll
        for (int k = 0; k < 4; ++k) { const float v0 = accE[k], v1 = accE[4 + k], v2 = accE[8 + k], v3 = accE[12 + k];
            cv[k] = (grp == 0 ? v0 : grp == 1 ? v1 : grp == 2 ? v2 : v3) + bep[8 * grp + 4 * h2 + k]; }
        float a1 = -__builtin_inff(), a2 = -__builtin_inff(); int i1 = 0, i2 = 0;
#pragma unroll
        for (int k = 0; k < 4; ++k) { const float sv = cv[k]; const int id = 4 * h2 + k;
            if (sv > a1) { a2 = a1; i2 = i1; a1 = sv; i1 = id; } else if (sv > a2) { a2 = sv; i2 = id; } }
        const float b1 = __shfl_xor(a1, 32), b2 = __shfl_xor(a2, 32); const int j1 = __shfl_xor(i1, 32), j2 = __shfl_xor(i2, 32);
        float t1, t2; int e1, e2;
        if (n2_better(a1, i1, b1, j1)) { t1 = a1; e1 = i1; if (n2_better(a2, i2, b1, j1)) { t2 = a2; e2 = i2; } else { t2 = b1; e2 = j1; } }
        else { t1 = b1; e1 = j1; if (n2_better(a1, i1, b2, j2)) { t2 = a1; e2 = i1; } else { t2 = b2; e2 = j2; } }
        const float ex2 = __expf(t2 - t1), inv = 1.f / (1.f + ex2);
        if (h2 == 0) { const int e0g = grp * 8 + e1, e1g = grp * 8 + e2;
            tok_e[row * 2] = e0g; tok_e[row * 2 + 1] = e1g; tok_w[row * 2] = pgrp * inv; tok_w[row * 2 + 1] = pgrp * ex2 * inv;
            __hip_atomic_fetch_add((LAS unsigned*)(hist + e0g), 1u, __ATOMIC_RELAXED, __HIP_MEMORY_SCOPE_WORKGROUP); __hip_atomic_fetch_add((LAS unsigned*)(hist + e1g), 1u, __ATOMIC_RELAXED, __HIP_MEMORY_SCOPE_WORKGROUP); }
        __syncthreads();
        if (F.tid < 32) hist_g[vb * 32 + F.tid] = (int)hist[F.tid];
    }
}
DI void ph_scatter(Ctx& F) {
    unsigned char* ws = F.ws;
    const int* hist_g = (const int*)(ws + WS_HIST); const int* tok_e = (const int*)(ws + WS_TOKE);
    int* tok_s = (int*)(ws + WS_TOKS); int* slot_tok = (int*)(ws + WS_SLOTTOK); int* tile_e = (int*)(ws + WS_TILEE);
    LAS int* H = (LAS int*)F.lds; LAS int* eid = H + 8192; LAS int* tot = eid + 512; LAS int* base = tot + 32; LAS int* pstart = base + 32; LAS int* ptotal = pstart + 32; LAS int* ptot = ptotal + 32; LAS int* pbase = ptot + 512;
    for (int vb = F.bid; vb < T / 256; vb += F.G) {
        __syncthreads();
        for (int i = F.tid; i < 8192; i += NTHR) H[i] = hist_g[i];
        eid[F.tid] = tok_e[vb * 512 + F.tid];
        __syncthreads();
        { const int e_ = F.tid & 31, part = F.tid >> 5; int total = 0, before = 0;
#pragma unroll 4
          for (int q = 0; q < 16; ++q) { const int bb = part * 16 + q; const int c = H[bb * 32 + e_]; total += c; before += (bb < vb) ? c : 0; }
          ptot[part * 32 + e_] = total; pbase[part * 32 + e_] = before; }
        __syncthreads();
        if (F.tid < 32) { int total = 0, before = 0;
#pragma unroll
            for (int q = 0; q < 16; ++q) { total += ptot[q * 32 + F.tid]; before += pbase[q * 32 + F.tid]; }
            tot[F.tid] = total; base[F.tid] = before; }
        __syncthreads();
        if (F.tid == 0) { int ps = 0; for (int e = 0; e < 32; ++e) { pstart[e] = ps; ps += ((tot[e] + 255) >> 8) << 8; } ptotal[0] = ps; }
        __syncthreads();
        const int e = eid[F.tid]; int rank = 0;
        for (int j = 0; j < F.tid; ++j) rank += (eid[j] == e) ? 1 : 0;
        const int slot = pstart[e] + base[e] + rank;
        slot_tok[slot] = vb * 256 + (F.tid >> 1); tok_s[vb * 512 + F.tid] = slot;
        if (vb == 0) {
            if (F.tid < 32) { const int ee = F.tid, s0 = pstart[ee] + tot[ee], s1 = pstart[ee] + (((tot[ee] + 255) >> 8) << 8);
                for (int s = s0; s < s1; ++s) slot_tok[s] = 0;
                for (int tl = pstart[ee] >> 8; tl < (s1 >> 8); ++tl) tile_e[tl] = ee; }
            if (F.tid == 0) tile_e[1023] = ptotal[0] >> 8;
        }
    }
}
DI void ph_final(Ctx& F) {
    const KParams& P = *F.p; unsigned char* ws = F.ws;
    const int gw = F.bid * NWAVES + F.wave, NGW = F.G * NWAVES;
    const float* modf = (const float*)(ws + WS_MODF); float* X = (float*)P.out; const bf16* XB = (const bf16*)(ws + WS_XB); const float* fg = PIN(I_FINALG);
    for (int blk = gw; blk < T / 32; blk += NGW) {
        const int row0 = blk * 32, b = row0 / SEQ;
        f32x4 g2[4], gf[4];
        mod_vec_f(modf, DEPTH - 1, b, 5, F.lane, g2);
#pragma unroll
        for (int j = 0; j < 4; ++j) gf[j] = *(const f32x4*)(fg + 4 * F.lane + 256 * j);
        const int* ts = (const int*)(ws + WS_TOKS); const float* tw = (const float*)(ws + WS_TOKW); const unsigned char* ybp = ws + WS_YB;
        const int rw = row0 + (F.lane & 31);
        const int sl0 = __hip_atomic_load(ts + rw * 2, __ATOMIC_RELAXED, __HIP_MEMORY_SCOPE_AGENT), sl1 = __hip_atomic_load(ts + rw * 2 + 1, __ATOMIC_RELAXED, __HIP_MEMORY_SCOPE_AGENT);
        const float wl0 = __hip_atomic_load(tw + rw * 2, __ATOMIC_RELAXED, __HIP_MEMORY_SCOPE_AGENT), wl1 = __hip_atomic_load(tw + rw * 2 + 1, __ATOMIC_RELAXED, __HIP_MEMORY_SCOPE_AGENT);
        RowIn Rn, Rn2; rowin_load<true, false>(Rn, XB + (size_t)row0 * D, ybp, rdlane_i(sl0, 0), rdlane_i(sl1, 0), F.lane); rowin_load<true, false>(Rn2, XB + (size_t)(row0 + 1) * D, ybp, rdlane_i(sl0, 1), rdlane_i(sl1, 1), F.lane);
        for (int r = 0; r < 32; ++r) { const int row = row0 + r;
            RowIn Rc = Rn; Rn = Rn2;
            if (r + 2 < 32) rowin_load<true, false>(Rn2, XB + (size_t)(row + 2) * D, ybp, rdlane_i(sl0, r + 2), rdlane_i(sl1, r + 2), F.lane);
            f32x4 v[4]; rowin_combine(Rc, rdlane(wl0, r) * (1.f / pg8::MOE_S_Y), rdlane(wl1, r) * (1.f / pg8::MOE_S_Y), g2, v);
            const float rstd = row_rstd(v);
#pragma unroll
            for (int j = 0; j < 4; ++j) *(f32x4*)(X + (size_t)row * D + 4 * F.lane + 256 * j) = v[j] * rstd * gf[j];
        }
    }
}

constexpr int N_PHASES = 46;
#ifndef EN
#define EN 0xFFFFu
#endif
#ifdef PROBE_GROUP
#ifndef PROBE_LAYER
#define PROBE_LAYER (-1)
#endif
#ifndef PROBE_UNIT_US
#define PROBE_UNIT_US 8.f
#endif
#ifndef PROBE_L2
#define PROBE_L2 (-1)
#endif
#endif
#define ENB(i) (((EN) >> (i)) & 1u)
__host__ __device__ inline bool phase_exists(int k) { if (k == 0 || k == 45) return true; const int l = (k - 1) / 11, j = (k - 1) % 11; if (j == 3) return l == 1 || l == 3; if (j == 4) return l == 1; if (j == 5) return false; return true; }

#define RUN(k) (ph_lo <= (k) && (k) < ph_hi)
#define FRESH() int t_ = threadIdx.x; asm volatile("" : "+v"(t_)); F.tid = t_; F.lane = t_ & 63; F.wave = __builtin_amdgcn_readfirstlane(t_ >> 6); \
    { const KParams* kp_ = (const KParams*)__builtin_amdgcn_kernarg_segment_ptr(); asm volatile("" : "+s"(kp_)); F.p = kp_; } GAS unsigned char* wsg_ = F.p->ws; asm volatile("" : "+s"(wsg_)); unsigned char* ws = (unsigned char*)wsg_;   F.ws = ws; bf16* HO = (bf16*)(ws + WS_HO); bf16* BIG = (bf16*)(ws + WS_BIG); float* modf = (float*)(ws + WS_MODF); (void)HO; (void)BIG; (void)modf
#ifdef PROBE_GROUP
#define PROBE(grp, lay) do { const unsigned long long t_ = __builtin_amdgcn_s_memrealtime(); if ((grp) == PROBE_GROUP && (PROBE_LAYER < 0 || (lay) == PROBE_LAYER)) pr_acc += t_ - pr_prev; pr_prev = t_; } while (0)
#else
#define PROBE(grp, lay) do { } while (0)
#endif
#if MK_N_LAUNCHES == 1
#define SEAM(k) do { int hi_ = ph_hi; asm volatile("" : "+s"(hi_)); if ((k) + 1 < hi_) { PROBE_BAR(99); SPREAD_ARRIVE(k); xcd_barrier<false>(bar); PROBE_BAR(16); } } while (0)
#define SEAM0() do { if (1 < ph_hi) xcd_barrier<true>(bar); } while (0)
#else
#define SEAM(k) do { } while (0)
#define SEAM0() do { } while (0)
#endif
#if defined(PROBE_GROUP) && PROBE_GROUP == 16
#define PROBE_BAR(g) PROBE(g, 0)
#else
#define PROBE_BAR(g) do { } while (0)
#endif
#if defined(PROBE_GROUP) && PROBE_GROUP == 17
#define SPREAD_ARRIVE(k) do { if (threadIdx.x == 0) { const unsigned long long t_ = __builtin_amdgcn_s_memrealtime(); unsigned long long* sp_ = (unsigned long long*)((unsigned char*)F.p->ws + WS_CTL + 65536); \
        atomicMax(sp_ + (k), ~t_); atomicMax(sp_ + 64 + (k), t_); } } while (0)
#else
#define SPREAD_ARRIVE(k) do { } while (0)
#endif
template <int l> DI void run_layer(Ctx& F, const XcdBarrier& bar, const int ph_lo, const int ph_hi, unsigned long long& pr_prev, unsigned long long& pr_acc) {
        const int pb = 1 + 11 * l;
        if (ENB(1) && RUN(pb + 0)) { FRESH(); ph_norm1(F, l); SEAM(pb + 0); PROBE(1, l); }
        if (ENB(2) && RUN(pb + 1)) { FRESH();
            const int N = (l == 3) ? 4608 : 3072;
            const void* Bt = ws + (l == 0 ? W_SBIN : l == 1 ? W_GLAIN : l == 2 ? W_CONVIN : W_DILIN);
            pg8::DenseSched S; S.init(T, N, in_fp8(l) ? D : D * 2, Bt, F.G, F.bid);
            pg8::EpiProj E; E.O = BIG; E.ldc = N; E.period = (l == 3) ? 1536 : 3072; E.qcols = (l == 0) ? 1024 : (l == 2) ? 0 : 512;
            E.qscale = (l == 1) ? 0.08838834764831845f : 0.125f * LOG2E; E.base = in_fp8(l) ? 1.f / pg8::MOE_S_W1 : 1.f;
            if constexpr (in_fp8(l)) pg8::gemm_phase<pg8::EpiProj, pg8::DenseSched, true, true>(F.tid, F.lds, (const char*)HO, D, D / 128, S, E);
            else pg8::gemm_phase<pg8::EpiProj, pg8::DenseSched, true, false>(F.tid, F.lds, (const char*)HO, D * 2, D / 64, S, E);
            SEAM(pb + 1); PROBE(2, l);
        }
        if (RUN(pb + 2)) { FRESH();
            if (l == 0) { if (ENB(3)) ph_sb_attn(F); } else if (l == 1) { if (ENB(4)) ph_gla_g1(F); } else if (l == 2) { if (ENB(5)) ph_conv(F); } else { if (ENB(6)) ph_dil_attn(F); }
            SEAM(pb + 2); PROBE(3 + l, l);
        }
        if ((l == 1 || l == 3) && RUN(pb + 3)) { FRESH(); if (l == 1) { if (ENB(7)) ph_gla_g2<0>(F); } else { if (ENB(8)) ph_dil_combine(F); } SEAM(pb + 3); PROBE(l == 1 ? 7 : 8, l); }
        if (ENB(7) && l == 1 && RUN(pb + 4)) { FRESH(); ph_gla_g2<1>(F); SEAM(pb + 4); PROBE(7, l); }
        if (ENB(10) && RUN(pb + 6)) { FRESH();
            constexpr int K = (l == 3) ? 512 : D;
            const void* Bt = ws + (l == 0 ? W_SBOUT : l == 1 ? W_GLAOUT : l == 2 ? W_CONVOUT : W_DILOUT);
            pg8::EpiResid<l == 0> E; E.resid = (l == 0) ? (const void*)(const float*)F.p->in[I_X] : (const void*)(ws + WS_XB); E.out = (bf16*)(ws + WS_XB); E.gate = modf + (size_t)l * NB * 6144 + 2 * D; E.ssp = (float*)(ws + WS_SSP);
            if constexpr (out_fp8(l)) {
                const char* A = (l == 1) ? (const char*)(ws + WS_KST) : (const char*)HO;
                pg8::DenseSched S; S.init(T, D, K, Bt, F.G, F.bid); E.gscale = 1.f / pg8::MOE_S_W1;
                pg8::gemm_phase<pg8::EpiResid<l == 0>, pg8::DenseSched, true, true>(F.tid, F.lds, A, K, K / 128, S, E);
            } else {
                const int lda = (l == 0) ? 3072 : K; const char* A = (l == 0) ? (const char*)BIG : (const char*)HO;
                pg8::DenseSched S; S.init(T, D, K * 2, Bt, F.G, F.bid); E.gscale = 1.f;
                pg8::gemm_phase<pg8::EpiResid<l == 0>, pg8::DenseSched, true>(F.tid, F.lds, A, lda * 2, K / 64, S, E);
            }
            SEAM(pb + 6); PROBE(10, l);
        }
        if (ENB(11) && RUN(pb + 7)) { FRESH(); ph_norm2(F, l); SEAM(pb + 7); PROBE(11, l); }
        if (ENB(12) && RUN(pb + 8)) { FRESH(); ph_scatter(F); SEAM(pb + 8); PROBE(12, l); }
        if (ENB(13) && RUN(pb + 9)) { FRESH();
            const int* tile_e = (const int*)(ws + WS_TILEE);
            const int ntiles = __builtin_amdgcn_readfirstlane(__hip_atomic_load(tile_e + 1023, __ATOMIC_RELAXED, __HIP_MEMORY_SCOPE_AGENT));
            pg8::MoeSched<true> S; S.G = F.G; S.c = (F.G % 8 == 0) ? (F.bid % 8) * (F.G / 8) + F.bid / 8 : F.bid;     S.ldb = D; S.Bt = (const char*)(ws + WS_W1T); S.estride = (size_t)1024 * D; S.tile_e = tile_e; S.slot_tok = (const int*)(ws + WS_SLOTTOK); S.nunits = ntiles * 4;
            pg8::EpiMoe1 E; E.O = (unsigned char*)(ws + WS_ACT);
            pg8::gemm_phase<pg8::EpiMoe1, pg8::MoeSched<true>, true, true>(F.tid, F.lds, (const char*)HO, D, D / 128, S, E);
            SEAM(pb + 9); PROBE(13, l);
        }
        if (ENB(14) && RUN(pb + 10)) { FRESH();
            const int* tile_e = (const int*)(ws + WS_TILEE);
            const int ntiles = __builtin_amdgcn_readfirstlane(__hip_atomic_load(tile_e + 1023, __ATOMIC_RELAXED, __HIP_MEMORY_SCOPE_AGENT));
            pg8::MoeSched<false> S; S.G = F.G; S.c = (F.G % 8 == 0) ? (F.bid % 8) * (F.G / 8) + F.bid / 8 : F.bid;     S.ldb = MOE_FF; S.Bt = (const char*)(ws + WS_W2T); S.estride = (size_t)1024 * MOE_FF; S.tile_e = tile_e; S.slot_tok = nullptr; S.nunits = ntiles * 4;
            pg8::EpiY8 E; E.O = ws + WS_YB; E.s = pg8::MOE_S_Y / (pg8::MOE_S_ACT * pg8::MOE_S_W2);
            pg8::gemm_phase<pg8::EpiY8, pg8::MoeSched<false>, true, true>(F.tid, F.lds, (const char*)(ws + WS_ACT), MOE_FF, MOE_FF / 128, S, E);
            SEAM(pb + 10); PROBE(14, l);
        }
    }

__global__ void __launch_bounds__(NTHR, 2) fwd(Params P) {
    extern __shared__ __attribute__((aligned(16))) unsigned char lds_raw[];
    Ctx F;
    F.lds = (LAS unsigned char*)lds_raw; F.MISC = (volatile LAS unsigned*)(F.lds + MISC_OFF);
    F.tid = threadIdx.x; F.lane = F.tid & 63; F.wave = __builtin_amdgcn_readfirstlane(F.tid >> 6); F.G = gridDim.x; F.bid = blockIdx.x; F.p = (const KParams*)__builtin_amdgcn_kernarg_segment_ptr();
    if (F.tid < 128) F.MISC[F.tid] = 0u;
    __syncthreads();
    const int ph_lo = F.p->ph_lo, ph_hi = F.p->ph_hi;
    XcdBarrier bar; bar.bar = nullptr; bar.x = 0; bar.st = nullptr;
#if MK_N_LAUNCHES == 1
    bar = xcd_barrier_post((unsigned*)((unsigned char*)F.p->ws + WS_CTL) + CW_BAR, F.MISC + 8);
#endif
    unsigned long long pr_prev = 0ull, pr_acc = 0ull;
#ifdef PROBE_GROUP
    pr_prev = __builtin_amdgcn_s_memrealtime();
#endif
    if (ENB(0) && RUN(0)) { FRESH(); ph_prologue(F); SEAM0(); PROBE(0, 0); }
    run_layer<0>(F, bar, ph_lo, ph_hi, pr_prev, pr_acc);
    run_layer<1>(F, bar, ph_lo, ph_hi, pr_prev, pr_acc);
    run_layer<2>(F, bar, ph_lo, ph_hi, pr_prev, pr_acc);
    run_layer<3>(F, bar, ph_lo, ph_hi, pr_prev, pr_acc);
    if (ENB(15) && RUN(45)) { FRESH(); ph_final(F); PROBE(15, 0); }
#ifdef PROBE_GROUP
#if PROBE_GROUP == 17
    if (blockIdx.x == 0 && threadIdx.x == 0) { unsigned long long* sp_ = (unsigned long long*)((unsigned char*)F.p->ws + WS_CTL + 65536); pr_acc = 0ull;
        for (int k = 1; k < 45; ++k) { const unsigned long long mn = ~__hip_atomic_load(sp_ + k, __ATOMIC_RELAXED, __HIP_MEMORY_SCOPE_AGENT), mx = __hip_atomic_load(sp_ + 64 + k, __ATOMIC_RELAXED, __HIP_MEMORY_SCOPE_AGENT);
            const int j = (k - 1) % 11, ll = (k - 1) / 11; if (mx != 0ull && (PROBE_LAYER < 0 || j == PROBE_LAYER) && (PROBE_L2 < 0 || ll == PROBE_L2)) pr_acc += mx - mn; } }
#endif
    if (blockIdx.x == 0 && threadIdx.x == 0) { asm volatile("s_waitcnt vmcnt(0)" ::: "memory"); ((float*)F.p->out)[0] = 8.f + (float)pr_acc * (1.f / (100.f * PROBE_UNIT_US)); }
#endif
}
#undef RUN
#undef SEAM
#undef SEAM0
#undef FRESH
#undef PROBE

extern "C" void kernel_launch(void* const* d_in, const int* in_sizes, int n_in, void* d_out, int out_size, void* d_ws, size_t ws_size, hipStream_t stream) {
    static int grid = 0;
    if (grid == 0) {
        if (n_in != 26 || out_size != T * D || ws_size < WS_END) { fprintf(stderr, "kernel_launch: unexpected shapes (n_in %d, out %d, ws %zu < %zu)\n", n_in, out_size, ws_size, (size_t)WS_END); grid = -1; return; }
        int dev = 0, cus = 0, per_cu = 0;
        if (hipGetDevice(&dev) != hipSuccess || hipDeviceGetAttribute(&cus, hipDeviceAttributeMultiprocessorCount, dev) != hipSuccess) { grid = -1; return; }
        if (hipFuncSetAttribute((const void*)fwd, hipFuncAttributeMaxDynamicSharedMemorySize, LDS_BYTES) != hipSuccess) { fprintf(stderr, "kernel_launch: hipFuncSetAttribute failed\n"); grid = -1; return; }
        if (hipOccupancyMaxActiveBlocksPerMultiprocessor(&per_cu, (const void*)fwd, NTHR, LDS_BYTES) != hipSuccess || per_cu < 1) fprintf(stderr, "kernel_launch: occupancy query reports %d\n", per_cu);
        (void)hipGetLastError();
        grid = cus;
    }
    if (grid < 0) return;
    (void)hipMemsetAsync((char*)d_ws + WS_CTL, 0, CTL_ZERO_BYTES, stream);
    Params p{};
    for (int i = 0; i < 26; ++i) p.in[i] = (const float*)d_in[i];
    p.out = (float*)d_out; p.ws = (unsigned char*)d_ws;
#if MK_N_LAUNCHES == 1
    p.ph_lo = 0; p.ph_hi = N_PHASES;
    hipLaunchKernelGGL(fwd, dim3(grid), dim3(NTHR), LDS_BYTES, stream, p);
#else
    for (int k = 0; k < N_PHASES; ++k) { if (!phase_exists(k)) continue; p.ph_lo = k; p.ph_hi = k + 1; hipLaunchKernelGGL(fwd, dim3(grid), dim3(NTHR), LDS_BYTES, stream, p); }
#endif
}
```

```cpp
#include <hip/hip_runtime.h>
#include <cstdio>
#include <cstdint>
#ifndef MK_N_LAUNCHES
#define MK_N_LAUNCHES 1
#endif
#define LAS __attribute__((address_space(3)))
#define GAS __attribute__((address_space(1)))
typedef unsigned short bf16;
typedef short bf16x8 __attribute__((ext_vector_type(8)));
typedef short s16x4 __attribute__((ext_vector_type(4)));
typedef float f32x2 __attribute__((ext_vector_type(2)));
typedef float f32x4 __attribute__((ext_vector_type(4)));
typedef float f32x16 __attribute__((ext_vector_type(16)));
typedef unsigned u32x2 __attribute__((ext_vector_type(2)));
typedef unsigned u32x4 __attribute__((ext_vector_type(4)));
typedef int i32x4 __attribute__((ext_vector_type(4)));
typedef int i32x8 __attribute__((ext_vector_type(8)));
#define DI __device__ __forceinline__

constexpr int NB = 8, SEQ = 8192, D = 1024, T = NB * SEQ, DEPTH = 4;
constexpr float RMS_EPS = 1e-6f;
constexpr float LOG2E = 1.4426950408889634f;
constexpr int NWAVES = 8, NTHR = 512;
constexpr int MOE_E = 32, MOE_FF = 512;
constexpr int PMAX = 2 * T + MOE_E * 256;
constexpr int KSPLIT = 8;
#ifndef INFP8_MASK
#define INFP8_MASK 0x9
#endif
#ifndef OUTFP8_MASK
#define OUTFP8_MASK 0x8
#endif
__host__ __device__ constexpr bool out_fp8(int l) { return ((OUTFP8_MASK) >> l) & 1; }
__host__ __device__ constexpr bool in_fp8(int l) { return ((INFP8_MASK) >> l) & 1; }

constexpr size_t MiB = 1u << 20;
constexpr size_t WS_CTL = 0, CTL_ZERO_BYTES = 1 * MiB;
constexpr size_t WS_MODP = 2 * MiB;
constexpr size_t WS_MODF = 9 * MiB;
constexpr size_t WS_TOKE = 10 * MiB;
constexpr size_t WS_TOKW = WS_TOKE + 512 * 1024;
constexpr size_t WS_TOKS = WS_TOKW + 512 * 1024;
constexpr size_t WS_SLOTTOK = WS_TOKS + 512 * 1024;
constexpr size_t WS_HIST = 13 * MiB;
constexpr size_t WS_TILEE = WS_HIST + 64 * 1024;
constexpr size_t WS_GDOWN = 14 * MiB;
constexpr size_t WS_DECAY = 18 * MiB;
constexpr size_t WS_LSE = 20 * MiB;
constexpr size_t WS_WMIX = 26 * MiB;
constexpr size_t W_SBIN = WS_WMIX, W_SBOUT = W_SBIN + 6 * MiB, W_GLAIN = W_SBOUT + 2 * MiB, W_GLAOUT = W_GLAIN + 6 * MiB, W_CONVIN = W_GLAOUT + 2 * MiB,
                 W_CONVOUT = W_CONVIN + 6 * MiB, W_DILIN = W_CONVOUT + 2 * MiB, W_DILOUT = W_DILIN + 9 * MiB;
constexpr size_t WS_W1T = 62 * MiB;
constexpr size_t WS_W2T = 126 * MiB;
constexpr size_t WS_HO = 158 * MiB;
constexpr size_t WS_BIG = 286 * MiB;
constexpr size_t WS_KST = WS_BIG + 384 * MiB;
constexpr size_t WS_VT = WS_KST + 64 * MiB;
constexpr size_t WS_SC = WS_VT + 128 * MiB;
constexpr size_t WS_ACT = WS_BIG;
constexpr size_t WS_YB = WS_BIG + 140 * MiB;
constexpr size_t WS_SEND = WS_SC + 32 * MiB;
constexpr size_t WS_DSEG = WS_SEND + 32 * MiB;
constexpr size_t WS_XB = WS_DSEG + 1 * MiB;
constexpr size_t WS_SSP = WS_XB + 128 * MiB;
constexpr size_t WS_END = WS_SSP + 4 * MiB;
constexpr int CW_BAR = 4096;

constexpr int LDS_BYTES = 160 * 1024 - 512;
constexpr int MISC_OFF = LDS_BYTES - 512;

DI unsigned f2bf(float f) { unsigned u = __builtin_bit_cast(unsigned, f); return (u + 0x7fffu + ((u >> 16) & 1u)) >> 16; }
typedef __bf16 bf16n2 __attribute__((ext_vector_type(2)));
DI unsigned pk2(float lo, float hi) { const f32x2 v = {lo, hi}; return __builtin_bit_cast(unsigned, __builtin_convertvector(v, bf16n2)); }
DI unsigned pk4_fp8(float a, float b, float c, float d) {
    a = __builtin_amdgcn_fmed3f(a, -448.f, 448.f); b = __builtin_amdgcn_fmed3f(b, -448.f, 448.f); c = __builtin_amdgcn_fmed3f(c, -448.f, 448.f); d = __builtin_amdgcn_fmed3f(d, -448.f, 448.f);
    int w = 0; w = __builtin_amdgcn_cvt_pk_fp8_f32(a, b, w, false); w = __builtin_amdgcn_cvt_pk_fp8_f32(c, d, w, true); return (unsigned)w;
}
DI float bf2f(unsigned short b) { return __builtin_bit_cast(float, (unsigned)b << 16); }
DI float bflo(unsigned w) { return __builtin_bit_cast(float, w << 16); }
DI float bfhi(unsigned w) { return __builtin_bit_cast(float, w & 0xffff0000u); }
DI float wave_sum(float v) {
#pragma unroll
    for (int o = 1; o < 64; o <<= 1) v += __shfl_xor(v, o);
    return v;
}
template <int N> DI float halving_reduce(float (&a)[N], int lane) {
    int bit = 32;
#pragma unroll
    for (int n = N; n > 1; n >>= 1) {
        const bool hi = (lane & bit) != 0;
#pragma unroll
        for (int i = 0; i < n / 2; ++i) { const float keep = hi ? a[n / 2 + i] : a[i], send = hi ? a[i] : a[n / 2 + i]; a[i] = keep + __shfl_xor(send, bit); }
        bit >>= 1;
    }
    float k = a[0];
#pragma unroll
    for (; bit >= 1; bit >>= 1) k += __shfl_xor(k, bit);
    return k;
}
DI float rdlane(float v, int l) { return __builtin_bit_cast(float, __builtin_amdgcn_readlane(__builtin_bit_cast(int, v), l)); }
DI float fexp2(float x) { return __builtin_amdgcn_exp2f(x); }
DI float flog2(float x) { return __builtin_amdgcn_logf(x); }
#define LDS_WAIT() asm volatile("s_waitcnt lgkmcnt(0)" ::: "memory")
#define VM_WAIT() asm volatile("s_waitcnt vmcnt(0)" ::: "memory")

#define XB_TMO      128
#define XB_XCNT(j)  (256  + 64 * (j))
#define XB_XSUB(j)  (1280 + 64 * (j))
#define XB_XGEN(j)  (2304 + 64 * (j))
#define XB_TOP      3328
#define XB_TOPGEN   3392
#define XCD_BAR_WORDS 3456
#define XB_SPIN_CAP (1u << 20)
DI unsigned xb_ld(unsigned* p)              { return __hip_atomic_load(p, __ATOMIC_RELAXED, __HIP_MEMORY_SCOPE_AGENT); }
DI unsigned xb_add(unsigned* p, unsigned v) { return __hip_atomic_fetch_add(p, v, __ATOMIC_RELAXED, __HIP_MEMORY_SCOPE_AGENT); }
DI unsigned xb_xcc_id() { return (unsigned)__builtin_amdgcn_s_getreg((3 << 11) | 20) & 0xFu; }
#define XB_SPIN(cond, bar) do { unsigned _sp = 0; while (cond) { __builtin_amdgcn_s_sleep(1); \
    if ((++_sp & 255u) == 0u) { if (xb_ld(&(bar)[XB_TMO])) break; if (_sp > XB_SPIN_CAP) { atomicAdd(&(bar)[XB_TMO], 1u); break; } } } } while (0)
struct XcdBarrier { unsigned* bar; unsigned x; volatile LAS unsigned* st; };
DI XcdBarrier xcd_barrier_post(unsigned* bar, volatile LAS unsigned* st) {
    XcdBarrier b; b.bar = bar; b.x = xb_xcc_id(); b.st = st;
    if (threadIdx.x == 0) (void)xb_add(&bar[XB_XCNT(b.x)], 1u);
    return b;
}
DI void xcd_barrier_complete(unsigned* bar, unsigned x, unsigned& nloc, unsigned& nx) {
    const unsigned G = gridDim.x * gridDim.y * gridDim.z;
    unsigned sum, cnt, mine, sp = 0u;
    for (;;) {
        sum = 0u; cnt = 0u; mine = 0u;
#pragma unroll
        for (unsigned j = 0; j < 16; ++j) { const unsigned c = xb_ld(&bar[XB_XCNT(j)]); sum += c; cnt += (c > 0u) ? 1u : 0u; mine = (j == x) ? c : mine; }
        if (sum == G) break;
        __builtin_amdgcn_s_sleep(1);
        if ((++sp & 255u) == 0u) { if (xb_ld(&bar[XB_TMO])) break; if (sp > XB_SPIN_CAP) { atomicAdd(&bar[XB_TMO], 1u); break; } }
    }
    nloc = mine > 0u ? mine : 1u; nx = cnt > 0u ? cnt : 1u;
}
template <bool FIRST> DI void xcd_barrier(const XcdBarrier& b) {
    asm volatile("s_waitcnt vmcnt(0)" ::: "memory");
    __syncthreads();
    if (threadIdx.x == 0) {
        unsigned* bar = b.bar;
        __builtin_amdgcn_s_waitcnt(0);
        unsigned nloc = b.st[0], nx = b.st[1];
        if constexpr (FIRST) { if (nloc == 0u) { xcd_barrier_complete(bar, b.x, nloc, nx); b.st[0] = nloc; b.st[1] = nx; } }
        const unsigned old = xb_add(&bar[XB_XSUB(b.x)], 1u);
        const unsigned gen = old / nloc;
        if (old + 1u == (gen + 1u) * nloc) {
            __builtin_amdgcn_fence(__ATOMIC_RELEASE, "agent");
            asm volatile("s_waitcnt vmcnt(0)" ::: "memory");
            const unsigned og = xb_add(&bar[XB_TOP], 1u);
            const unsigned tg = og / nx;
            if (og + 1u == (tg + 1u) * nx) xb_add(&bar[XB_TOPGEN], 1u);
            else XB_SPIN(xb_ld(&bar[XB_TOPGEN]) == tg, bar);
            __builtin_amdgcn_fence(__ATOMIC_ACQUIRE, "agent");
            xb_add(&bar[XB_XGEN(b.x)], 1u);
            asm volatile("s_waitcnt vmcnt(0)" ::: "memory");
        } else {
            XB_SPIN(xb_ld(&bar[XB_XGEN(b.x)]) == gen, bar);
            __builtin_amdgcn_fence(__ATOMIC_ACQUIRE, "agent");
            asm volatile("s_waitcnt vmcnt(0)" ::: "memory");
        }
    }
    __syncthreads();
}

namespace pg8 {
constexpr int BM = 256, BK = 64, HALF = 128, HTB = HALF * BK * 2, STAGE_BYTES = 8 * HTB, NXCD = 8, WGM = 8;
DI int lds_byte(int r, int c) { const int st = (r >> 4) * 2 + (c >> 5), rr = r & 15, cc = c & 31, ob = rr * 64 + cc * 2; return st * 1024 + (ob ^ (((ob >> 9) & 1) << 5)); }
DI void stage_rc(int b, int& R, int& C) { const int st = b / 1024, sb = b % 1024, swz = sb ^ (((sb >> 9) & 1) << 5); R = (st >> 1) * 16 + swz / 64; C = (st & 1) * 32 + (swz % 64) / 2; }
DI int perm32(int rho) { const int n = rho >> 4, i = rho & 15; return 8 * (i >> 2) + 4 * n + (i & 3); }
struct Unit { int pm, pn, eb; };

struct DenseSched {
    int nM, nN, nwg, G, c; const char* Bt; int ldb;
    DI void init(int M, int N, int ldb_bytes, const void* Bt_, int G_, int c_) { nM = M / BM; nN = N / BM; nwg = nM * nN; G = G_; c = c_; Bt = (const char*)Bt_; ldb = ldb_bytes; }
    DI bool next(int i, Unit& u) const {
        const long L = (long)i * G + c; if (L >= nwg) return false;
        int wgid = (int)L; { const int q = nwg / NXCD, r = nwg % NXCD, xcd = wgid % NXCD, off = wgid / NXCD; wgid = (xcd < r ? xcd * (q + 1) : r * (q + 1) + (xcd - r) * q) + off; }
        const int nig = WGM * nN, gid = wgid / nig, fm = gid * WGM, gsz = (nM - fm) < WGM ? (nM - fm) : WGM;
        u.pm = fm + ((wgid % nig) % gsz); u.pn = (wgid % nig) / gsz; u.eb = 0; return true;
    }
    DI unsigned a_row(const Unit& u, int r) const { return (unsigned)(u.pm * BM + r); }
    DI const char* b_base(const Unit& u) const { return Bt + (size_t)u.pn * BM * ldb; }
};
template <bool GATHER> struct MoeSched {
    int G, c, ldb; const char* Bt; size_t estride; const int* tile_e; const int* slot_tok; int nunits;
    DI bool next(int i, Unit& u) const {
        const int L = i * G + c; if (L >= nunits) return false;
        u.pm = L >> 2; u.pn = L & 3; u.eb = __builtin_amdgcn_readfirstlane(__hip_atomic_load(tile_e + u.pm, __ATOMIC_RELAXED, __HIP_MEMORY_SCOPE_AGENT)); return true;
    }
    DI unsigned a_row(const Unit& u, int r) const { if (GATHER) return (unsigned)__hip_atomic_load(slot_tok + u.pm * BM + r, __ATOMIC_RELAXED, __HIP_MEMORY_SCOPE_AGENT); return (unsigned)(u.pm * BM + r); }
    DI const char* b_base(const Unit& u) const { return Bt + (size_t)u.eb * estride + (size_t)u.pn * BM * ldb; }
};

struct EpiProj {
    static constexpr bool PERM = true;
    bf16* O; int ldc; int period, qcols; float qscale, base;
    DI void operator()(const f32x4 (&acc)[2][2][4][2], const Unit& u, int wr, int wc, int fr, int fq) const {
        const int row0 = u.pm * BM + wr * 64 + fr, colt = u.pn * BM;
        const float sc = base * (((colt % period) < qcols) ? qscale : 1.f);
        const int col0 = colt + wc * 32 + 8 * fq;
#pragma unroll
        for (int ai = 0; ai < 2; ++ai)
#pragma unroll
            for (int m = 0; m < 4; ++m) { bf16* rowp = O + (size_t)(row0 + ai * HALF + m * 16) * ldc + col0;
#pragma unroll
                for (int bj = 0; bj < 2; ++bj) { const f32x4 v0 = acc[ai][bj][m][0] * sc, v1 = acc[ai][bj][m][1] * sc;
                    u32x4 w; w.x = pk2(v0[0], v0[1]); w.y = pk2(v0[2], v0[3]); w.z = pk2(v1[0], v1[1]); w.w = pk2(v1[2], v1[3]);
                    *(u32x4*)(rowp + bj * HALF) = w; } }
    }
};
constexpr float MOE_S_W1 = 32.f, MOE_S_ACT = 8.f, MOE_S_W2 = 16.f;
struct EpiMoe1 {
    static constexpr bool PERM = true;
    unsigned char* O;
    DI void operator()(const f32x4 (&acc)[2][2][4][2], const Unit& u, int wr, int wc, int fr, int fq) const {
        const int row0 = u.pm * BM + wr * 64 + fr, col0 = u.pn * 128 + wc * 32 + 8 * fq;
#pragma unroll
        for (int ai = 0; ai < 2; ++ai)
#pragma unroll
            for (int m = 0; m < 4; ++m) { unsigned char* rowp = O + (size_t)(row0 + ai * HALF + m * 16) * MOE_FF + col0;
                float r[8];
#pragma unroll
                for (int n = 0; n < 2; ++n)
#pragma unroll
                    for (int e = 0; e < 4; ++e) { const float g = acc[ai][0][m][n][e] * (1.f / MOE_S_W1), up = acc[ai][1][m][n][e] * (MOE_S_ACT / MOE_S_W1);
                        r[n * 4 + e] = g * __builtin_amdgcn_rcpf(1.f + fexp2(-g * LOG2E)) * up; }
                u32x2 w; w.x = pk4_fp8(r[0], r[1], r[2], r[3]); w.y = pk4_fp8(r[4], r[5], r[6], r[7]);
                *(u32x2*)rowp = w; }
    }
};
constexpr float MOE_S_Y = 16.f;
struct EpiY8 {
    static constexpr bool PERM = true;
    unsigned char* O; float s;
    DI void operator()(const f32x4 (&acc)[2][2][4][2], const Unit& u, int wr, int wc, int fr, int fq) const {
        const int row0 = u.pm * BM + wr * 64 + fr, col0 = u.pn * BM + wc * 32 + 8 * fq;
#pragma unroll
        for (int ai = 0; ai < 2; ++ai)
#pragma unroll
            for (int m = 0; m < 4; ++m) { unsigned char* rowp = O + (size_t)(row0 + ai * HALF + m * 16) * D + col0;
#pragma unroll
                for (int bj = 0; bj < 2; ++bj) { const f32x4 v0 = acc[ai][bj][m][0] * s, v1 = acc[ai][bj][m][1] * s;
                    u32x2 w; w.x = pk4_fp8(v0[0], v0[1], v0[2], v0[3]); w.y = pk4_fp8(v1[0], v1[1], v1[2], v1[3]);
                    *(u32x2*)(rowp + bj * HALF) = w; } }
    }
};
template <bool RF32> struct EpiResid {
    static constexpr bool PERM = true;
    const void* resid; bf16* out; const float* gate; float gscale; float* ssp;
    DI void operator()(const f32x4 (&acc)[2][2][4][2], const Unit& u, int wr, int wc, int fr, int fq) const {
        const int row0 = u.pm * BM + wr * 64 + fr, col0 = u.pn * BM + wc * 32 + 8 * fq;
        const float* gv = gate + (size_t)((u.pm * BM) / SEQ) * 6144 + col0;
        f32x4 g[2][2];
#pragma unroll
        for (int bj = 0; bj < 2; ++bj)
#pragma unroll
            for (int n = 0; n < 2; ++n) g[bj][n] = *(const f32x4*)(gv + bj * HALF + 4 * n) * gscale;
#pragma unroll
        for (int ai = 0; ai < 2; ++ai)
#pragma unroll
            for (int m = 0; m < 4; ++m) { const size_t off = (size_t)(row0 + ai * HALF + m * 16) * D + col0; float sq = 0.f;
#pragma unroll
                for (int bj = 0; bj < 2; ++bj) { f32x4 r0, r1;
                    if (RF32) { r0 = *(const f32x4*)((const float*)resid + off + bj * HALF); r1 = *(const f32x4*)((const float*)resid + off + bj * HALF + 4); }
                    else { const u32x4 w = *(const u32x4*)((const bf16*)resid + off + bj * HALF); r0 = (f32x4){bflo(w.x), bfhi(w.x), bflo(w.y), bfhi(w.y)}; r1 = (f32x4){bflo(w.z), bfhi(w.z), bflo(w.w), bfhi(w.w)}; }
                    const f32x4 v0 = r0 + g[bj][0] * acc[ai][bj][m][0], v1 = r1 + g[bj][1] * acc[ai][bj][m][1];
                    u32x4 o; o.x = pk2(v0[0], v0[1]); o.y = pk2(v0[2], v0[3]); o.z = pk2(v1[0], v1[1]); o.w = pk2(v1[2], v1[3]);
                    *(u32x4*)(out + off + bj * HALF) = o;
#pragma unroll
                    for (int e = 0; e < 4; ++e) { const float a = bflo(o[e]), b2 = bfhi(o[e]); sq += a * a + b2 * b2; } }
                sq += __shfl_xor(sq, 16); sq += __shfl_xor(sq, 32);
                if (fq == 0) ssp[(size_t)(row0 + ai * HALF + m * 16) * 16 + u.pn * 4 + wc] = sq;
                if (m & 1) asm volatile("" ::: "memory"); }
    }
};

template <class Epi, class Sched, bool ALIGN_EPI, bool FP8 = false>
DI void gemm_phase(const int tid, LAS unsigned char* lds, const char* gA, const int lda  , const int nt, const Sched& S, const Epi& E) {
    const int wid = __builtin_amdgcn_readfirstlane(tid >> 6), lane = tid & 63, wr = wid >> 2, wc = wid & 3, fr = lane & 15, fq = lane >> 4;
    int Rr[2], Cc[2]; unsigned voffB[2];
#pragma unroll
    for (int i = 0; i < 2; ++i) { stage_rc(tid * 16 + i * 8192, Rr[i], Cc[i]); const int Rb = Epi::PERM ? ((Rr[i] & ~31) + perm32(Rr[i] & 31)) : Rr[i];
        voffB[i] = (unsigned)(Rb * S.ldb + Cc[i] * 2); }
    const size_t kstep = (size_t)(BK * 2);
    const size_t hstepB = (size_t)HALF * S.ldb;
    const unsigned ldsw = (unsigned)wid * 1024u;
    const int aoff = lds_byte(wr * 64 + fr, fq * 8), boff = lds_byte(wc * 32 + fr, fq * 8);
#define PG8_SA(b, h) (((b) * 2 + (h)) * HTB)
#define PG8_SB(b, h) ((4 + (b) * 2 + (h)) * HTB)
#define PG8_STAGEB(bufoff, gbase) do { _Pragma("unroll") for (int _i = 0; _i < 2; ++_i) \
        __builtin_amdgcn_global_load_lds((const unsigned*)((const char*)(gbase) + voffB[_i]), (LAS unsigned*)(lds + (bufoff) + ldsw + _i * 8192), 16, 0, 0); } while (0)
#define PG8_STAGEA(bufoff, gbase, o0, o1) do { \
        __builtin_amdgcn_global_load_lds((const unsigned*)((const char*)(gbase) + (o0)), (LAS unsigned*)(lds + (bufoff) + ldsw), 16, 0, 0); \
        __builtin_amdgcn_global_load_lds((const unsigned*)((const char*)(gbase) + (o1)), (LAS unsigned*)(lds + (bufoff) + ldsw + 8192), 16, 0, 0); } while (0)
#define PG8_LD8(off) __builtin_shufflevector(*(const LAS i32x4*)(lds + (off)), *(const LAS i32x4*)(lds + (off) + 1024), 0, 1, 2, 3, 4, 5, 6, 7)
#define PG8_LDA(dst, b, h) do { if constexpr (FP8) { _Pragma("unroll") for (int m = 0; m < 4; ++m) dst##8[m] = PG8_LD8(PG8_SA(b, h) + aoff + m * 2048); } \
        else { _Pragma("unroll") for (int m = 0; m < 4; ++m) _Pragma("unroll") for (int k = 0; k < 2; ++k) dst[m][k] = *(const LAS bf16x8*)(lds + PG8_SA(b, h) + aoff + m * 2048 + k * 1024); } } while (0)
#define PG8_LDB(dst, b, h) do { if constexpr (FP8) { _Pragma("unroll") for (int n = 0; n < 2; ++n) dst##8[n] = PG8_LD8(PG8_SB(b, h) + boff + n * 2048); } \
        else { _Pragma("unroll") for (int n = 0; n < 2; ++n) _Pragma("unroll") for (int k = 0; k < 2; ++k) dst[n][k] = *(const LAS bf16x8*)(lds + PG8_SB(b, h) + boff + n * 2048 + k * 1024); } } while (0)
#define PG8_MMA(ai, bj, At, Bt) do { __builtin_amdgcn_s_setprio(1); \
        if constexpr (FP8) { _Pragma("unroll") for (int m = 0; m < 4; ++m) _Pragma("unroll") for (int n = 0; n < 2; ++n) \
            acc[ai][bj][m][n] = __builtin_amdgcn_mfma_scale_f32_16x16x128_f8f6f4(Bt##8[n], At##8[m], acc[ai][bj][m][n], 0, 0, 0, 0x7f7f7f7f, 0, 0x7f7f7f7f); } \
        else { _Pragma("unroll") for (int m = 0; m < 4; ++m) _Pragma("unroll") for (int n = 0; n < 2; ++n) _Pragma("unroll") for (int k = 0; k < 2; ++k) \
            acc[ai][bj][m][n] = __builtin_amdgcn_mfma_f32_16x16x32_bf16(Bt[n][k], At[m][k], acc[ai][bj][m][n], 0, 0, 0); } \
        __builtin_amdgcn_s_setprio(0); } while (0)
#define PG8_WAIT_V(n) asm volatile("s_waitcnt vmcnt(" #n ")" ::: "memory")
#define PG8_WAIT_L(n) asm volatile("s_waitcnt lgkmcnt(" #n ")" ::: "memory")
#define PG8_BAR __builtin_amdgcn_s_barrier()
#define PG8_SCHED __builtin_amdgcn_sched_barrier(0)
    Unit cur, nxt; int ui = 0;
    if (!S.next(0, cur)) return;
    f32x4 acc[2][2][4][2];
#pragma unroll
    for (int a = 0; a < 2; ++a)
#pragma unroll
        for (int b = 0; b < 2; ++b)
#pragma unroll
            for (int m = 0; m < 4; ++m)
#pragma unroll
                for (int n = 0; n < 2; ++n) acc[a][b][m][n] = (f32x4){0.f, 0.f, 0.f, 0.f};
    bf16x8 At[4][2], B0[2][2], B1[2][2]; i32x8 At8[4], B08[2], B18[2];
    unsigned vA[2][2], vN[2][2];
#pragma unroll
    for (int h = 0; h < 2; ++h)
#pragma unroll
        for (int i = 0; i < 2; ++i) vA[h][i] = S.a_row(cur, h * HALF + Rr[i]) * (unsigned)lda + (unsigned)Cc[i] * 2u;
    const char* cB = S.b_base(cur);
    PG8_STAGEB(PG8_SB(0, 0), cB); PG8_STAGEB(PG8_SB(0, 1), cB + hstepB); PG8_STAGEA(PG8_SA(0, 0), gA, vA[0][0], vA[0][1]); PG8_STAGEA(PG8_SA(0, 1), gA, vA[1][0], vA[1][1]);
    if (wr == 1) PG8_BAR;
    PG8_WAIT_V(2); PG8_BAR;
    PG8_STAGEB(PG8_SB(1, 0), cB + kstep); PG8_STAGEA(PG8_SA(1, 0), gA + kstep, vA[0][0], vA[0][1]); PG8_STAGEB(PG8_SB(1, 1), cB + hstepB + kstep);
    PG8_WAIT_V(6); PG8_BAR;
    for (;;) {
        const bool has_next = S.next(ui + 1, nxt);
        const char* nB = has_next ? S.b_base(nxt) : cB;
#pragma unroll
        for (int h = 0; h < 2; ++h)
#pragma unroll
            for (int i = 0; i < 2; ++i) vN[h][i] = has_next ? S.a_row(nxt, h * HALF + Rr[i]) * (unsigned)lda + (unsigned)Cc[i] * 2u : vA[h][i];
#pragma unroll 1
        for (int t = 0; t < nt; t += 2) {
            const bool last = (t == nt - 2);
            const char* a1 = gA + (size_t)(t + 1) * kstep;
            const char* a2 = gA + (last ? (size_t)0 : (size_t)(t + 2) * kstep); const char* b2 = last ? nB : cB + (size_t)(t + 2) * kstep;
            const char* a3 = a2 + kstep; const char* b3 = b2 + kstep;
            PG8_LDB(B0, 0, 0); PG8_LDB(B1, 0, 1); PG8_SCHED; PG8_LDA(At, 0, 0); PG8_STAGEA(PG8_SA(1, 1), a1, vA[1][0], vA[1][1]);
            if (last) {
#pragma unroll
                for (int h = 0; h < 2; ++h)
#pragma unroll
                    for (int i = 0; i < 2; ++i) vA[h][i] = vN[h][i]; }
            PG8_WAIT_V(8); PG8_WAIT_L(0); PG8_BAR; PG8_MMA(0, 0, At, B0); PG8_MMA(0, 1, At, B1); PG8_BAR; PG8_SCHED;
            PG8_LDA(At, 0, 1); PG8_STAGEB(PG8_SB(0, 0), b2); PG8_STAGEB(PG8_SB(0, 1), b2 + hstepB); PG8_STAGEA(PG8_SA(0, 0), a2, vA[0][0], vA[0][1]);
            PG8_WAIT_V(8); PG8_WAIT_L(0); PG8_BAR; PG8_MMA(1, 0, At, B0); PG8_MMA(1, 1, At, B1); PG8_BAR; PG8_SCHED;
            PG8_LDB(B0, 1, 0); PG8_LDB(B1, 1, 1); PG8_SCHED; PG8_LDA(At, 1, 0); PG8_STAGEA(PG8_SA(0, 1), a2, vA[1][0], vA[1][1]);
            PG8_WAIT_V(8); PG8_WAIT_L(0); PG8_BAR; PG8_MMA(0, 0, At, B0); PG8_MMA(0, 1, At, B1); PG8_BAR; PG8_SCHED;
            PG8_LDA(At, 1, 1); PG8_STAGEB(PG8_SB(1, 0), b3); PG8_STAGEB(PG8_SB(1, 1), b3 + hstepB); PG8_STAGEA(PG8_SA(1, 0), a3, vA[0][0], vA[0][1]);
            PG8_WAIT_V(8); PG8_WAIT_L(0); PG8_BAR; PG8_MMA(1, 0, At, B0); PG8_MMA(1, 1, At, B1); PG8_BAR; PG8_SCHED;
        }
        if constexpr (ALIGN_EPI) { if (wr == 0) PG8_BAR; }
        E(acc, cur, wr, wc, fr, fq);
        if (!has_next) break;
#pragma unroll
        for (int a = 0; a < 2; ++a)
#pragma unroll
            for (int b = 0; b < 2; ++b)
#pragma unroll
                for (int m = 0; m < 4; ++m)
#pragma unroll
                    for (int n = 0; n < 2; ++n) acc[a][b][m][n] = (f32x4){0.f, 0.f, 0.f, 0.f};
        cur = nxt; cB = nB; ++ui;
        if constexpr (ALIGN_EPI) { if (wr == 1) PG8_BAR; }
    }
    PG8_WAIT_V(0);
    if constexpr (!ALIGN_EPI) { if (wr == 0) PG8_BAR; }
    PG8_BAR;
#undef PG8_SA
#undef PG8_SB
#undef PG8_STAGEA
#undef PG8_STAGEB
#undef PG8_LDA
#undef PG8_LDB
#undef PG8_MMA
#undef PG8_LD8
#undef PG8_WAIT_V
#undef PG8_WAIT_L
#undef PG8_BAR
#undef PG8_SCHED
}
}

struct Params {
    const float* in[26];
    float* out; unsigned char* ws;
    int ph_lo, ph_hi;
};
enum { I_X = 0, I_C, I_ADAW, I_ADAB, I_NORMG, I_FINALG, I_SBWIN, I_SBWOUT, I_GLAWIN, I_GLAGU, I_GLABG, I_GLANG, I_GLAWOUT, I_CONVWIN, I_CONVW, I_CONVB, I_CONVWOUT,
       I_DILWIN, I_DILWOUT, I_MGRPW, I_MGRPB, I_MEXPW, I_MEXPB, I_MWG, I_MWU, I_MWD };
struct ParamsG { const GAS float* in[26]; GAS float* out; GAS unsigned char* ws; int ph_lo, ph_hi; };
static_assert(sizeof(ParamsG) == sizeof(Params), "ParamsG mirrors Params");
typedef __attribute__((address_space(4))) ParamsG KParams;
#define PIN(i) ((const float*)P.in[(i)])
struct Ctx {
    LAS unsigned char* lds; volatile LAS unsigned* MISC;
    int tid, lane, wave, G, bid;
    const KParams* p; unsigned char* ws;
};

DI void transpose_item(const float* W, int ldw  , int k0, int n0, bf16* WT, size_t drow0, int ldk  , LAS float* scr, int lane) {
    float tv[32];
#pragma unroll
    for (int i = 0; i < 32; ++i) tv[i] = __builtin_nontemporal_load(W + (size_t)(k0 + 2 * i + (lane >> 5)) * ldw + n0 + (lane & 31));
#pragma unroll
    for (int i = 0; i < 32; ++i) scr[(2 * i + (lane >> 5)) * 33 + (lane & 31)] = tv[i];
    LDS_WAIT();
    const int c = lane & 7;
#pragma unroll
    for (int j = 0; j < 4; ++j) { const int n = (lane >> 3) + 8 * j; const LAS float* s = scr + (8 * c) * 33 + n;
        u32x4 o; o.x = pk2(s[0 * 33], s[1 * 33]); o.y = pk2(s[2 * 33], s[3 * 33]); o.z = pk2(s[4 * 33], s[5 * 33]); o.w = pk2(s[6 * 33], s[7 * 33]);
        *(u32x4*)(WT + (drow0 + n) * (size_t)ldk + k0 + 8 * c) = o; }
    LDS_WAIT();
}
DI void transpose_matrix_fp8(Ctx& F, const float* W, int K, int N, int ldw, unsigned char* WT, float scale, int gw, int NGW);
DI void transpose_matrix(Ctx& F, const float* W, int K, int N, int ldw, int ncol0, bf16* WT, int gw, int NGW) {
    LAS float* scr = (LAS float*)(F.lds + F.wave * 16384);
    const int nblk = N / 32, nitems = (K / 64) * nblk;
    for (int it = gw; it < nitems; it += NGW) { const int kb = it / nblk, nb = it % nblk;
        transpose_item(W, ldw, 64 * kb, ncol0 + 32 * nb, WT, (size_t)(32 * nb), K, scr, F.lane); }
}

DI void ph_prologue(Ctx& F) {
    const KParams& P = *F.p; unsigned char* ws = F.ws;
    const int gw = F.bid * NWAVES + F.wave, NGW = F.G * NWAVES;
    if (in_fp8(0)) transpose_matrix_fp8(F, PIN(I_SBWIN), D, 3072, 3072, ws + W_SBIN, pg8::MOE_S_W1, gw, NGW); else transpose_matrix(F, PIN(I_SBWIN), D, 3072, 3072, 0, (bf16*)(ws + W_SBIN), gw, NGW);
    if (out_fp8(0)) transpose_matrix_fp8(F, PIN(I_SBWOUT), D, D, D, ws + W_SBOUT, pg8::MOE_S_W1, gw, NGW); else transpose_matrix(F, PIN(I_SBWOUT), D, D, D, 0, (bf16*)(ws + W_SBOUT), gw, NGW);
    if (in_fp8(1)) transpose_matrix_fp8(F, PIN(I_GLAWIN), D, 3072, 3088, ws + W_GLAIN, pg8::MOE_S_W1, gw, NGW); else transpose_matrix(F, PIN(I_GLAWIN), D, 3072, 3088, 0, (bf16*)(ws + W_GLAIN), gw, NGW);
    if (out_fp8(1)) transpose_matrix_fp8(F, PIN(I_GLAWOUT), D, D, D, ws + W_GLAOUT, pg8::MOE_S_W1, gw, NGW); else transpose_matrix(F, PIN(I_GLAWOUT), D, D, D, 0, (bf16*)(ws + W_GLAOUT), gw, NGW);
    if (in_fp8(2)) transpose_matrix_fp8(F, PIN(I_CONVWIN), D, 3072, 3072, ws + W_CONVIN, pg8::MOE_S_W1, gw, NGW); else transpose_matrix(F, PIN(I_CONVWIN), D, 3072, 3072, 0, (bf16*)(ws + W_CONVIN), gw, NGW);
    if (out_fp8(2)) transpose_matrix_fp8(F, PIN(I_CONVWOUT), D, D, D, ws + W_CONVOUT, pg8::MOE_S_W1, gw, NGW); else transpose_matrix(F, PIN(I_CONVWOUT), D, D, D, 0, (bf16*)(ws + W_CONVOUT), gw, NGW);
    if (in_fp8(3)) transpose_matrix_fp8(F, PIN(I_DILWIN), D, 4608, 4608, ws + W_DILIN, pg8::MOE_S_W1, gw, NGW); else transpose_matrix(F, PIN(I_DILWIN), D, 4608, 4608, 0, (bf16*)(ws + W_DILIN), gw, NGW);
    if (out_fp8(3)) transpose_matrix_fp8(F, PIN(I_DILWOUT), 512, D, D, ws + W_DILOUT, pg8::MOE_S_W1, gw, NGW); else transpose_matrix(F, PIN(I_DILWOUT), 512, D, D, 0, (bf16*)(ws + W_DILOUT), gw, NGW);
    const float* c = PIN(I_C); const float* aw = PIN(I_ADAW); float* modp = (float*)(ws + WS_MODP);
    LAS float* scond = (LAS float*)(F.lds + 126976);
    for (int i = F.tid; i < NB * D; i += NTHR) { const float cv = c[i]; scond[i] = cv / (1.f + __expf(-cv)); }
    __syncthreads();
    for (int it = gw; it < DEPTH * 96 * KSPLIT; it += NGW) {
        const int ks = it % KSPLIT, jb = (it / KSPLIT) % 96, l = it / (KSPLIT * 96);
        const int j = jb * 64 + F.lane; const int k0 = ks * (D / KSPLIT);
        float a[NB];
#pragma unroll
        for (int b = 0; b < NB; ++b) a[b] = 0.f;
        const float* wp = aw + ((size_t)l * D + k0) * 6144 + j;
#pragma unroll 16
        for (int k = 0; k < D / KSPLIT; ++k) { const float w = __builtin_nontemporal_load(wp + (size_t)k * 6144);
#pragma unroll
            for (int b = 0; b < NB; ++b) a[b] += scond[b * D + k0 + k] * w; }
#pragma unroll
        for (int b = 0; b < NB; ++b) modp[(((size_t)ks * DEPTH + l) * NB + b) * 6144 + j] = a[b];
    }
}
DI float mod_sum(const float* modp, const float* adab, int l, int b, int j) {
    float s = adab[l * 6144 + j];
#pragma unroll
    for (int ks = 0; ks < KSPLIT; ++ks) s += modp[(((size_t)ks * DEPTH + l) * NB + b) * 6144 + j];
    return s;
}

DI void mod_vec(const float* modp, const float* adab, int l, int b, int chunk, int lane, f32x4 (&out)[4]) {
#pragma unroll
    for (int j = 0; j < 4; ++j) out[j] = *(const f32x4*)(adab + l * 6144 + chunk * D + 4 * lane + 256 * j);
#pragma unroll 1
    for (int ks = 0; ks < KSPLIT; ++ks) { const float* p = modp + (((size_t)ks * DEPTH + l) * NB + b) * 6144 + chunk * D + 4 * lane;
#pragma unroll
        for (int j = 0; j < 4; ++j) out[j] = out[j] + *(const f32x4*)(p + 256 * j); }
}
DI void mod_vec_f(const float* modf, int l, int b, int chunk, int lane, f32x4 (&out)[4]) {
    const float* p = modf + ((size_t)l * NB + b) * 6144 + chunk * D + 4 * lane;
#pragma unroll
    for (int j = 0; j < 4; ++j) out[j] = *(const f32x4*)(p + 256 * j);
}
DI void row_load(const float* row, int lane, f32x4 (&v)[4]) {
#pragma unroll
    for (int j = 0; j < 4; ++j) v[j] = *(const f32x4*)(row + 4 * lane + 256 * j);
}
DI void row_load_bf16(const bf16* row, int lane, f32x4 (&v)[4]) {
#pragma unroll
    for (int j = 0; j < 4; ++j) { const u32x2 w = *(const u32x2*)(row + 4 * lane + 256 * j); v[j] = (f32x4){bflo(w.x), bfhi(w.x), bflo(w.y), bfhi(w.y)}; }
}
DI void row_store_bf16(bf16* row, int lane, const f32x4 (&v)[4]) {
#pragma unroll
    for (int j = 0; j < 4; ++j) { u32x2 w; w.x = pk2(v[j][0], v[j][1]); w.y = pk2(v[j][2], v[j][3]); *(u32x2*)(row + 4 * lane + 256 * j) = w; }
}
DI float row_rstd(const f32x4 (&v)[4]) {
    float s = 0.f;
#pragma unroll
    for (int j = 0; j < 4; ++j) s += (v[j][0] * v[j][0] + v[j][1] * v[j][1]) + (v[j][2] * v[j][2] + v[j][3] * v[j][3]);
    return 1.f / sqrtf(wave_sum(s) * (1.f / D) + RMS_EPS);
}
DI void moe_combine_row(Ctx& F, int row, const f32x4 (&g2)[4], f32x4 (&v)[4]) {
    unsigned char* ws = F.ws;
    const int* ts = (const int*)(ws + WS_TOKS); const float* tw = (const float*)(ws + WS_TOKW); const bf16* yb = (const bf16*)(ws + WS_YB);
    const int s0 = __hip_atomic_load(ts + row * 2, __ATOMIC_RELAXED, __HIP_MEMORY_SCOPE_AGENT), s1 = __hip_atomic_load(ts + row * 2 + 1, __ATOMIC_RELAXED, __HIP_MEMORY_SCOPE_AGENT);
    const float w0 = __hip_atomic_load(tw + row * 2, __ATOMIC_RELAXED, __HIP_MEMORY_SCOPE_AGENT), w1 = __hip_atomic_load(tw + row * 2 + 1, __ATOMIC_RELAXED, __HIP_MEMORY_SCOPE_AGENT);
#pragma unroll
    for (int j = 0; j < 4; ++j) { const u32x2 a = *(const u32x2*)(yb + (size_t)s0 * D + 4 * F.lane + 256 * j), b = *(const u32x2*)(yb + (size_t)s1 * D + 4 * F.lane + 256 * j);
        f32x4 y; y[0] = w0 * bflo(a.x) + w1 * bflo(b.x); y[1] = w0 * bfhi(a.x) + w1 * bfhi(b.x); y[2] = w0 * bflo(a.y) + w1 * bflo(b.y); y[3] = w0 * bfhi(a.y) + w1 * bfhi(b.y);
        v[j] = v[j] + g2[j] * y; }
}
struct RowIn { f32x4 x[4]; unsigned ya[4], yb[4]; };
template <bool COMB, bool XF32> DI void rowin_load(RowIn& R, const void* xrow, const unsigned char* ybase, int s0, int s1, int lane) {
#pragma unroll
    for (int j = 0; j < 4; ++j) { if (XF32) R.x[j] = *(const f32x4*)((const float*)xrow + 4 * lane + 256 * j);
        else { const u32x2 w = *(const u32x2*)((const bf16*)xrow + 4 * lane + 256 * j); R.x[j] = (f32x4){bflo(w.x), bfhi(w.x), bflo(w.y), bfhi(w.y)}; } }
    if (COMB) {
#pragma unroll
        for (int j = 0; j < 4; ++j) { R.ya[j] = *(const unsigned*)(ybase + (size_t)s0 * D + 4 * lane + 256 * j); R.yb[j] = *(const unsigned*)(ybase + (size_t)s1 * D + 4 * lane + 256 * j); }
    }
}
DI void rowin_combine(const RowIn& R, float w0, float w1, const f32x4 (&g2)[4], f32x4 (&v)[4]) {
#pragma unroll
    for (int j = 0; j < 4; ++j) { const int a = (int)R.ya[j], b = (int)R.yb[j];
        const f32x2 a01 = __builtin_amdgcn_cvt_pk_f32_fp8(a, false), a23 = __builtin_amdgcn_cvt_pk_f32_fp8(a, true), b01 = __builtin_amdgcn_cvt_pk_f32_fp8(b, false), b23 = __builtin_amdgcn_cvt_pk_f32_fp8(b, true);
        f32x4 y; y[0] = w0 * a01[0] + w1 * b01[0]; y[1] = w0 * a01[1] + w1 * b01[1]; y[2] = w0 * a23[0] + w1 * b23[0]; y[3] = w0 * a23[1] + w1 * b23[1];
        v[j] = R.x[j] + g2[j] * y; }
}
DI int rdlane_i(int v, int l) { return __builtin_amdgcn_readlane(v, l); }
DI void transpose_item_fp8(const float* W, int ldw, int k0, int n0, unsigned char* WT, size_t drow0, int ldk  , float scale, LAS float* scr, int lane) {
    float tv[32];
#pragma unroll
    for (int i = 0; i < 32; ++i) tv[i] = __builtin_nontemporal_load(W + (size_t)(k0 + 2 * i + (lane >> 5)) * ldw + n0 + (lane & 31));
#pragma unroll
    for (int i = 0; i < 32; ++i) scr[(2 * i + (lane >> 5)) * 33 + (lane & 31)] = tv[i] * scale;
    LDS_WAIT();
    const int n = lane >> 1, half = lane & 1; const LAS float* sp = scr + (32 * half) * 33 + n;
    u32x4 o0, o1;
#pragma unroll
    for (int q = 0; q < 4; ++q) { o0[q] = pk4_fp8(sp[(4 * q) * 33], sp[(4 * q + 1) * 33], sp[(4 * q + 2) * 33], sp[(4 * q + 3) * 33]);
        o1[q] = pk4_fp8(sp[(16 + 4 * q) * 33], sp[(16 + 4 * q + 1) * 33], sp[(16 + 4 * q + 2) * 33], sp[(16 + 4 * q + 3) * 33]); }
    unsigned char* dst = WT + (drow0 + n) * (size_t)ldk + k0 + 32 * half;
    *(u32x4*)dst = o0; *(u32x4*)(dst + 16) = o1;
    LDS_WAIT();
}
DI void transpose_matrix_fp8(Ctx& F, const float* W, int K, int N, int ldw, unsigned char* WT, float scale, int gw, int NGW) {
    LAS float* scr = (LAS float*)(F.lds + F.wave * 16384);
    const int nblk = N / 32, nitems = (K / 64) * nblk;
    for (int it = gw; it < nitems; it += NGW) { const int kb = it / nblk, nb = it % nblk;
        transpose_item_fp8(W, ldw, 64 * kb, 32 * nb, WT, (size_t)(32 * nb), K, scale, scr, F.lane); }
}
DI void moe_weight_convert(Ctx& F, int l, int gw, int NGW) {
    const KParams& P = *F.p; unsigned char* ws = F.ws;
    LAS float* scr = (LAS float*)(F.lds + F.wave * 16384);
    unsigned char* W1T = ws + WS_W1T; unsigned char* W2T = ws + WS_W2T;
    const int per_e = 256, n1 = MOE_E * 2 * per_e;
    for (int it = gw; it < n1; it += NGW) { const int e = it / (2 * per_e), r = it % (2 * per_e), half = r / per_e, q = r % per_e, kb = q / 16, nb = q % 16;
        const float* W = (half ? PIN(I_MWU) : PIN(I_MWG)) + ((size_t)l * MOE_E + e) * D * MOE_FF;
        const int n0 = 32 * nb; const size_t drow0 = (size_t)e * 1024 + (size_t)(n0 / 128) * 256 + half * 128 + (n0 % 128);
        transpose_item_fp8(W, MOE_FF, 64 * kb, n0, W1T, drow0, D, pg8::MOE_S_W1, scr, F.lane); }
    for (int it = gw; it < MOE_E * per_e; it += NGW) { const int e = it / per_e, q = it % per_e, kb = q / 32, nb = q % 32;
        const float* W = PIN(I_MWD) + ((size_t)l * MOE_E + e) * MOE_FF * D;
        transpose_item_fp8(W, D, 64 * kb, 32 * nb, W2T, (size_t)e * 1024 + 32 * nb, MOE_FF, pg8::MOE_S_W2, scr, F.lane); }
}

DI void ph_norm1(Ctx& F, int l) {
    const KParams& P = *F.p; unsigned char* ws = F.ws;
    const int gw = F.bid * NWAVES + F.wave, NGW = F.G * NWAVES;
    const float* modp = (const float*)(ws + WS_MODP); float* modf = (float*)(ws + WS_MODF);
    if (l == 0) {
        for (int i = F.bid * NTHR + F.tid; i < DEPTH * NB * 6144; i += F.G * NTHR) { const int j = i % 6144, b = (i / 6144) % NB, ll = i / (6144 * NB); modf[i] = mod_sum(modp, PIN(I_ADAB), ll, b, j); }
    }
    const bool gla = (l == 1);
    LAS float* wgd = (LAS float*)F.lds;
    if (gla) { const float* w = PIN(I_GLAWIN);
        for (int idx = F.tid; idx < 16 * D; idx += NTHR) { const int c = idx & (D - 1), o = idx >> 10; wgd[idx] = w[(size_t)c * 3088 + 3072 + o]; }
        __syncthreads(); }
    const float* xin0 = PIN(I_X); bf16* XB = (bf16*)(ws + WS_XB);
    unsigned char* HO8 = ws + WS_HO; float* gdn = (float*)(ws + WS_GDOWN);
    const float* ng = PIN(I_NORMG) + (size_t)(l * 2 + 0) * D;
    for (int blk = gw; blk < T / 32; blk += NGW) {
        const int row0 = blk * 32, b = row0 / SEQ;
        f32x4 gm[4], sh[4], g2[4];
        if (l == 0) { mod_vec(modp, PIN(I_ADAB), l, b, 0, F.lane, sh); mod_vec(modp, PIN(I_ADAB), l, b, 1, F.lane, gm); }
        else { mod_vec_f(modf, l, b, 0, F.lane, sh); mod_vec_f(modf, l, b, 1, F.lane, gm); }
#pragma unroll
        for (int j = 0; j < 4; ++j) gm[j] = *(const f32x4*)(ng + 4 * F.lane + 256 * j) * (gm[j] + 1.f);
        if (l > 0) mod_vec_f(modf, l - 1, b, 5, F.lane, g2);
        else {
#pragma unroll
            for (int j = 0; j < 4; ++j) g2[j] = (f32x4){0.f, 0.f, 0.f, 0.f}; }
        const int* ts = (const int*)(ws + WS_TOKS); const float* tw = (const float*)(ws + WS_TOKW); const unsigned char* ybp = ws + WS_YB;
        int sl0 = 0, sl1 = 0; float wl0 = 0.f, wl1 = 0.f;
        if (l > 0) { const int rw = row0 + (F.lane & 31);
            sl0 = __hip_atomic_load(ts + rw * 2, __ATOMIC_RELAXED, __HIP_MEMORY_SCOPE_AGENT); sl1 = __hip_atomic_load(ts + rw * 2 + 1, __ATOMIC_RELAXED, __HIP_MEMORY_SCOPE_AGENT);
            wl0 = __hip_atomic_load(tw + rw * 2, __ATOMIC_RELAXED, __HIP_MEMORY_SCOPE_AGENT); wl1 = __hip_atomic_load(tw + rw * 2 + 1, __ATOMIC_RELAXED, __HIP_MEMORY_SCOPE_AGENT); }
        RowIn Rn, Rn2;
#define N1_LOAD(R, rr_) do { if (l > 0) rowin_load<true, false>(R, XB + (size_t)(row0 + (rr_)) * D, ybp, rdlane_i(sl0, (rr_)), rdlane_i(sl1, (rr_)), F.lane); else rowin_load<false, true>(R, xin0 + (size_t)(row0 + (rr_)) * D, ybp, 0, 0, F.lane); } while (0)
        N1_LOAD(Rn, 0); N1_LOAD(Rn2, 1);
        for (int r = 0; r < 32; ++r) { const int row = row0 + r;
            RowIn Rc = Rn; Rn = Rn2;
            if (r + 2 < 32) N1_LOAD(Rn2, r + 2);
            f32x4 v[4];
            if (l > 0) { rowin_combine(Rc, rdlane(wl0, r) * (1.f / pg8::MOE_S_Y), rdlane(wl1, r) * (1.f / pg8::MOE_S_Y), g2, v); row_store_bf16(XB + (size_t)row * D, F.lane, v); }
            else {
#pragma unroll
                for (int j = 0; j < 4; ++j) v[j] = Rc.x[j]; }
            const float rstd = row_rstd(v);
#pragma unroll
            for (int j = 0; j < 4; ++j) v[j] = v[j] * rstd * gm[j] + sh[j];
            if (in_fp8(l)) { unsigned* hrow = (unsigned*)(HO8 + (size_t)row * D);
#pragma unroll
              for (int j = 0; j < 4; ++j) hrow[F.lane + 64 * j] = pk4_fp8(v[j][0], v[j][1], v[j][2], v[j][3]); }
            else row_store_bf16((bf16*)HO8 + (size_t)row * D, F.lane, v);
            if (gla) {
                float ga[16];
#pragma unroll
                for (int o = 0; o < 16; ++o) { float s = 0.f;
#pragma unroll
                    for (int j = 0; j < 4; ++j) { const f32x4 w = *(const LAS f32x4*)(wgd + o * D + 4 * F.lane + 256 * j); s += (v[j][0] * w[0] + v[j][1] * w[1]) + (v[j][2] * w[2] + v[j][3] * w[3]); }
                    ga[o] = s; if (o & 1) __builtin_amdgcn_sched_barrier(0); }
                const float gk = halving_reduce<16>(ga, F.lane);
                if ((F.lane & 3) == 0) gdn[(size_t)row * 16 + (F.lane >> 2)] = gk;
            }
        }
    }
    __syncthreads();
    moe_weight_convert(F, l, gw, NGW);
}

#define MFMA32(a, b, c) __builtin_amdgcn_mfma_f32_32x32x16_bf16((a), (b), (c), 0, 0, 0)
DI bf16x8 ldg8(const bf16* p) { return *(const bf16x8*)p; }
DI bf16x8 pack8(float a0, float a1, float a2, float a3, float a4, float a5, float a6, float a7) {
    u32x4 p; p.x = pk2(a0, a1); p.y = pk2(a2, a3); p.z = pk2(a4, a5); p.w = pk2(a6, a7); return __builtin_bit_cast(bf16x8, p);
}
DI bf16x8 pack_step(const f32x16& x, int s) { return s == 0 ? pack8(x[0], x[1], x[2], x[3], x[4], x[5], x[6], x[7]) : pack8(x[8], x[9], x[10], x[11], x[12], x[13], x[14], x[15]); }
DI f32x16 zero16() { f32x16 z; for (int i = 0; i < 16; ++i) z[i] = 0.f; return z; }
DI bf16x8 tr_read2(unsigned a_lo, unsigned a_hi) {
    s16x4 lo, hi;
    asm volatile("ds_read_b64_tr_b16 %0, %2\n\tds_read_b64_tr_b16 %1, %3\n\ts_waitcnt lgkmcnt(0)" : "=&v"(lo), "=&v"(hi) : "v"(a_lo), "v"(a_hi) : "memory");
    return __builtin_shufflevector(lo, hi, 0, 1, 2, 3, 4, 5, 6, 7);
}
constexpr int VPITCH = 144;
DI bf16x8 vt_frag(unsigned vbase, int lane, int dblk, int s) {
    const int i16 = lane & 15, q = i16 >> 2, p = i16 & 3, blk = (lane >> 4) & 1, h2 = lane >> 5;
    const unsigned col = (unsigned)((32 * dblk + 16 * blk) * 2 + 8 * p);
    return tr_read2(vbase + (unsigned)((16 * s + 4 * h2 + q) * VPITCH) + col, vbase + (unsigned)((16 * s + 8 + 4 * h2 + q) * VPITCH) + col);
}

DI void vt_frags4(unsigned vbase, int lane, bf16x8& v00, bf16x8& v01, bf16x8& v10, bf16x8& v11) {
    const int i16 = lane & 15, q = i16 >> 2, p = i16 & 3, blk = (lane >> 4) & 1, h2 = lane >> 5;
    const unsigned a0 = vbase + (unsigned)((4 * h2 + q) * VPITCH) + (unsigned)(32 * blk + 8 * p);
    s16x4 r0, r1, r2, r3, r4, r5, r6, r7;
    asm volatile("ds_read_b64_tr_b16 %0, %8\n\tds_read_b64_tr_b16 %1, %8 offset:1152\n\tds_read_b64_tr_b16 %2, %8 offset:2304\n\tds_read_b64_tr_b16 %3, %8 offset:3456\n\t"
                 "ds_read_b64_tr_b16 %4, %8 offset:64\n\tds_read_b64_tr_b16 %5, %8 offset:1216\n\tds_read_b64_tr_b16 %6, %8 offset:2368\n\tds_read_b64_tr_b16 %7, %8 offset:3520\n\ts_waitcnt lgkmcnt(0)"
                 : "=&v"(r0), "=&v"(r1), "=&v"(r2), "=&v"(r3), "=&v"(r4), "=&v"(r5), "=&v"(r6), "=&v"(r7) : "v"(a0) : "memory");
    v00 = __builtin_shufflevector(r0, r1, 0, 1, 2, 3, 4, 5, 6, 7); v01 = __builtin_shufflevector(r2, r3, 0, 1, 2, 3, 4, 5, 6, 7);
    v10 = __builtin_shufflevector(r4, r5, 0, 1, 2, 3, 4, 5, 6, 7); v11 = __builtin_shufflevector(r6, r7, 0, 1, 2, 3, 4, 5, 6, 7);
}
static_assert(VPITCH == 144, "vt_frags4 offsets assume a 144-byte row pitch: 8 rows = 1152 B");

DI void ph_sb_attn(Ctx& F) {
    unsigned char* ws = F.ws; bf16* proj = (bf16*)(ws + WS_BIG);
    const int lane = F.lane, r = lane & 31, h2 = lane >> 5;
    LAS unsigned char* vl = F.lds + F.wave * (64 * VPITCH); LAS unsigned char* kl = vl + 32 * VPITCH;
    const unsigned vbase = (unsigned)(size_t)vl;
    const int vcu = (F.G % 8 == 0) ? (F.bid % 8) * (F.G / 8) + F.bid / 8 : F.bid;
    for (int it2 = vcu; it2 < NB * 256 * 2; it2 += F.G) {
        const int it = it2 >> 1, hd = F.wave + 8 * (it2 & 1);
        const int b = it >> 8, qt = it & 255;
        const int q0 = qt * 32; const size_t rowbase = (size_t)b * SEQ;
        const bf16* qp = proj + (rowbase + q0 + r) * 3072 + hd * 64;
        bf16x8 Qf[4];
#pragma unroll
        for (int kk = 0; kk < 4; ++kk) Qf[kk] = ldg8(qp + 16 * kk + 8 * h2);
        f32x16 o0 = zero16(), o1 = zero16(); float carry = 0.f;
        const int qpos = q0 + r;
        u32x4 kv[4], vv[4];
        { const bf16* tp = proj + (rowbase + (q0 >> 5) * 32 + (lane >> 3)) * 3072 + hd * 64 + (lane & 7) * 8;
#pragma unroll
          for (int i = 0; i < 4; ++i) { kv[i] = *(const u32x4*)(tp + (size_t)(8 * i) * 3072 + 1024); vv[i] = *(const u32x4*)(tp + (size_t)(8 * i) * 3072 + 2048); } }
        for (int kt = q0 >> 5; kt >= 0; --kt) {
#pragma unroll
            for (int i = 0; i < 4; ++i) { *(LAS u32x4*)(kl + (8 * i + (lane >> 3)) * VPITCH + (lane & 7) * 16) = kv[i]; *(LAS u32x4*)(vl + (8 * i + (lane >> 3)) * VPITCH + (lane & 7) * 16) = vv[i]; }
            if (kt > 0) { const bf16* tp = proj + (rowbase + (kt - 1) * 32 + (lane >> 3)) * 3072 + hd * 64 + (lane & 7) * 8;
#pragma unroll
                for (int i = 0; i < 4; ++i) { kv[i] = *(const u32x4*)(tp + (size_t)(8 * i) * 3072 + 1024); vv[i] = *(const u32x4*)(tp + (size_t)(8 * i) * 3072 + 2048); } }
            LDS_WAIT();
            bf16x8 Kf[4];
#pragma unroll
            for (int kk = 0; kk < 4; ++kk) Kf[kk] = *(const LAS bf16x8*)(kl + r * VPITCH + (16 * kk + 8 * h2) * 2);
            f32x16 st = zero16();
#pragma unroll
            for (int kk = 0; kk < 4; ++kk) st = MFMA32(Kf[kk], Qf[kk], st);
            const bool diag = (kt == (q0 >> 5));
            float Lv[16]; float sg[4], pg[4];
            const int kbase = kt * 32 + 4 * h2;
#pragma unroll
            for (int i = 0; i < 16; ++i) { const int kpos = kbase + (i & 3) + 8 * (i >> 2); const float z = st[i];
                const float sp = fmaxf(z, 0.f) + flog2(1.f + fexp2(-fabsf(z)));
                Lv[i] = (!diag || kpos < qpos) ? -sp : 0.f; }
#pragma unroll
            for (int g = 0; g < 4; ++g) { sg[g] = (Lv[4 * g] + Lv[4 * g + 1]) + (Lv[4 * g + 2] + Lv[4 * g + 3]); pg[g] = __shfl_xor(sg[g], 32); }
            float after = carry; float a[16];
#pragma unroll
            for (int g = 3; g >= 0; --g) {
                float run = after + (h2 == 0 ? pg[g] : 0.f);
#pragma unroll
                for (int k = 3; k >= 0; --k) { const int i = 4 * g + k; run += Lv[i]; const int kpos = kbase + k + 8 * g;
                    a[i] = (!diag || kpos < qpos) ? fexp2(st[i] + run) : 0.f; }
                after += sg[g] + pg[g];
            }
            carry = after;
            const bf16x8 P0 = pack8(a[0], a[1], a[2], a[3], a[4], a[5], a[6], a[7]), P1 = pack8(a[8], a[9], a[10], a[11], a[12], a[13], a[14], a[15]);
            LDS_WAIT();
            bf16x8 v00, v01, v10, v11; vt_frags4(vbase, lane, v00, v01, v10, v11);
            o0 = MFMA32(v00, P0, o0); o0 = MFMA32(v01, P1, o0); o1 = MFMA32(v10, P0, o1); o1 = MFMA32(v11, P1, o1);
            if (__all(carry < -126.f)) break;
        }
        if (out_fp8(0)) { unsigned char* op8 = ws + WS_HO + (rowbase + q0 + r) * D + hd * 64 + 4 * h2;
#pragma unroll
            for (int g = 0; g < 4; ++g) { *(unsigned*)(op8 + 8 * g) = pk4_fp8(o0[4 * g], o0[4 * g + 1], o0[4 * g + 2], o0[4 * g + 3]); *(unsigned*)(op8 + 32 + 8 * g) = pk4_fp8(o1[4 * g], o1[4 * g + 1], o1[4 * g + 2], o1[4 * g + 3]); } }
        else {
        bf16* op = proj + (rowbase + q0 + r) * 3072 + hd * 64 + 4 * h2;
#pragma unroll
        for (int g = 0; g < 4; ++g) { u32x2 w; w.x = pk2(o0[4 * g], o0[4 * g + 1]); w.y = pk2(o0[4 * g + 2], o0[4 * g + 3]); *(u32x2*)(op + 8 * g) = w;
            u32x2 w1; w1.x = pk2(o1[4 * g], o1[4 * g + 1]); w1.y = pk2(o1[4 * g + 2], o1[4 * g + 3]); *(u32x2*)(op + 32 + 8 * g) = w1; } }
    }
}

constexpr int DIL_NT = 12, DIL_TILE = 32 * VPITCH, DIL_VOFF = DIL_NT * DIL_TILE;
DI void ph_dil_attn(Ctx& F) {
    unsigned char* ws = F.ws; bf16* proj = (bf16*)(ws + WS_BIG); float* lse = (float*)(ws + WS_LSE);
    const int lane = F.lane, r = lane & 31, h2 = lane >> 5, tid = F.tid;
    const int vcu = (F.G % 8 == 0) ? (F.bid % 8) * (F.G / 8) + F.bid / 8 : F.bid;
    const int prow = (tid >> 3) & 31, pch = tid & 7, ptile0 = tid >> 8;
    u32x4 kst[6], vst[6];
#define DIL_DECODE(it_, g_, b_, hd_, rho_, mt0_, rr_) const int hd_ = (it_) & 7, tg_ = ((it_) >> 3) & 31, b_ = ((it_) >> 8) & 7, g_ = (it_) >> 11; const int rr_ = 1 << (2 * g_), tpc_ = 256 >> (2 * g_); \
        const int rho_ = (tg_ * 8) / tpc_, mt0_ = (tg_ * 8) % tpc_
#define DIL_LOAD(g_, b_, hd_, rho_, mt0_, rr_) do { const bf16* base_ = proj + ((size_t)(b_) * SEQ + (rho_)) * 4608 + (g_) * 1536 + (hd_) * 64 + pch * 8; \
        _Pragma("unroll") for (int j = 0; j < 6; ++j) { const int kt_ = (mt0_) - 4 + ptile0 + 2 * j; if (kt_ >= 0) { const bf16* p_ = base_ + (size_t)((kt_ * 32 + prow) * (rr_)) * 4608; kst[j] = *(const u32x4*)(p_ + 512); vst[j] = *(const u32x4*)(p_ + 1024); } } } while (0)
    int it = vcu;
    if (it < 3 * NB * 256) { DIL_DECODE(it, g, b, hd, rho, mt0, rr); DIL_LOAD(g, b, hd, rho, mt0, rr); }
    for (; it < 3 * NB * 256; it += F.G) {
        DIL_DECODE(it, g, b, hd, rho, mt0, rr);
        asm volatile("s_waitcnt lgkmcnt(0)" ::: "memory"); __builtin_amdgcn_s_barrier(); asm volatile("" ::: "memory");
#pragma unroll
        for (int j = 0; j < 6; ++j) { const int tl = ptile0 + 2 * j; if (mt0 - 4 + tl >= 0) { *(LAS u32x4*)(F.lds + tl * DIL_TILE + prow * VPITCH + pch * 16) = kst[j]; *(LAS u32x4*)(F.lds + DIL_VOFF + tl * DIL_TILE + prow * VPITCH + pch * 16) = vst[j]; } }
        { const int itn = it + F.G; if (itn < 3 * NB * 256) { DIL_DECODE(itn, gn, bn, hdn, rhon, mt0n, rrn); DIL_LOAD(gn, bn, hdn, rhon, mt0n, rrn); } }
        asm volatile("s_waitcnt lgkmcnt(0)" ::: "memory"); __builtin_amdgcn_s_barrier(); asm volatile("" ::: "memory");
        const int mt = mt0 + F.wave;
        const size_t rowbase = (size_t)b * SEQ + rho; const int cq = g * 1536 + hd * 64;
        const int m0 = mt * 32;
        const bf16* qp = proj + (rowbase + (size_t)(m0 + r) * rr) * 4608 + cq;
        bf16x8 Qf[4];
#pragma unroll
        for (int kk = 0; kk < 4; ++kk) Qf[kk] = ldg8(qp + 16 * kk + 8 * h2);
        f32x16 o0 = zero16(), o1 = zero16(); float mrun = -__builtin_inff(), lrun = 0.f;
        const int mq = m0 + r;
        for (int kt = (mt >= 4 ? mt - 4 : 0); kt <= mt; ++kt) {
            const int tl = kt - (mt0 - 4);
            const LAS unsigned char* kl = F.lds + tl * DIL_TILE; const unsigned vbase = (unsigned)(size_t)(F.lds + DIL_VOFF + tl * DIL_TILE);
            bf16x8 Kf[4];
#pragma unroll
            for (int kk = 0; kk < 4; ++kk) Kf[kk] = *(const LAS bf16x8*)(kl + r * VPITCH + (16 * kk + 8 * h2) * 2);
            f32x16 st = zero16();
#pragma unroll
            for (int kk = 0; kk < 4; ++kk) st = MFMA32(Kf[kk], Qf[kk], st);
            const int kbase = kt * 32 + 4 * h2;
            float mx = -__builtin_inff();
            if (kt == mt || kt + 4 == mt) {
#pragma unroll
                for (int i = 0; i < 16; ++i) { const int mk = kbase + (i & 3) + 8 * (i >> 2); const bool valid = (mk <= mq) && (mq - mk <= 128);
                    st[i] = valid ? st[i] : -__builtin_inff(); } }
#pragma unroll
            for (int i = 0; i < 16; ++i) mx = fmaxf(mx, st[i]);
            mx = fmaxf(mx, __shfl_xor(mx, 32));
            const float mnew = fmaxf(mrun, mx);
            const float alpha = fexp2(mrun - mnew);
            float a[16]; float ps = 0.f;
#pragma unroll
            for (int i = 0; i < 16; ++i) { a[i] = fexp2(st[i] - mnew); ps += a[i]; }
            ps += __shfl_xor(ps, 32);
            lrun = lrun * alpha + ps; mrun = mnew;
#pragma unroll
            for (int i = 0; i < 16; ++i) { o0[i] *= alpha; o1[i] *= alpha; }
            const bf16x8 P0 = pack8(a[0], a[1], a[2], a[3], a[4], a[5], a[6], a[7]), P1 = pack8(a[8], a[9], a[10], a[11], a[12], a[13], a[14], a[15]);
            bf16x8 v00, v01, v10, v11; vt_frags4(vbase, lane, v00, v01, v10, v11);
            o0 = MFMA32(v00, P0, o0); o0 = MFMA32(v01, P1, o0); o1 = MFMA32(v10, P0, o1); o1 = MFMA32(v11, P1, o1);
        }
        const float inv = 1.f / lrun;
        const size_t orow = rowbase + (size_t)(m0 + r) * rr;
        bf16* op = proj + orow * 4608 + cq + 4 * h2;
#pragma unroll
        for (int gq = 0; gq < 4; ++gq) { u32x2 w; w.x = pk2(o0[4 * gq] * inv, o0[4 * gq + 1] * inv); w.y = pk2(o0[4 * gq + 2] * inv, o0[4 * gq + 3] * inv); *(u32x2*)(op + 8 * gq) = w;
            u32x2 w1; w1.x = pk2(o1[4 * gq] * inv, o1[4 * gq + 1] * inv); w1.y = pk2(o1[4 * gq + 2] * inv, o1[4 * gq + 3] * inv); *(u32x2*)(op + 32 + 8 * gq) = w1; }
        if (h2 == 0) lse[((size_t)g * T + orow) * 8 + hd] = mrun + flog2(lrun);
    }
#undef DIL_DECODE
#undef DIL_LOAD
}
DI void ph_dil_combine(Ctx& F) {
    unsigned char* ws = F.ws; const bf16* proj = (const bf16*)(ws + WS_BIG); const float* lse = (const float*)(ws + WS_LSE); bf16* HO = (bf16*)(ws + WS_HO);
    const int gw = F.bid * NWAVES + F.wave, NGW = F.G * NWAVES; const int lane = F.lane, hd = lane >> 3;
    for (int row = gw; row < T; row += NGW) {
        const float l0 = lse[((size_t)0 * T + row) * 8 + hd], l1 = lse[((size_t)1 * T + row) * 8 + hd], l2 = lse[((size_t)2 * T + row) * 8 + hd];
        const float m = fmaxf(l0, fmaxf(l1, l2)); float w0 = fexp2(l0 - m), w1 = fexp2(l1 - m), w2 = fexp2(l2 - m); const float inv = 1.f / (w0 + w1 + w2); w0 *= inv; w1 *= inv; w2 *= inv;
        const bf16* p = proj + (size_t)row * 4608 + 8 * lane;
        const u32x4 a = *(const u32x4*)p, b = *(const u32x4*)(p + 1536), c = *(const u32x4*)(p + 3072);
        u32x4 o; float f[8];
#pragma unroll
        for (int e = 0; e < 4; ++e) { const float lo = w0 * bflo(a[e]) + w1 * bflo(b[e]) + w2 * bflo(c[e]), hi = w0 * bfhi(a[e]) + w1 * bfhi(b[e]) + w2 * bfhi(c[e]); o[e] = pk2(lo, hi); f[2 * e] = lo; f[2 * e + 1] = hi; }
        if (out_fp8(3)) { u32x2 q8; q8.x = pk4_fp8(f[0], f[1], f[2], f[3]); q8.y = pk4_fp8(f[4], f[5], f[6], f[7]); *(u32x2*)((unsigned char*)HO + (size_t)row * 512 + 8 * lane) = q8; }
        else *(u32x4*)(HO + (size_t)row * 512 + 8 * lane) = o;
    }
}

DI void ph_conv(Ctx& F) {
    const KParams& P = *F.p; unsigned char* ws = F.ws; const bf16* proj = (const bf16*)(ws + WS_BIG); bf16* HO = (bf16*)(ws + WS_HO);
    const int gw = F.bid * NWAVES + F.wave, NGW = F.G * NWAVES; const int lane = F.lane;
    const float* cw = PIN(I_CONVW); const float* cb = PIN(I_CONVB);
    f32x4 w0[4], w1[4], w2[4], bb[4];
#pragma unroll
    for (int j = 0; j < 4; ++j) { const int col = 4 * lane + 256 * j; w0[j] = *(const f32x4*)(cw + col); w1[j] = *(const f32x4*)(cw + D + col); w2[j] = *(const f32x4*)(cw + 2 * D + col); bb[j] = *(const f32x4*)(cb + col); }
    for (int blk = gw; blk < T / 32; blk += NGW) {
        const int row0 = blk * 32, pos0 = row0 % SEQ;
        f32x4 um1[4], um2[4];
#pragma unroll
        for (int j = 0; j < 4; ++j) { um1[j] = (f32x4){0.f, 0.f, 0.f, 0.f}; um2[j] = um1[j]; }
        if (pos0 >= 2) {
#pragma unroll
            for (int j = 0; j < 4; ++j) { const int col = 4 * lane + 256 * j;
                const u32x2 c1 = *(const u32x2*)(proj + (size_t)(row0 - 1) * 3072 + 1024 + col), u1 = *(const u32x2*)(proj + (size_t)(row0 - 1) * 3072 + 2048 + col);
                const u32x2 c2 = *(const u32x2*)(proj + (size_t)(row0 - 2) * 3072 + 1024 + col), u2 = *(const u32x2*)(proj + (size_t)(row0 - 2) * 3072 + 2048 + col);
                um1[j] = (f32x4){bflo(c1.x) * bflo(u1.x), bfhi(c1.x) * bfhi(u1.x), bflo(c1.y) * bflo(u1.y), bfhi(c1.y) * bfhi(u1.y)};
                um2[j] = (f32x4){bflo(c2.x) * bflo(u2.x), bfhi(c2.x) * bfhi(u2.x), bflo(c2.y) * bflo(u2.y), bfhi(c2.y) * bfhi(u2.y)}; }
        }
        u32x2 ngb[4], nc0[4], nu0[4];
#pragma unroll
        for (int j = 0; j < 4; ++j) { const int col = 4 * lane + 256 * j; const bf16* p = proj + (size_t)row0 * 3072 + col; ngb[j] = *(const u32x2*)p; nc0[j] = *(const u32x2*)(p + 1024); nu0[j] = *(const u32x2*)(p + 2048); }
        for (int rr = 0; rr < 32; ++rr) { const size_t row = (size_t)row0 + rr;
            u32x2 gbv_[4], c0v[4], u0v[4];
#pragma unroll
            for (int j = 0; j < 4; ++j) { gbv_[j] = ngb[j]; c0v[j] = nc0[j]; u0v[j] = nu0[j]; }
            if (rr + 1 < 32) {
#pragma unroll
                for (int j = 0; j < 4; ++j) { const int col = 4 * lane + 256 * j; const bf16* p = proj + (row + 1) * 3072 + col; ngb[j] = *(const u32x2*)p; nc0[j] = *(const u32x2*)(p + 1024); nu0[j] = *(const u32x2*)(p + 2048); } }
#pragma unroll
            for (int j = 0; j < 4; ++j) { const int col = 4 * lane + 256 * j;
                const u32x2 gb = gbv_[j], c0 = c0v[j], u0 = u0v[j];
                const f32x4 uc = (f32x4){bflo(c0.x) * bflo(u0.x), bfhi(c0.x) * bfhi(u0.x), bflo(c0.y) * bflo(u0.y), bfhi(c0.y) * bfhi(u0.y)};
                const f32x4 y = w0[j] * um2[j] + w1[j] * um1[j] + w2[j] * uc + bb[j];
                const f32x4 gbv = (f32x4){bflo(gb.x), bfhi(gb.x), bflo(gb.y), bfhi(gb.y)};
                const f32x4 z = gbv * y;
                if (out_fp8(2)) *(unsigned*)((unsigned char*)HO + row * D + col) = pk4_fp8(z[0], z[1], z[2], z[3]);
                else { u32x2 o; o.x = pk2(z[0], z[1]); o.y = pk2(z[2], z[3]); *(u32x2*)(HO + row * D + col) = o; }
                um2[j] = um1[j]; um1[j] = uc; }
        }
    }
}

constexpr int G1_GD = 0, G1_QIN = 4096, G1_PITCH = 1040, G1_KIN = G1_QIN + 64 * G1_PITCH;
DI void ph_gla_g1(Ctx& F) {
    const KParams& P = *F.p; unsigned char* ws = F.ws; bf16* proj = (bf16*)(ws + WS_BIG);
    const float* gdn = (const float*)(ws + WS_GDOWN); float* decay = (float*)(ws + WS_DECAY);
    bf16* kst = (bf16*)(ws + WS_KST); bf16* vT = (bf16*)(ws + WS_VT); bf16* sc = (bf16*)(ws + WS_SC);
    LAS float* GD = (LAS float*)(F.lds + G1_GD); LAS unsigned char* QIN = F.lds + G1_QIN; LAS unsigned char* KIN = F.lds + G1_KIN;
    const int tid = F.tid, ch = tid, lane = F.lane, r = lane & 31, h2 = lane >> 5;
    float wup[16];
#pragma unroll
    for (int o = 0; o < 16; ++o) wup[o] = PIN(I_GLAGU)[o * 512 + ch];
    const float bg = PIN(I_GLABG)[ch];
    for (int item = F.bid; item < T / 64; item += F.G) {
        const size_t row0 = (size_t)item * 64;
        __syncthreads();
        if (tid < 256) *(LAS f32x4*)(GD + tid * 4) = *(const f32x4*)(gdn + row0 * 16 + tid * 4);
#pragma unroll
        for (int p = 0; p < 8; ++p) { const int piece = tid + 512 * p, row = piece >> 6, c16 = piece & 63; const bf16* src = proj + (row0 + row) * 3072 + c16 * 8;
            *(LAS u32x4*)(QIN + row * G1_PITCH + c16 * 16) = *(const u32x4*)src; *(LAS u32x4*)(KIN + row * G1_PITCH + c16 * 16) = *(const u32x4*)(src + 512); }
#pragma unroll
        for (int q = 0; q < 2; ++q) { const int blk = tid + 512 * q, to = blk & 7, co = blk >> 3;
            u32x4 rw[8];
#pragma unroll
            for (int t = 0; t < 8; ++t) rw[t] = *(const u32x4*)(proj + (row0 + 8 * to + t) * 3072 + 1024 + 8 * co);
#pragma unroll
            for (int c = 0; c < 8; ++c) { const unsigned sel = (c & 1) ? 0x07060302u : 0x05040100u; u32x4 o;
                o.x = __builtin_amdgcn_perm(rw[1][c >> 1], rw[0][c >> 1], sel); o.y = __builtin_amdgcn_perm(rw[3][c >> 1], rw[2][c >> 1], sel);
                o.z = __builtin_amdgcn_perm(rw[5][c >> 1], rw[4][c >> 1], sel); o.w = __builtin_amdgcn_perm(rw[7][c >> 1], rw[6][c >> 1], sel);
                *(u32x4*)(vT + ((size_t)item * 1024 + 8 * co + c) * 64 + 8 * to) = o; } }
        __syncthreads();
        float bs[64]; float bc = 0.f;
#pragma unroll
        for (int i = 0; i < 64; ++i) {
            float u = bg;
#pragma unroll
            for (int q4 = 0; q4 < 4; ++q4) { const f32x4 g = *(const LAS f32x4*)(GD + i * 16 + q4 * 4); u += (g[0] * wup[q4 * 4] + g[1] * wup[q4 * 4 + 1]) + (g[2] * wup[q4 * 4 + 2] + g[3] * wup[q4 * 4 + 3]); }
            const float u2 = u * LOG2E;
            const float ls2 = -(fmaxf(-u2, 0.f) + flog2(1.f + fexp2(-fabsf(u2))));
            bc += ls2 * (1.f / 16.f); bs[i] = bc;
        }
        unsigned kp[32];
#pragma unroll
        for (int i = 0; i < 64; ++i) {
            LAS unsigned short* qp = (LAS unsigned short*)(QIN + i * G1_PITCH + ch * 2); LAS unsigned short* kq = (LAS unsigned short*)(KIN + i * G1_PITCH + ch * 2);
            const float qv = bf2f(*qp), kv = bf2f(*kq);
            const float qin = qv * fexp2(bs[i]), kin = kv * fexp2(-bs[i]), kstv = kv * fexp2(bs[63] - bs[i]);
            *qp = (unsigned short)f2bf(qin); *kq = (unsigned short)f2bf(kin);
            if (i & 1) kp[i >> 1] |= f2bf(kstv) << 16; else kp[i >> 1] = f2bf(kstv);
        }
        { u32x4* dst = (u32x4*)(kst + ((size_t)item * 512 + ch) * 64);
#pragma unroll
          for (int q8 = 0; q8 < 8; ++q8) dst[q8] = (u32x4){kp[4 * q8], kp[4 * q8 + 1], kp[4 * q8 + 2], kp[4 * q8 + 3]}; }
        decay[(size_t)item * 512 + ch] = fexp2(bs[63]);
        __syncthreads();
#pragma unroll
        for (int p = 0; p < 8; ++p) { const int piece = tid + 512 * p, row = piece >> 6, c16 = piece & 63;
            *(u32x4*)(proj + (row0 + row) * 3072 + c16 * 8) = *(const LAS u32x4*)(QIN + row * G1_PITCH + c16 * 16); }
        { const int shd = F.wave >> 1, jt = F.wave & 1;
#pragma unroll
          for (int itile = 0; itile < 2; ++itile) {
            f32x16 st = zero16();
            if (jt <= itile) {
#pragma unroll
                for (int s = 0; s < 8; ++s) { const bf16x8 kf = *(const LAS bf16x8*)(KIN + (jt * 32 + r) * G1_PITCH + (shd * 128 + 16 * s + 8 * h2) * 2);
                    const bf16x8 qf = *(const LAS bf16x8*)(QIN + (itile * 32 + r) * G1_PITCH + (shd * 128 + 16 * s + 8 * h2) * 2);
                    st = MFMA32(kf, qf, st); }
            }
            const int iq = itile * 32 + r;
            bf16* dst = sc + (((size_t)item * 4 + shd) * 64 + iq) * 64 + jt * 32 + 4 * h2;
#pragma unroll
            for (int g = 0; g < 4; ++g) { float v[4];
#pragma unroll
                for (int k = 0; k < 4; ++k) { const int j = jt * 32 + 8 * g + 4 * h2 + k; v[k] = (j <= iq) ? st[4 * g + k] : 0.f; }
                u32x2 w; w.x = pk2(v[0], v[1]); w.y = pk2(v[2], v[3]); *(u32x2*)(dst + 8 * g) = w; }
          } }
    }
}
constexpr int G2_SC = 0, G2_QI = 9216, G2_KS = G2_QI + 17408, G2_DC = G2_KS + 18432, G2_BUF = G2_DC + 512;
constexpr int NSEG = 8, SEGC = (SEQ / 64) / NSEG;
template <int MODE> DI void ph_gla_g2(Ctx& F) {
    unsigned char* ws = F.ws; const bf16* proj = (const bf16*)(ws + WS_BIG); const float* decay = (const float*)(ws + WS_DECAY);
    const bf16* kst = (const bf16*)(ws + WS_KST); const bf16* vT = (const bf16*)(ws + WS_VT); const bf16* sc = (const bf16*)(ws + WS_SC); bf16* oraw = (bf16*)(ws + WS_HO);
    float* send = (float*)(ws + WS_SEND); float* dseg = (float*)(ws + WS_DSEG);
    const int tid = F.tid, lane = F.lane, r = lane & 31, h2 = lane >> 5, dvs = F.wave;
    for (int item = F.bid; item < NB * 4 * NSEG; item += F.G) {
        const int seg = item & (NSEG - 1), hd = (item >> 3) & 3, b = item >> 5;
        if (MODE == 0 && seg == NSEG - 1) continue;
        const size_t ci0 = (size_t)b * (SEQ / 64) + seg * SEGC;
        const int sc_row = tid >> 3, sc_c = tid & 7;
        const int qi_row0 = tid >> 4, qi_c = tid & 15;
        const int ks_row0 = tid >> 3, ks_c = tid & 7;
        u32x4 st_sc, st_q0, st_q1, st_k0, st_k1; f32x4 st_d = (f32x4){0.f, 0.f, 0.f, 0.f};
        bf16x8 Vf[4], VfN[4];
#define G2_LOAD(ci) do { \
            if (MODE == 1) { st_sc = *(const u32x4*)(sc + (((ci) * 4 + hd) * 64 + sc_row) * 64 + sc_c * 8); \
                st_q0 = *(const u32x4*)(proj + ((ci) * 64 + qi_row0) * 3072 + hd * 128 + qi_c * 8); st_q1 = *(const u32x4*)(proj + ((ci) * 64 + qi_row0 + 32) * 3072 + hd * 128 + qi_c * 8); } \
            st_k0 = *(const u32x4*)(kst + (((ci) * 4 + hd) * 128 + ks_row0) * 64 + ks_c * 8); st_k1 = *(const u32x4*)(kst + (((ci) * 4 + hd) * 128 + ks_row0 + 64) * 64 + ks_c * 8); \
            if (tid < 32) st_d = *(const f32x4*)(decay + (ci) * 512 + hd * 128 + tid * 4); \
            { const bf16* vrow_ = vT + ((ci) * 1024 + hd * 256 + dvs * 32 + r) * 64 + 8 * h2; _Pragma("unroll") for (int s_ = 0; s_ < 4; ++s_) VfN[s_] = ldg8(vrow_ + 16 * s_); } } while (0)
#define G2_STORE(bufp) do { \
            if (MODE == 1) { *(LAS u32x4*)((bufp) + G2_SC + sc_row * 144 + sc_c * 16) = st_sc; \
                *(LAS u32x4*)((bufp) + G2_QI + qi_row0 * 272 + qi_c * 16) = st_q0; *(LAS u32x4*)((bufp) + G2_QI + (qi_row0 + 32) * 272 + qi_c * 16) = st_q1; } \
            *(LAS u32x4*)((bufp) + G2_KS + ks_row0 * 144 + ks_c * 16) = st_k0; *(LAS u32x4*)((bufp) + G2_KS + (ks_row0 + 64) * 144 + ks_c * 16) = st_k1; \
            if (tid < 32) *(LAS f32x4*)((bufp) + G2_DC + tid * 16) = st_d; } while (0)
        __syncthreads();
        G2_LOAD(ci0);
        f32x16 S[4];
#pragma unroll
        for (int mt = 0; mt < 4; ++mt) S[mt] = zero16();
        if (MODE == 1) {
            for (int sp = 0; sp < seg; ++sp) {
                const float* dp = dseg + (size_t)(item - seg + sp) * 128 + 4 * h2;
                const float* sp_ = send + ((size_t)(item - seg + sp) * NWAVES + dvs) * 4096 + lane * 4;
#pragma unroll
                for (int mt = 0; mt < 4; ++mt)
#pragma unroll
                    for (int g = 0; g < 4; ++g) { const f32x4 dv = *(const f32x4*)(dp + 32 * mt + 8 * g), sv = *(const f32x4*)(sp_ + (mt * 4 + g) * 256);
#pragma unroll
                        for (int k = 0; k < 4; ++k) S[mt][4 * g + k] = S[mt][4 * g + k] * dv[k] + sv[k]; }
            }
        } else if (tid < 128) {
            float pr = 1.f;
            for (int n = 0; n < SEGC; ++n) pr *= decay[(ci0 + n) * 512 + hd * 128 + tid];
            dseg[(size_t)item * 128 + tid] = pr;
        }
        G2_STORE(F.lds);
#pragma unroll
        for (int s = 0; s < 4; ++s) Vf[s] = VfN[s];
        __syncthreads();
        for (int n = 0; n < SEGC; ++n) {
            const size_t ci = ci0 + n;
            LAS unsigned char* buf = F.lds + (n & 1) * G2_BUF; LAS unsigned char* nbuf = F.lds + ((n + 1) & 1) * G2_BUF;
            if (n + 1 < SEGC) G2_LOAD(ci + 1);
            if (MODE == 1) {
                bf16x8 Sb[4][2];
#pragma unroll
                for (int mt = 0; mt < 4; ++mt) { Sb[mt][0] = pack_step(S[mt], 0); Sb[mt][1] = pack_step(S[mt], 1); }
#pragma unroll
                for (int itile = 0; itile < 2; ++itile) {
                    f32x16 o = zero16();
                    const LAS unsigned char* scrow = buf + G2_SC + (itile * 32 + r) * 144 + 16 * h2;
#pragma unroll
                    for (int s = 0; s < 4; ++s) o = MFMA32(Vf[s], *(const LAS bf16x8*)(scrow + 32 * s), o);
                    const LAS unsigned char* qrow = buf + G2_QI + (itile * 32 + r) * 272 + 8 * h2;
#pragma unroll
                    for (int mt = 0; mt < 4; ++mt)
#pragma unroll
                        for (int s2 = 0; s2 < 2; ++s2) { const u32x2 lo = *(const LAS u32x2*)(qrow + 64 * mt + 32 * s2), hi = *(const LAS u32x2*)(qrow + 64 * mt + 32 * s2 + 16);
                            const u32x4 fr = (u32x4){lo.x, lo.y, hi.x, hi.y};
                            o = MFMA32(Sb[mt][s2], __builtin_bit_cast(bf16x8, fr), o); }
                    bf16* op = oraw + (ci * 64 + itile * 32 + r) * 1024 + hd * 256 + dvs * 32 + 4 * h2;
#pragma unroll
                    for (int g = 0; g < 4; ++g) { u32x2 w; w.x = pk2(o[4 * g], o[4 * g + 1]); w.y = pk2(o[4 * g + 2], o[4 * g + 3]); *(u32x2*)(op + 8 * g) = w; }
                }
            }
#pragma unroll
            for (int mt = 0; mt < 4; ++mt) {
                const LAS unsigned char* dp = buf + G2_DC + (32 * mt + 4 * h2) * 4;
#pragma unroll
                for (int g = 0; g < 4; ++g) { const f32x4 dv = *(const LAS f32x4*)(dp + 32 * g);
#pragma unroll
                    for (int k = 0; k < 4; ++k) S[mt][4 * g + k] *= dv[k]; }
                const LAS unsigned char* krow = buf + G2_KS + (32 * mt + r) * 144 + 16 * h2;
#pragma unroll
                for (int s = 0; s < 4; ++s) S[mt] = MFMA32(*(const LAS bf16x8*)(krow + 32 * s), Vf[s], S[mt]);
            }
            if (n + 1 < SEGC) { G2_STORE(nbuf);
#pragma unroll
                for (int s = 0; s < 4; ++s) Vf[s] = VfN[s]; }
            asm volatile("s_waitcnt lgkmcnt(0)" ::: "memory"); __builtin_amdgcn_s_barrier(); asm volatile("" ::: "memory");
        }
        if (MODE == 1) {
            asm volatile("s_waitcnt vmcnt(0)" ::: "memory"); __syncthreads();
            const float* gng = (const float*)F.p->in[I_GLANG]; const int cl = (lane & 15) * 16;
            float gn[16];
#pragma unroll
            for (int e = 0; e < 16; ++e) gn[e] = gng[cl + e];
            u32x4 na0, na1, nr0, nr1;
            { const size_t row = ci0 * 64 + (size_t)F.wave * 4 + (lane >> 4); const bf16* op = oraw + row * D + hd * 256 + cl; const bf16* rp = proj + row * 3072 + 2048 + hd * 256 + cl;
              na0 = *(const u32x4*)op; na1 = *(const u32x4*)(op + 8); nr0 = *(const u32x4*)rp; nr1 = *(const u32x4*)(rp + 8); }
            for (int q = F.wave; q < SEGC * 16; q += NWAVES) {
                const size_t row = ci0 * 64 + (size_t)q * 4 + (lane >> 4);
                bf16* op = oraw + row * D + hd * 256 + cl;
                const u32x4 a0 = na0, a1 = na1, r0 = nr0, r1 = nr1;
                if (q + NWAVES < SEGC * 16) { const size_t rown = row + 4 * NWAVES; const bf16* opn = oraw + rown * D + hd * 256 + cl; const bf16* rpn = proj + rown * 3072 + 2048 + hd * 256 + cl;
                    na0 = *(const u32x4*)opn; na1 = *(const u32x4*)(opn + 8); nr0 = *(const u32x4*)rpn; nr1 = *(const u32x4*)(rpn + 8); }
                float v[16], rv[16];
#pragma unroll
                for (int e = 0; e < 4; ++e) { v[2 * e] = bflo(a0[e]); v[2 * e + 1] = bfhi(a0[e]); v[8 + 2 * e] = bflo(a1[e]); v[8 + 2 * e + 1] = bfhi(a1[e]);
                    rv[2 * e] = bflo(r0[e]); rv[2 * e + 1] = bfhi(r0[e]); rv[8 + 2 * e] = bflo(r1[e]); rv[8 + 2 * e + 1] = bfhi(r1[e]); }
                float ss = 0.f;
#pragma unroll
                for (int e = 0; e < 16; ++e) ss += v[e] * v[e];
                ss += __shfl_xor(ss, 1); ss += __shfl_xor(ss, 2); ss += __shfl_xor(ss, 4); ss += __shfl_xor(ss, 8);
                const float rstd = 1.f / sqrtf(ss * (1.f / 256.f) + RMS_EPS);
                float o[16];
#pragma unroll
                for (int e = 0; e < 16; ++e) { const float rr = rv[e]; o[e] = v[e] * rstd * gn[e] * (rr / (1.f + __expf(-rr))); }
                if (out_fp8(1)) { u32x4 q8;
#pragma unroll
                    for (int e = 0; e < 4; ++e) q8[e] = pk4_fp8(o[4 * e], o[4 * e + 1], o[4 * e + 2], o[4 * e + 3]);
                    *(u32x4*)(ws + WS_KST + row * D + hd * 256 + cl) = q8; }
                else { u32x4 w0, w1;
#pragma unroll
                    for (int e = 0; e < 4; ++e) { w0[e] = pk2(o[2 * e], o[2 * e + 1]); w1[e] = pk2(o[8 + 2 * e], o[8 + 2 * e + 1]); }
                    *(u32x4*)op = w0; *(u32x4*)(op + 8) = w1; }
            }
        }
        if (MODE == 0) {
            float* sp_ = send + ((size_t)item * NWAVES + dvs) * 4096 + lane * 4;
#pragma unroll
            for (int mt = 0; mt < 4; ++mt)
#pragma unroll
                for (int g = 0; g < 4; ++g) *(f32x4*)(sp_ + (mt * 4 + g) * 256) = (f32x4){S[mt][4 * g], S[mt][4 * g + 1], S[mt][4 * g + 2], S[mt][4 * g + 3]};
        }
#undef G2_LOAD
#undef G2_STORE
    }
}
DI void ph_gla_g3(Ctx& F) {
    const KParams& P = *F.p; unsigned char* ws = F.ws; const bf16* proj = (const bf16*)(ws + WS_BIG); bf16* HO = (bf16*)(ws + WS_HO);
    const int gw = F.bid * NWAVES + F.wave, NGW = F.G * NWAVES; const int lane = F.lane;
    float gn[16];
#pragma unroll
    for (int e = 0; e < 16; ++e) gn[e] = PIN(I_GLANG)[(16 * lane + e) & 255];
    for (int row = gw; row < T; row += NGW) {
        bf16* op = HO + (size_t)row * D + 16 * lane; const bf16* rp = proj + (size_t)row * 3072 + 2048 + 16 * lane;
        const u32x4 a0 = *(const u32x4*)op, a1 = *(const u32x4*)(op + 8), r0 = *(const u32x4*)rp, r1 = *(const u32x4*)(rp + 8);
        float v[16], rv[16];
#pragma unroll
        for (int e = 0; e < 4; ++e) { v[2 * e] = bflo(a0[e]); v[2 * e + 1] = bfhi(a0[e]); v[8 + 2 * e] = bflo(a1[e]); v[8 + 2 * e + 1] = bfhi(a1[e]);
            rv[2 * e] = bflo(r0[e]); rv[2 * e + 1] = bfhi(r0[e]); rv[8 + 2 * e] = bflo(r1[e]); rv[8 + 2 * e + 1] = bfhi(r1[e]); }
        float ss = 0.f;
#pragma unroll
        for (int e = 0; e < 16; ++e) ss += v[e] * v[e];
        ss += __shfl_xor(ss, 1); ss += __shfl_xor(ss, 2); ss += __shfl_xor(ss, 4); ss += __shfl_xor(ss, 8);
        const float rstd = 1.f / sqrtf(ss * (1.f / 256.f) + RMS_EPS);
        float o[16];
#pragma unroll
        for (int e = 0; e < 16; ++e) { const float rr = rv[e]; o[e] = v[e] * rstd * gn[e] * (rr / (1.f + __expf(-rr))); }
        if (out_fp8(1)) { u32x4 q8;
#pragma unroll
            for (int e = 0; e < 4; ++e) q8[e] = pk4_fp8(o[4 * e], o[4 * e + 1], o[4 * e + 2], o[4 * e + 3]);
            *(u32x4*)(ws + WS_KST + (size_t)row * D + 16 * lane) = q8; }
        else {
        u32x4 w0, w1;
#pragma unroll
        for (int e = 0; e < 4; ++e) { w0[e] = pk2(o[2 * e], o[2 * e + 1]); w1[e] = pk2(o[8 + 2 * e], o[8 + 2 * e + 1]); }
        *(u32x4*)op = w0; *(u32x4*)(op + 8) = w1; }
    }
}

constexpr int N2_PITCH = 2064, N2_GM = 37 * N2_PITCH + 432  , N2_SH = N2_GM + 4096;
DI bool n2_better(float va, int ia, float vb, int ib) { return va > vb || (va == vb && ia < ib); }
DI void ph_norm2(Ctx& F, int l) {
    const KParams& P = *F.p; unsigned char* ws = F.ws;
    const float* modf = (const float*)(ws + WS_MODF);
    LAS unsigned char* WTb = F.lds;
    LAS float* GM = (LAS float*)(F.lds + N2_GM); LAS float* SH = (LAS float*)(F.lds + N2_SH);
    volatile LAS unsigned* hist = F.MISC + 32;
    const float* wg = PIN(I_MGRPW) + (size_t)l * D * 4; const float* we = PIN(I_MEXPW) + (size_t)l * D * 32;
    const float* bgp = PIN(I_MGRPB) + l * 4; const float* bep = PIN(I_MEXPB) + l * 32;
    __syncthreads();
    for (int c = F.tid; c < D; c += NTHR) { const f32x4 w = *(const f32x4*)(wg + c * 4);
#pragma unroll
        for (int e = 0; e < 4; ++e) *(LAS unsigned short*)(WTb + (32 + e) * N2_PITCH + c * 2) = (unsigned short)f2bf(w[e]);
        *(LAS unsigned short*)(WTb + 36 * N2_PITCH + c * 2) = 0; }
    for (int idx = F.tid; idx < D * 8; idx += NTHR) { const int c = idx >> 3, part = idx & 7; const f32x4 w = *(const f32x4*)(we + c * 32 + part * 4);
#pragma unroll
        for (int e = 0; e < 4; ++e) *(LAS unsigned short*)(WTb + (part * 4 + e) * N2_PITCH + c * 2) = (unsigned short)f2bf(w[e]); }
    const bf16* X = (const bf16*)(ws + WS_XB); unsigned char* HO8 = ws + WS_HO;
    int* tok_e = (int*)(ws + WS_TOKE); float* tok_w = (float*)(ws + WS_TOKW); int* hist_g = (int*)(ws + WS_HIST);
    const float* ng = PIN(I_NORMG) + (size_t)(l * 2 + 1) * D;
    const int lane = F.lane, r = lane & 31, h2 = lane >> 5;
    for (int vb = F.bid; vb < T / 256; vb += F.G) {
        __syncthreads();
        if (F.tid < 32) hist[F.tid] = 0u;
        const int b = (vb * 256) / SEQ;
        if (F.tid < 256) { const float* mp = modf + ((size_t)l * NB + b) * 6144; const f32x4 shv = *(const f32x4*)(mp + 3 * D + 4 * F.tid), scv = *(const f32x4*)(mp + 4 * D + 4 * F.tid), gv = *(const f32x4*)(ng + 4 * F.tid);
            *(LAS f32x4*)(GM + 4 * F.tid) = gv * (scv + 1.f); *(LAS f32x4*)(SH + 4 * F.tid) = shv; }
        __syncthreads();
        const int row = vb * 256 + F.wave * 32 + r;
        const bf16* xrow = X + (size_t)row * D + 512 * h2;
        float ss = 0.f;
        { const float* sp = (const float*)(ws + WS_SSP) + (size_t)row * 16;
#pragma unroll
          for (int q = 0; q < 4; ++q) { const f32x4 pq = *(const f32x4*)(sp + 4 * q); ss += (pq[0] + pq[1]) + (pq[2] + pq[3]); } }
        const float rstd = 1.f / sqrtf(ss * (1.f / D) + RMS_EPS);
        f32x16 accE = zero16(), accG = zero16();
        const LAS unsigned char* aE = WTb + r * N2_PITCH + 1024 * h2; const LAS unsigned char* aG = WTb + (r < 4 ? 32 + r : 36) * N2_PITCH + 1024 * h2;
        const LAS float* gmp = GM + 512 * h2; const LAS float* shp = SH + 512 * h2;
        unsigned char* hrow = HO8 + (size_t)row * D + 512 * h2;
        for (int s8 = 0; s8 < 64; s8 += 8) {
            u32x4 wv[8];
#pragma unroll
            for (int q = 0; q < 8; ++q) wv[q] = *(const u32x4*)(xrow + 8 * (s8 + q));
#pragma unroll
            for (int q = 0; q < 8; q += 2) {
                u32x4 st8;
#pragma unroll
                for (int q2 = 0; q2 < 2; ++q2) { const int s2 = s8 + q + q2; const u32x4 w = wv[q + q2];
                    const f32x4 g0 = *(const LAS f32x4*)(gmp + 8 * s2), g1 = *(const LAS f32x4*)(gmp + 8 * s2 + 4), s0 = *(const LAS f32x4*)(shp + 8 * s2), s1 = *(const LAS f32x4*)(shp + 8 * s2 + 4);
                    float h[8];
                    h[0] = bflo(w.x) * rstd * g0[0] + s0[0]; h[1] = bfhi(w.x) * rstd * g0[1] + s0[1]; h[2] = bflo(w.y) * rstd * g0[2] + s0[2]; h[3] = bfhi(w.y) * rstd * g0[3] + s0[3];
                    h[4] = bflo(w.z) * rstd * g1[0] + s1[0]; h[5] = bfhi(w.z) * rstd * g1[1] + s1[1]; h[6] = bflo(w.w) * rstd * g1[2] + s1[2]; h[7] = bfhi(w.w) * rstd * g1[3] + s1[3];
                    st8[2 * q2] = pk4_fp8(h[0], h[1], h[2], h[3]); st8[2 * q2 + 1] = pk4_fp8(h[4], h[5], h[6], h[7]);
                    const bf16x8 hb = pack8(h[0], h[1], h[2], h[3], h[4], h[5], h[6], h[7]);
                    accE = MFMA32(*(const LAS bf16x8*)(aE + 16 * s2), hb, accE);
                    accG = MFMA32(*(const LAS bf16x8*)(aG + 16 * s2), hb, accG); }
                *(u32x4*)(hrow + 8 * (s8 + q)) = st8;
            }
        }
        float gl[4];
#pragma unroll
        for (int o = 0; o < 4; ++o) gl[o] = accG[o] + bgp[o];
        int grp = 0; float gmax = gl[0];
#pragma unroll
        for (int o = 1; o < 4; ++o) if (gl[o] > gmax) { gmax = gl[o]; grp = o; }
        float gden = 0.f;
#pragma unroll
        for (int o = 0; o < 4; ++o) gden += __expf(gl[o] - gmax);
        float pgrp = 1.f / gden;
        grp = __shfl(grp, r); pgrp = __shfl(pgrp, r);
        float cv[4];
#pragma unroll
        for (int k = 0; k < 4; ++k) { const float v0 = accE[k], v1 = accE[4 + k], v2 = accE[8 + k], v3 = accE[12 + k];
            cv[k] = (grp == 0 ? v0 : grp == 1 ? v1 : grp == 2 ? v2 : v3) + bep[8 * grp + 4 * h2 + k]; }
        float a1 = -__builtin_inff(), a2 = -__builtin_inff(); int i1 = 0, i2 = 0;
#pragma unroll
        for (int k = 0; k < 4; ++k) { const float sv = cv[k]; const int id = 4 * h2 + k;
            if (sv > a1) { a2 = a1; i2 = i1; a1 = sv; i1 = id; } else if (sv > a2) { a2 = sv; i2 = id; } }
        const float b1 = __shfl_xor(a1, 32), b2 = __shfl_xor(a2, 32); const int j1 = __shfl_xor(i1, 32), j2 = __shfl_xor(i2, 32);
        float t1, t2; int e1, e2;
        if (n2_better(a1, i1, b1, j1)) { t1 = a1; e1 = i1; if (n2_better(a2, i2, b1, j1)) { t2 = a2; e2 = i2; } else { t2 = b1; e2 = j1; } }
        else { t1 = b1; e1 = j1; if (n2_better(a1, i1, b2, j2)) { t2 = a1; e2 = i1; } else { t2 = b2; e2 = j2; } }
        const float ex2 = __expf(t2 - t1), inv = 1.f / (1.f + ex2);
        if (h2 == 0) { const int e0g = grp * 8 + e1, e1g = grp * 8 + e2;
            tok_e[row * 2] = e0g; tok_e[row * 2 + 1] = e1g; tok_w[row * 2] = pgrp * inv; tok_w[row * 2 + 1] = pgrp * ex2 * inv;
            __hip_atomic_fetch_add((LAS unsigned*)(hist + e0g), 1u, __ATOMIC_RELAXED, __HIP_MEMORY_SCOPE_WORKGROUP); __hip_atomic_fetch_add((LAS unsigned*)(hist + e1g), 1u, __ATOMIC_RELAXED, __HIP_MEMORY_SCOPE_WORKGROUP); }
        __syncthreads();
        if (F.tid < 32) hist_g[vb * 32 + F.tid] = (int)hist[F.tid];
    }
}
DI void ph_scatter(Ctx& F) {
    unsigned char* ws = F.ws;
    const int* hist_g = (const int*)(ws + WS_HIST); const int* tok_e = (const int*)(ws + WS_TOKE);
    int* tok_s = (int*)(ws + WS_TOKS); int* slot_tok = (int*)(ws + WS_SLOTTOK); int* tile_e = (int*)(ws + WS_TILEE);
    LAS int* H = (LAS int*)F.lds; LAS int* eid = H + 8192; LAS int* tot = eid + 512; LAS int* base = tot + 32; LAS int* pstart = base + 32; LAS int* ptotal = pstart + 32; LAS int* ptot = ptotal + 32; LAS int* pbase = ptot + 512;
    for (int vb = F.bid; vb < T / 256; vb += F.G) {
        __syncthreads();
        for (int i = F.tid; i < 8192; i += NTHR) H[i] = hist_g[i];
        eid[F.tid] = tok_e[vb * 512 + F.tid];
        __syncthreads();
        { const int e_ = F.tid & 31, part = F.tid >> 5; int total = 0, before = 0;
#pragma unroll 4
          for (int q = 0; q < 16; ++q) { const int bb = part * 16 + q; const int c = H[bb * 32 + e_]; total += c; before += (bb < vb) ? c : 0; }
          ptot[part * 32 + e_] = total; pbase[part * 32 + e_] = before; }
        __syncthreads();
        if (F.tid < 32) { int total = 0, before = 0;
#pragma unroll
            for (int q = 0; q < 16; ++q) { total += ptot[q * 32 + F.tid]; before += pbase[q * 32 + F.tid]; }
            tot[F.tid] = total; base[F.tid] = before; }
        __syncthreads();
        if (F.tid == 0) { int ps = 0; for (int e = 0; e < 32; ++e) { pstart[e] = ps; ps += ((tot[e] + 255) >> 8) << 8; } ptotal[0] = ps; }
        __syncthreads();
        const int e = eid[F.tid]; int rank = 0;
        for (int j = 0; j < F.tid; ++j) rank += (eid[j] == e) ? 1 : 0;
        const int slot = pstart[e] + base[e] + rank;
        slot_tok[slot] = vb * 256 + (F.tid >> 1); tok_s[vb * 512 + F.tid] = slot;
        if (vb == 0) {
            if (F.tid < 32) { const int ee = F.tid, s0 = pstart[ee] + tot[ee], s1 = pstart[ee] + (((tot[ee] + 255) >> 8) << 8);
                for (int s = s0; s < s1; ++s) slot_tok[s] = 0;
                for (int tl = pstart[ee] >> 8; tl < (s1 >> 8); ++tl) tile_e[tl] = ee; }
            if (F.tid == 0) tile_e[1023] = ptotal[0] >> 8;
        }
    }
}
DI void ph_final(Ctx& F) {
    const KParams& P = *F.p; unsigned char* ws = F.ws;
    const int gw = F.bid * NWAVES + F.wave, NGW = F.G * NWAVES;
    const float* modf = (const float*)(ws + WS_MODF); float* X = (float*)P.out; const bf16* XB = (const bf16*)(ws + WS_XB); const float* fg = PIN(I_FINALG);
    for (int blk = gw; blk < T / 32; blk += NGW) {
        const int row0 = blk * 32, b = row0 / SEQ;
        f32x4 g2[4], gf[4];
        mod_vec_f(modf, DEPTH - 1, b, 5, F.lane, g2);
#pragma unroll
        for (int j = 0; j < 4; ++j) gf[j] = *(const f32x4*)(fg + 4 * F.lane + 256 * j);
        const int* ts = (const int*)(ws + WS_TOKS); const float* tw = (const float*)(ws + WS_TOKW); const unsigned char* ybp = ws + WS_YB;
        const int rw = row0 + (F.lane & 31);
        const int sl0 = __hip_atomic_load(ts + rw * 2, __ATOMIC_RELAXED, __HIP_MEMORY_SCOPE_AGENT), sl1 = __hip_atomic_load(ts + rw * 2 + 1, __ATOMIC_RELAXED, __HIP_MEMORY_SCOPE_AGENT);
        const float wl0 = __hip_atomic_load(tw + rw * 2, __ATOMIC_RELAXED, __HIP_MEMORY_SCOPE_AGENT), wl1 = __hip_atomic_load(tw + rw * 2 + 1, __ATOMIC_RELAXED, __HIP_MEMORY_SCOPE_AGENT);
        RowIn Rn, Rn2; rowin_load<true, false>(Rn, XB + (size_t)row0 * D, ybp, rdlane_i(sl0, 0), rdlane_i(sl1, 0), F.lane); rowin_load<true, false>(Rn2, XB + (size_t)(row0 + 1) * D, ybp, rdlane_i(sl0, 1), rdlane_i(sl1, 1), F.lane);
        for (int r = 0; r < 32; ++r) { const int row = row0 + r;
            RowIn Rc = Rn; Rn = Rn2;
            if (r + 2 < 32) rowin_load<true, false>(Rn2, XB + (size_t)(row + 2) * D, ybp, rdlane_i(sl0, r + 2), rdlane_i(sl1, r + 2), F.lane);
            f32x4 v[4]; rowin_combine(Rc, rdlane(wl0, r) * (1.f / pg8::MOE_S_Y), rdlane(wl1, r) * (1.f / pg8::MOE_S_Y), g2, v);
            const float rstd = row_rstd(v);
#pragma unroll
            for (int j = 0; j < 4; ++j) *(f32x4*)(X + (size_t)row * D + 4 * F.lane + 256 * j) = v[j] * rstd * gf[j];
        }
    }
}

constexpr int N_PHASES = 46;
#ifndef EN
#define EN 0xFFFFu
#endif
#ifdef PROBE_GROUP
#ifndef PROBE_LAYER
#define PROBE_LAYER (-1)
#endif
#ifndef PROBE_UNIT_US
#define PROBE_UNIT_US 8.f
#endif
#ifndef PROBE_L2
#define PROBE_L2 (-1)
#endif
#endif
#define ENB(i) (((EN) >> (i)) & 1u)
__host__ __device__ inline bool phase_exists(int k) { if (k == 0 || k == 45) return true; const int l = (k - 1) / 11, j = (k - 1) % 11; if (j == 3) return l == 1 || l == 3; if (j == 4) return l == 1; if (j == 5) return false; return true; }

#define RUN(k) (ph_lo <= (k) && (k) < ph_hi)
#define FRESH() int t_ = threadIdx.x; asm volatile("" : "+v"(t_)); F.tid = t_; F.lane = t_ & 63; F.wave = __builtin_amdgcn_readfirstlane(t_ >> 6); \
    { const KParams* kp_ = (const KParams*)__builtin_amdgcn_kernarg_segment_ptr(); asm volatile("" : "+s"(kp_)); F.p = kp_; } GAS unsigned char* wsg_ = F.p->ws; asm volatile("" : "+s"(wsg_)); unsigned char* ws = (unsigned char*)wsg_;   F.ws = ws; bf16* HO = (bf16*)(ws + WS_HO); bf16* BIG = (bf16*)(ws + WS_BIG); float* modf = (float*)(ws + WS_MODF); (void)HO; (void)BIG; (void)modf
#ifdef PROBE_GROUP
#define PROBE(grp, lay) do { const unsigned long long t_ = __builtin_amdgcn_s_memrealtime(); if ((grp) == PROBE_GROUP && (PROBE_LAYER < 0 || (lay) == PROBE_LAYER)) pr_acc += t_ - pr_prev; pr_prev = t_; } while (0)
#else
#define PROBE(grp, lay) do { } while (0)
#endif
#if MK_N_LAUNCHES == 1
#define SEAM(k) do { int hi_ = ph_hi; asm volatile("" : "+s"(hi_)); if ((k) + 1 < hi_) { PROBE_BAR(99); SPREAD_ARRIVE(k); xcd_barrier<false>(bar); PROBE_BAR(16); } } while (0)
#define SEAM0() do { if (1 < ph_hi) xcd_barrier<true>(bar); } while (0)
#else
#define SEAM(k) do { } while (0)
#define SEAM0() do { } while (0)
#endif
#if defined(PROBE_GROUP) && PROBE_GROUP == 16
#define PROBE_BAR(g) PROBE(g, 0)
#else
#define PROBE_BAR(g) do { } while (0)
#endif
#if defined(PROBE_GROUP) && PROBE_GROUP == 17
#define SPREAD_ARRIVE(k) do { if (threadIdx.x == 0) { const unsigned long long t_ = __builtin_amdgcn_s_memrealtime(); unsigned long long* sp_ = (unsigned long long*)((unsigned char*)F.p->ws + WS_CTL + 65536); \
        atomicMax(sp_ + (k), ~t_); atomicMax(sp_ + 64 + (k), t_); } } while (0)
#else
#define SPREAD_ARRIVE(k) do { } while (0)
#endif
template <int l> DI void run_layer(Ctx& F, const XcdBarrier& bar, const int ph_lo, const int ph_hi, unsigned long long& pr_prev, unsigned long long& pr_acc) {
        const int pb = 1 + 11 * l;
        if (ENB(1) && RUN(pb + 0)) { FRESH(); ph_norm1(F, l); SEAM(pb + 0); PROBE(1, l); }
        if (ENB(2) && RUN(pb + 1)) { FRESH();
            const int N = (l == 3) ? 4608 : 3072;
            const void* Bt = ws + (l == 0 ? W_SBIN : l == 1 ? W_GLAIN : l == 2 ? W_CONVIN : W_DILIN);
            pg8::DenseSched S; S.init(T, N, in_fp8(l) ? D : D * 2, Bt, F.G, F.bid);
            pg8::EpiProj E; E.O = BIG; E.ldc = N; E.period = (l == 3) ? 1536 : 3072; E.qcols = (l == 0) ? 1024 : (l == 2) ? 0 : 512;
            E.qscale = (l == 1) ? 0.08838834764831845f : 0.125f * LOG2E; E.base = in_fp8(l) ? 1.f / pg8::MOE_S_W1 : 1.f;
            if constexpr (in_fp8(l)) pg8::gemm_phase<pg8::EpiProj, pg8::DenseSched, true, true>(F.tid, F.lds, (const char*)HO, D, D / 128, S, E);
            else pg8::gemm_phase<pg8::EpiProj, pg8::DenseSched, true, false>(F.tid, F.lds, (const char*)HO, D * 2, D / 64, S, E);
            SEAM(pb + 1); PROBE(2, l);
        }
        if (RUN(pb + 2)) { FRESH();
            if (l == 0) { if (ENB(3)) ph_sb_attn(F); } else if (l == 1) { if (ENB(4)) ph_gla_g1(F); } else if (l == 2) { if (ENB(5)) ph_conv(F); } else { if (ENB(6)) ph_dil_attn(F); }
            SEAM(pb + 2); PROBE(3 + l, l);
        }
        if ((l == 1 || l == 3) && RUN(pb + 3)) { FRESH(); if (l == 1) { if (ENB(7)) ph_gla_g2<0>(F); } else { if (ENB(8)) ph_dil_combine(F); } SEAM(pb + 3); PROBE(l == 1 ? 7 : 8, l); }
        if (ENB(7) && l == 1 && RUN(pb + 4)) { FRESH(); ph_gla_g2<1>(F); SEAM(pb + 4); PROBE(7, l); }
        if (ENB(10) && RUN(pb + 6)) { FRESH();
            constexpr int K = (l == 3) ? 512 : D;
            const void* Bt = ws + (l == 0 ? W_SBOUT : l == 1 ? W_GLAOUT : l == 2 ? W_CONVOUT : W_DILOUT);
            pg8::EpiResid<l == 0> E; E.resid = (l == 0) ? (const void*)(const float*)F.p->in[I_X] : (const void*)(ws + WS_XB); E.out = (bf16*)(ws + WS_XB); E.gate = modf + (size_t)l * NB * 6144 + 2 * D; E.ssp = (float*)(ws + WS_SSP);
            if constexpr (out_fp8(l)) {
                const char* A = (l == 1) ? (const char*)(ws + WS_KST) : (const char*)HO;
                pg8::DenseSched S; S.init(T, D, K, Bt, F.G, F.bid); E.gscale = 1.f / pg8::MOE_S_W1;
                pg8::gemm_phase<pg8::EpiResid<l == 0>, pg8::DenseSched, true, true>(F.tid, F.lds, A, K, K / 128, S, E);
            } else {
                const int lda = (l == 0) ? 3072 : K; const char* A = (l == 0) ? (const char*)BIG : (const char*)HO;
                pg8::DenseSched S; S.init(T, D, K * 2, Bt, F.G, F.bid); E.gscale = 1.f;
                pg8::gemm_phase<pg8::EpiResid<l == 0>, pg8::DenseSched, true>(F.tid, F.lds, A, lda * 2, K / 64, S, E);
            }
            SEAM(pb + 6); PROBE(10, l);
        }
        if (ENB(11) && RUN(pb + 7)) { FRESH(); ph_norm2(F, l); SEAM(pb + 7); PROBE(11, l); }
        if (ENB(12) && RUN(pb + 8)) { FRESH(); ph_scatter(F); SEAM(pb + 8); PROBE(12, l); }
        if (ENB(13) && RUN(pb + 9)) { FRESH();
            const int* tile_e = (const int*)(ws + WS_TILEE);
            const int ntiles = __builtin_amdgcn_readfirstlane(__hip_atomic_load(tile_e + 1023, __ATOMIC_RELAXED, __HIP_MEMORY_SCOPE_AGENT));
            pg8::MoeSched<true> S; S.G = F.G; S.c = (F.G % 8 == 0) ? (F.bid % 8) * (F.G / 8) + F.bid / 8 : F.bid;     S.ldb = D; S.Bt = (const char*)(ws + WS_W1T); S.estride = (size_t)1024 * D; S.tile_e = tile_e; S.slot_tok = (const int*)(ws + WS_SLOTTOK); S.nunits = ntiles * 4;
            pg8::EpiMoe1 E; E.O = (unsigned char*)(ws + WS_ACT);
            pg8::gemm_phase<pg8::EpiMoe1, pg8::MoeSched<true>, true, true>(F.tid, F.lds, (const char*)HO, D, D / 128, S, E);
            SEAM(pb + 9); PROBE(13, l);
        }
        if (ENB(14) && RUN(pb + 10)) { FRESH();
            const int* tile_e = (const int*)(ws + WS_TILEE);
            const int ntiles = __builtin_amdgcn_readfirstlane(__hip_atomic_load(tile_e + 1023, __ATOMIC_RELAXED, __HIP_MEMORY_SCOPE_AGENT));
            pg8::MoeSched<false> S; S.G = F.G; S.c = (F.G % 8 == 0) ? (F.bid % 8) * (F.G / 8) + F.bid / 8 : F.bid;     S.ldb = MOE_FF; S.Bt = (const char*)(ws + WS_W2T); S.estride = (size_t)1024 * MOE_FF; S.tile_e = tile_e; S.slot_tok = nullptr; S.nunits = ntiles * 4;
            pg8::EpiY8 E; E.O = ws + WS_YB; E.s = pg8::MOE_S_Y / (pg8::MOE_S_ACT * pg8::MOE_S_W2);
            pg8::gemm_phase<pg8::EpiY8, pg8::MoeSched<false>, true, true>(F.tid, F.lds, (const char*)(ws + WS_ACT), MOE_FF, MOE_FF / 128, S, E);
            SEAM(pb + 10); PROBE(14, l);
        }
    }

__global__ void __launch_bounds__(NTHR, 2) fwd(Params P) {
    extern __shared__ __attribute__((aligned(16))) unsigned char lds_raw[];
    Ctx F;
    F.lds = (LAS unsigned char*)lds_raw; F.MISC = (volatile LAS unsigned*)(F.lds + MISC_OFF);
    F.tid = threadIdx.x; F.lane = F.tid & 63; F.wave = __builtin_amdgcn_readfirstlane(F.tid >> 6); F.G = gridDim.x; F.bid = blockIdx.x; F.p = (const KParams*)__builtin_amdgcn_kernarg_segment_ptr();
    if (F.tid < 128) F.MISC[F.tid] = 0u;
    __syncthreads();
    const int ph_lo = F.p->ph_lo, ph_hi = F.p->ph_hi;
    XcdBarrier bar; bar.bar = nullptr; bar.x = 0; bar.st = nullptr;
#if MK_N_LAUNCHES == 1
    bar = xcd_barrier_post((unsigned*)((unsigned char*)F.p->ws + WS_CTL) + CW_BAR, F.MISC + 8);
#endif
    unsigned long long pr_prev = 0ull, pr_acc = 0ull;
#ifdef PROBE_GROUP
    pr_prev = __builtin_amdgcn_s_memrealtime();
#endif
    if (ENB(0) && RUN(0)) { FRESH(); ph_prologue(F); SEAM0(); PROBE(0, 0); }
    run_layer<0>(F, bar, ph_lo, ph_hi, pr_prev, pr_acc);
    run_layer<1>(F, bar, ph_lo, ph_hi, pr_prev, pr_acc);
    run_layer<2>(F, bar, ph_lo, ph_hi, pr_prev, pr_acc);
    run_layer<3>(F, bar, ph_lo, ph_hi, pr_prev, pr_acc);
    if (ENB(15) && RUN(45)) { FRESH(); ph_final(F); PROBE(15, 0); }
#ifdef PROBE_GROUP
#if PROBE_GROUP == 17
    if (blockIdx.x == 0 && threadIdx.x == 0) { unsigned long long* sp_ = (unsigned long long*)((unsigned char*)F.p->ws + WS_CTL + 65536); pr_acc = 0ull;
        for (int k = 1; k < 45; ++k) { const unsigned long long mn = ~__hip_atomic_load(sp_ + k, __ATOMIC_RELAXED, __HIP_MEMORY_SCOPE_AGENT), mx = __hip_atomic_load(sp_ + 64 + k, __ATOMIC_RELAXED, __HIP_MEMORY_SCOPE_AGENT);
            const int j = (k - 1) % 11, ll = (k - 1) / 11; if (mx != 0ull && (PROBE_LAYER < 0 || j == PROBE_LAYER) && (PROBE_L2 < 0 || ll == PROBE_L2)) pr_acc += mx - mn; } }
#endif
    if (blockIdx.x == 0 && threadIdx.x == 0) { asm volatile("s_waitcnt vmcnt(0)" ::: "memory"); ((float*)F.p->out)[0] = 8.f + (float)pr_acc * (1.f / (100.f * PROBE_UNIT_US)); }
#endif
}
#undef RUN
#undef SEAM
#undef SEAM0
#undef FRESH
#undef PROBE

extern "C" void kernel_launch(void* const* d_in, const int* in_sizes, int n_in, void* d_out, int out_size, void* d_ws, size_t ws_size, hipStream_t stream) {
    static int grid = 0;
    if (grid == 0) {
        if (n_in != 26 || out_size != T * D || ws_size < WS_END) { fprintf(stderr, "kernel_launch: unexpected shapes (n_in %d, out %d, ws %zu < %zu)\n", n_in, out_size, ws_size, (size_t)WS_END); grid = -1; return; }
        int dev = 0, cus = 0, per_cu = 0;
        if (hipGetDevice(&dev) != hipSuccess || hipDeviceGetAttribute(&cus, hipDeviceAttributeMultiprocessorCount, dev) != hipSuccess) { grid = -1; return; }
        if (hipFuncSetAttribute((const void*)fwd, hipFuncAttributeMaxDynamicSharedMemorySize, LDS_BYTES) != hipSuccess) { fprintf(stderr, "kernel_launch: hipFuncSetAttribute failed\n"); grid = -1; return; }
        if (hipOccupancyMaxActiveBlocksPerMultiprocessor(&per_cu, (const void*)fwd, NTHR, LDS_BYTES) != hipSuccess || per_cu < 1) fprintf(stderr, "kernel_launch: occupancy query reports %d\n", per_cu);
        (void)hipGetLastError();
        grid = cus;
    }
    if (grid < 0) return;
    (void)hipMemsetAsync((char*)d_ws + WS_CTL, 0, CTL_ZERO_BYTES, stream);
    Params p{};
    for (int i = 0; i < 26; ++i) p.in[i] = (const float*)d_in[i];
    p.out = (float*)d_out; p.ws = (unsigned char*)d_ws;
#if MK_N_LAUNCHES == 1
    p.ph_lo = 0; p.ph_hi = N_PHASES;
    hipLaunchKernelGGL(fwd, dim3(grid), dim3(NTHR), LDS_BYTES, stream, p);
#else
    for (int k = 0; k < N_PHASES; ++k) { if (!phase_exists(k)) continue; p.ph_lo = k; p.ph_hi = k + 1; hipLaunchKernelGGL(fwd, dim3(grid), dim3(NTHR), LDS_BYTES, stream, p); }
#endif
}
```

```cpp
#include <hip/hip_runtime.h>
#include <cstdio>
#include <cstdint>
#ifndef MK_N_LAUNCHES
#define MK_N_LAUNCHES 1
#endif
#define LAS __attribute__((address_space(3)))
#define GAS __attribute__((address_space(1)))
typedef unsigned short bf16;
typedef short bf16x8 __attribute__((ext_vector_type(8)));
typedef short s16x4 __attribute__((ext_vector_type(4)));
typedef float f32x2 __attribute__((ext_vector_type(2)));
typedef float f32x4 __attribute__((ext_vector_type(4)));
typedef float f32x16 __attribute__((ext_vector_type(16)));
typedef unsigned u32x2 __attribute__((ext_vector_type(2)));
typedef unsigned u32x4 __attribute__((ext_vector_type(4)));
typedef int i32x4 __attribute__((ext_vector_type(4)));
typedef int i32x8 __attribute__((ext_vector_type(8)));
#define DI __device__ __forceinline__

constexpr int NB = 8, SEQ = 8192, D = 1024, T = NB * SEQ, DEPTH = 4;
constexpr float RMS_EPS = 1e-6f;
constexpr float LOG2E = 1.4426950408889634f;
constexpr int NWAVES = 8, NTHR = 512;
constexpr int MOE_E = 32, MOE_FF = 512;
constexpr int PMAX = 2 * T + MOE_E * 256;
constexpr int KSPLIT = 8;
#ifndef INFP8_MASK
#define INFP8_MASK 0x9
#endif
#ifndef OUTFP8_MASK
#define OUTFP8_MASK 0x8
#endif
__host__ __device__ constexpr bool out_fp8(int l) { return ((OUTFP8_MASK) >> l) & 1; }
__host__ __device__ constexpr bool in_fp8(int l) { return ((INFP8_MASK) >> l) & 1; }

constexpr size_t MiB = 1u << 20;
constexpr size_t WS_CTL = 0, CTL_ZERO_BYTES = 1 * MiB;
constexpr size_t WS_MODP = 2 * MiB;
constexpr size_t WS_MODF = 9 * MiB;
constexpr size_t WS_TOKE = 10 * MiB;
constexpr size_t WS_TOKW = WS_TOKE + 512 * 1024;
constexpr size_t WS_TOKS = WS_TOKW + 512 * 1024;
constexpr size_t WS_SLOTTOK = WS_TOKS + 512 * 1024;
constexpr size_t WS_HIST = 13 * MiB;
constexpr size_t WS_TILEE = WS_HIST + 64 * 1024;
constexpr size_t WS_GDOWN = 14 * MiB;
constexpr size_t WS_DECAY = 18 * MiB;
constexpr size_t WS_LSE = 20 * MiB;
constexpr size_t WS_WMIX = 26 * MiB;
constexpr size_t W_SBIN = WS_WMIX, W_SBOUT = W_SBIN + 6 * MiB, W_GLAIN = W_SBOUT + 2 * MiB, W_GLAOUT = W_GLAIN + 6 * MiB, W_CONVIN = W_GLAOUT + 2 * MiB,
                 W_CONVOUT = W_CONVIN + 6 * MiB, W_DILIN = W_CONVOUT + 2 * MiB, W_DILOUT = W_DILIN + 9 * MiB;
constexpr size_t WS_W1T = 62 * MiB;
constexpr size_t WS_W2T = 126 * MiB;
constexpr size_t WS_HO = 158 * MiB;
constexpr size_t WS_BIG = 286 * MiB;
constexpr size_t WS_KST = WS_BIG + 384 * MiB;
constexpr size_t WS_VT = WS_KST + 64 * MiB;
constexpr size_t WS_SC = WS_VT + 128 * MiB;
constexpr size_t WS_ACT = WS_BIG;
constexpr size_t WS_YB = WS_BIG + 140 * MiB;
constexpr size_t WS_SEND = WS_SC + 32 * MiB;
constexpr size_t WS_DSEG = WS_SEND + 32 * MiB;
constexpr size_t WS_XB = WS_DSEG + 1 * MiB;
constexpr size_t WS_SSP = WS_XB + 128 * MiB;
constexpr size_t WS_END = WS_SSP + 4 * MiB;
constexpr int CW_BAR = 4096;

constexpr int LDS_BYTES = 160 * 1024 - 512;
constexpr int MISC_OFF = LDS_BYTES - 512;

DI unsigned f2bf(float f) { unsigned u = __builtin_bit_cast(unsigned, f); return (u + 0x7fffu + ((u >> 16) & 1u)) >> 16; }
typedef __bf16 bf16n2 __attribute__((ext_vector_type(2)));
DI unsigned pk2(float lo, float hi) { const f32x2 v = {lo, hi}; return __builtin_bit_cast(unsigned, __builtin_convertvector(v, bf16n2)); }
DI unsigned pk4_fp8(float a, float b, float c, float d) {
    a = __builtin_amdgcn_fmed3f(a, -448.f, 448.f); b = __builtin_amdgcn_fmed3f(b, -448.f, 448.f); c = __builtin_amdgcn_fmed3f(c, -448.f, 448.f); d = __builtin_amdgcn_fmed3f(d, -448.f, 448.f);
    int w = 0; w = __builtin_amdgcn_cvt_pk_fp8_f32(a, b, w, false); w = __builtin_amdgcn_cvt_pk_fp8_f32(c, d, w, true); return (unsigned)w;
}
DI float bf2f(unsigned short b) { return __builtin_bit_cast(float, (unsigned)b << 16); }
DI float bflo(unsigned w) { return __builtin_bit_cast(float, w << 16); }
DI float bfhi(unsigned w) { return __builtin_bit_cast(float, w & 0xffff0000u); }
DI float wave_sum(float v) {
#pragma unroll
    for (int o = 1; o < 64; o <<= 1) v += __shfl_xor(v, o);
    return v;
}
template <int N> DI float halving_reduce(float (&a)[N], int lane) {
    int bit = 32;
#pragma unroll
    for (int n = N; n > 1; n >>= 1) {
        const bool hi = (lane & bit) != 0;
#pragma unroll
        for (int i = 0; i < n / 2; ++i) { const float keep = hi ? a[n / 2 + i] : a[i], send = hi ? a[i] : a[n / 2 + i]; a[i] = keep + __shfl_xor(send, bit); }
        bit >>= 1;
    }
    float k = a[0];
#pragma unroll
    for (; bit >= 1; bit >>= 1) k += __shfl_xor(k, bit);
    return k;
}
DI float rdlane(float v, int l) { return __builtin_bit_cast(float, __builtin_amdgcn_readlane(__builtin_bit_cast(int, v), l)); }
DI float fexp2(float x) { return __builtin_amdgcn_exp2f(x); }
DI float flog2(float x) { return __builtin_amdgcn_logf(x); }
#define LDS_WAIT() asm volatile("s_waitcnt lgkmcnt(0)" ::: "memory")
#define VM_WAIT() asm volatile("s_waitcnt vmcnt(0)" ::: "memory")

#define XB_TMO      128
#define XB_XCNT(j)  (256  + 64 * (j))
#define XB_XSUB(j)  (1280 + 64 * (j))
#define XB_XGEN(j)  (2304 + 64 * (j))
#define XB_TOP      3328
#define XB_TOPGEN   3392
#define XCD_BAR_WORDS 3456
#define XB_SPIN_CAP (1u << 20)
DI unsigned xb_ld(unsigned* p)              { return __hip_atomic_load(p, __ATOMIC_RELAXED, __HIP_MEMORY_SCOPE_AGENT); }
DI unsigned xb_add(unsigned* p, unsigned v) { return __hip_atomic_fetch_add(p, v, __ATOMIC_RELAXED, __HIP_MEMORY_SCOPE_AGENT); }
DI unsigned xb_xcc_id() { return (unsigned)__builtin_amdgcn_s_getreg((3 << 11) | 20) & 0xFu; }
#define XB_SPIN(cond, bar) do { unsigned _sp = 0; while (cond) { __builtin_amdgcn_s_sleep(1); \
    if ((++_sp & 255u) == 0u) { if (xb_ld(&(bar)[XB_TMO])) break; if (_sp > XB_SPIN_CAP) { atomicAdd(&(bar)[XB_TMO], 1u); break; } } } } while (0)
struct XcdBarrier { unsigned* bar; unsigned x; volatile LAS unsigned* st; };
DI XcdBarrier xcd_barrier_post(unsigned* bar, volatile LAS unsigned* st) {
    XcdBarrier b; b.bar = bar; b.x = xb_xcc_id(); b.st = st;
    if (threadIdx.x == 0) (void)xb_add(&bar[XB_XCNT(b.x)], 1u);
    return b;
}
DI void xcd_barrier_complete(unsigned* bar, unsigned x, unsigned& nloc, unsigned& nx) {
    const unsigned G = gridDim.x * gridDim.y * gridDim.z;
    unsigned sum, cnt, mine, sp = 0u;
    for (;;) {
        sum = 0u; cnt = 0u; mine = 0u;
#pragma unroll
        for (unsigned j = 0; j < 16; ++j) { const unsigned c = xb_ld(&bar[XB_XCNT(j)]); sum += c; cnt += (c > 0u) ? 1u : 0u; mine = (j == x) ? c : mine; }
        if (sum == G) break;
        __builtin_amdgcn_s_sleep(1);
        if ((++sp & 255u) == 0u) { if (xb_ld(&bar[XB_TMO])) break; if (sp > XB_SPIN_CAP) { atomicAdd(&bar[XB_TMO], 1u); break; } }
    }
    nloc = mine > 0u ? mine : 1u; nx = cnt > 0u ? cnt : 1u;
}
template <bool FIRST> DI void xcd_barrier(const XcdBarrier& b) {
    asm volatile("s_waitcnt vmcnt(0)" ::: "memory");
    __syncthreads();
    if (threadIdx.x == 0) {
        unsigned* bar = b.bar;
        __builtin_amdgcn_s_waitcnt(0);
        unsigned nloc = b.st[0], nx = b.st[1];
        if constexpr (FIRST) { if (nloc == 0u) { xcd_barrier_complete(bar, b.x, nloc, nx); b.st[0] = nloc; b.st[1] = nx; } }
        const unsigned old = xb_add(&bar[XB_XSUB(b.x)], 1u);
        const unsigned gen = old / nloc;
        if (old + 1u == (gen + 1u) * nloc) {
            __builtin_amdgcn_fence(__ATOMIC_RELEASE, "agent");
            asm volatile("s_waitcnt vmcnt(0)" ::: "memory");
            const unsigned og = xb_add(&bar[XB_TOP], 1u);
            const unsigned tg = og / nx;
            if (og + 1u == (tg + 1u) * nx) xb_add(&bar[XB_TOPGEN], 1u);
            else XB_SPIN(xb_ld(&bar[XB_TOPGEN]) == tg, bar);
            __builtin_amdgcn_fence(__ATOMIC_ACQUIRE, "agent");
            xb_add(&bar[XB_XGEN(b.x)], 1u);
            asm volatile("s_waitcnt vmcnt(0)" ::: "memory");
        } else {
            XB_SPIN(xb_ld(&bar[XB_XGEN(b.x)]) == gen, bar);
            __builtin_amdgcn_fence(__ATOMIC_ACQUIRE, "agent");
            asm volatile("s_waitcnt vmcnt(0)" ::: "memory");
        }
    }
    __syncthreads();
}

namespace pg8 {
constexpr int BM = 256, BK = 64, HALF = 128, HTB = HALF * BK * 2, STAGE_BYTES = 8 * HTB, NXCD = 8, WGM = 8;
DI int lds_byte(int r, int c) { const int st = (r >> 4) * 2 + (c >> 5), rr = r & 15, cc = c & 31, ob = rr * 64 + cc * 2; return st * 1024 + (ob ^ (((ob >> 9) & 1) << 5)); }
DI void stage_rc(int b, int& R, int& C) { const int st = b / 1024, sb = b % 1024, swz = sb ^ (((sb >> 9) & 1) << 5); R = (st >> 1) * 16 + swz / 64; C = (st & 1) * 32 + (swz % 64) / 2; }
DI int perm32(int rho) { const int n = rho >> 4, i = rho & 15; return 8 * (i >> 2) + 4 * n + (i & 3); }
struct Unit { int pm, pn, eb; };

struct DenseSched {
    int nM, nN, nwg, G, c; const char* Bt; int ldb;
    DI void init(int M, int N, int ldb_bytes, const void* Bt_, int G_, int c_) { nM = M / BM; nN = N / BM; nwg = nM * nN; G = G_; c = c_; Bt = (const char*)Bt_; ldb = ldb_bytes; }
    DI bool next(int i, Unit& u) const {
        const long L = (long)i * G + c; if (L >= nwg) return false;
        int wgid = (int)L; { const int q = nwg / NXCD, r = nwg % NXCD, xcd = wgid % NXCD, off = wgid / NXCD; wgid = (xcd < r ? xcd * (q + 1) : r * (q + 1) + (xcd - r) * q) + off; }
        const int nig = WGM * nN, gid = wgid / nig, fm = gid * WGM, gsz = (nM - fm) < WGM ? (nM - fm) : WGM;
        u.pm = fm + ((wgid % nig) % gsz); u.pn = (wgid % nig) / gsz; u.eb = 0; return true;
    }
    DI unsigned a_row(const Unit& u, int r) const { return (unsigned)(u.pm * BM + r); }
    DI const char* b_base(const Unit& u) const { return Bt + (size_t)u.pn * BM * ldb; }
};
template <bool GATHER> struct MoeSched {
    int G, c, ldb; const char* Bt; size_t estride; const int* tile_e; const int* slot_tok; int nunits;
    DI bool next(int i, Unit& u) const {
        const int L = i * G + c; if (L >= nunits) return false;
        u.pm = L >> 2; u.pn = L & 3; u.eb = __builtin_amdgcn_readfirstlane(__hip_atomic_load(tile_e + u.pm, __ATOMIC_RELAXED, __HIP_MEMORY_SCOPE_AGENT)); return true;
    }
    DI unsigned a_row(const Unit& u, int r) const { if (GATHER) return (unsigned)__hip_atomic_load(slot_tok + u.pm * BM + r, __ATOMIC_RELAXED, __HIP_MEMORY_SCOPE_AGENT); return (unsigned)(u.pm * BM + r); }
    DI const char* b_base(const Unit& u) const { return Bt + (size_t)u.eb * estride + (size_t)u.pn * BM * ldb; }
};

struct EpiProj {
    static constexpr bool PERM = true;
    bf16* O; int ldc; int period, qcols; float qscale, base;
    DI void operator()(const f32x4 (&acc)[2][2][4][2], const Unit& u, int wr, int wc, int fr, int fq) const {
        const int row0 = u.pm * BM + wr * 64 + fr, colt = u.pn * BM;
        const float sc = base * (((colt % period) < qcols) ? qscale : 1.f);
        const int col0 = colt + wc * 32 + 8 * fq;
#pragma unroll
        for (int ai = 0; ai < 2; ++ai)
#pragma unroll
            for (int m = 0; m < 4; ++m) { bf16* rowp = O + (size_t)(row0 + ai * HALF + m * 16) * ldc + col0;
#pragma unroll
                for (int bj = 0; bj < 2; ++bj) { const f32x4 v0 = acc[ai][bj][m][0] * sc, v1 = acc[ai][bj][m][1] * sc;
                    u32x4 w; w.x = pk2(v0[0], v0[1]); w.y = pk2(v0[2], v0[3]); w.z = pk2(v1[0], v1[1]); w.w = pk2(v1[2], v1[3]);
                    *(u32x4*)(rowp + bj * HALF) = w; } }
    }
};
constexpr float MOE_S_W1 = 32.f, MOE_S_ACT = 8.f, MOE_S_W2 = 16.f;
struct EpiMoe1 {
    static constexpr bool PERM = true;
    unsigned char* O;
    DI void operator()(const f32x4 (&acc)[2][2][4][2], const Unit& u, int wr, int wc, int fr, int fq) const {
        const int row0 = u.pm * BM + wr * 64 + fr, col0 = u.pn * 128 + wc * 32 + 8 * fq;
#pragma unroll
        for (int ai = 0; ai < 2; ++ai)
#pragma unroll
            for (int m = 0; m < 4; ++m) { unsigned char* rowp = O + (size_t)(row0 + ai * HALF + m * 16) * MOE_FF + col0;
                float r[8];
#pragma unroll
                for (int n = 0; n < 2; ++n)
#pragma unroll
                    for (int e = 0; e < 4; ++e) { const float g = acc[ai][0][m][n][e] * (1.f / MOE_S_W1), up = acc[ai][1][m][n][e] * (MOE_S_ACT / MOE_S_W1);
                        r[n * 4 + e] = g * __builtin_amdgcn_rcpf(1.f + fexp2(-g * LOG2E)) * up; }
                u32x2 w; w.x = pk4_fp8(r[0], r[1], r[2], r[3]); w.y = pk4_fp8(r[4], r[5], r[6], r[7]);
                *(u32x2*)rowp = w; }
    }
};
constexpr float MOE_S_Y = 16.f;
struct EpiY8 {
    static constexpr bool PERM = true;
    unsigned char* O; float s;
    DI void operator()(const f32x4 (&acc)[2][2][4][2], const Unit& u, int wr, int wc, int fr, int fq) const {
        const int row0 = u.pm * BM + wr * 64 + fr, col0 = u.pn * BM + wc * 32 + 8 * fq;
#pragma unroll
        for (int ai = 0; ai < 2; ++ai)
#pragma unroll
            for (int m = 0; m < 4; ++m) { unsigned char* rowp = O + (size_t)(row0 + ai * HALF + m * 16) * D + col0;
#pragma unroll
                for (int bj = 0; bj < 2; ++bj) { const f32x4 v0 = acc[ai][bj][m][0] * s, v1 = acc[ai][bj][m][1] * s;
                    u32x2 w; w.x = pk4_fp8(v0[0], v0[1], v0[2], v0[3]); w.y = pk4_fp8(v1[0], v1[1], v1[2], v1[3]);
                    *(u32x2*)(rowp + bj * HALF) = w; } }
    }
};
template <bool RF32> struct EpiResid {
    static constexpr bool PERM = true;
    const void* resid; bf16* out; const float* gate; float gscale; float* ssp;
    DI void operator()(const f32x4 (&acc)[2][2][4][2], const Unit& u, int wr, int wc, int fr, int fq) const {
        const int row0 = u.pm * BM + wr * 64 + fr, col0 = u.pn * BM + wc * 32 + 8 * fq;
        const float* gv = gate + (size_t)((u.pm * BM) / SEQ) * 6144 + col0;
        f32x4 g[2][2];
#pragma unroll
        for (int bj = 0; bj < 2; ++bj)
#pragma unroll
            for (int n = 0; n < 2; ++n) g[bj][n] = *(const f32x4*)(gv + bj * HALF + 4 * n) * gscale;
#pragma unroll
        for (int ai = 0; ai < 2; ++ai)
#pragma unroll
            for (int m = 0; m < 4; ++m) { const size_t off = (size_t)(row0 + ai * HALF + m * 16) * D + col0; float sq = 0.f;
#pragma unroll
                for (int bj = 0; bj < 2; ++bj) { f32x4 r0, r1;
                    if (RF32) { r0 = *(const f32x4*)((const float*)resid + off + bj * HALF); r1 = *(const f32x4*)((const float*)resid + off + bj * HALF + 4); }
                    else { const u32x4 w = *(const u32x4*)((const bf16*)resid + off + bj * HALF); r0 = (f32x4){bflo(w.x), bfhi(w.x), bflo(w.y), bfhi(w.y)}; r1 = (f32x4){bflo(w.z), bfhi(w.z), bflo(w.w), bfhi(w.w)}; }
                    const f32x4 v0 = r0 + g[bj][0] * acc[ai][bj][m][0], v1 = r1 + g[bj][1] * acc[ai][bj][m][1];
                    u32x4 o; o.x = pk2(v0[0], v0[1]); o.y = pk2(v0[2], v0[3]); o.z = pk2(v1[0], v1[1]); o.w = pk2(v1[2], v1[3]);
                    *(u32x4*)(out + off + bj * HALF) = o;
#pragma unroll
                    for (int e = 0; e < 4; ++e) { const float a = bflo(o[e]), b2 = bfhi(o[e]); sq += a * a + b2 * b2; } }
                sq += __shfl_xor(sq, 16); sq += __shfl_xor(sq, 32);
                if (fq == 0) ssp[(size_t)(row0 + ai * HALF + m * 16) * 16 + u.pn * 4 + wc] = sq;
                if (m & 1) asm volatile("" ::: "memory"); }
    }
};

template <class Epi, class Sched, bool ALIGN_EPI, bool FP8 = false>
DI void gemm_phase(const int tid, LAS unsigned char* lds, const char* gA, const int lda  , const int nt, const Sched& S, const Epi& E) {
    const int wid = __builtin_amdgcn_readfirstlane(tid >> 6), lane = tid & 63, wr = wid >> 2, wc = wid & 3, fr = lane & 15, fq = lane >> 4;
    int Rr[2], Cc[2]; unsigned voffB[2];
#pragma unroll
    for (int i = 0; i < 2; ++i) { stage_rc(tid * 16 + i * 8192, Rr[i], Cc[i]); const int Rb = Epi::PERM ? ((Rr[i] & ~31) + perm32(Rr[i] & 31)) : Rr[i];
        voffB[i] = (unsigned)(Rb * S.ldb + Cc[i] * 2); }
    const size_t kstep = (size_t)(BK * 2);
    const size_t hstepB = (size_t)HALF * S.ldb;
    const unsigned ldsw = (unsigned)wid * 1024u;
    const int aoff = lds_byte(wr * 64 + fr, fq * 8), boff = lds_byte(wc * 32 + fr, fq * 8);
#define PG8_SA(b, h) (((b) * 2 + (h)) * HTB)
#define PG8_SB(b, h) ((4 + (b) * 2 + (h)) * HTB)
#define PG8_STAGEB(bufoff, gbase) do { _Pragma("unroll") for (int _i = 0; _i < 2; ++_i) \
        __builtin_amdgcn_global_load_lds((const unsigned*)((const char*)(gbase) + voffB[_i]), (LAS unsigned*)(lds + (bufoff) + ldsw + _i * 8192), 16, 0, 0); } while (0)
#define PG8_STAGEA(bufoff, gbase, o0, o1) do { \
        __builtin_amdgcn_global_load_lds((const unsigned*)((const char*)(gbase) + (o0)), (LAS unsigned*)(lds + (bufoff) + ldsw), 16, 0, 0); \
        __builtin_amdgcn_global_load_lds((const unsigned*)((const char*)(gbase) + (o1)), (LAS unsigned*)(lds + (bufoff) + ldsw + 8192), 16, 0, 0); } while (0)
#define PG8_LD8(off) __builtin_shufflevector(*(const LAS i32x4*)(lds + (off)), *(const LAS i32x4*)(lds + (off) + 1024), 0, 1, 2, 3, 4, 5, 6, 7)
#define PG8_LDA(dst, b, h) do { if constexpr (FP8) { _Pragma("unroll") for (int m = 0; m < 4; ++m) dst##8[m] = PG8_LD8(PG8_SA(b, h) + aoff + m * 2048); } \
        else { _Pragma("unroll") for (int m = 0; m < 4; ++m) _Pragma("unroll") for (int k = 0; k < 2; ++k) dst[m][k] = *(const LAS bf16x8*)(lds + PG8_SA(b, h) + aoff + m * 2048 + k * 1024); } } while (0)
#define PG8_LDB(dst, b, h) do { if constexpr (FP8) { _Pragma("unroll") for (int n = 0; n < 2; ++n) dst##8[n] = PG8_LD8(PG8_SB(b, h) + boff + n * 2048); } \
        else { _Pragma("unroll") for (int n = 0; n < 2; ++n) _Pragma("unroll") for (int k = 0; k < 2; ++k) dst[n][k] = *(const LAS bf16x8*)(lds + PG8_SB(b, h) + boff + n * 2048 + k * 1024); } } while (0)
#define PG8_MMA(ai, bj, At, Bt) do { __builtin_amdgcn_s_setprio(1); \
        if constexpr (FP8) { _Pragma("unroll") for (int m = 0; m < 4; ++m) _Pragma("unroll") for (int n = 0; n < 2; ++n) \
            acc[ai][bj][m][n] = __builtin_amdgcn_mfma_scale_f32_16x16x128_f8f6f4(Bt##8[n], At##8[m], acc[ai][bj][m][n], 0, 0, 0, 0x7f7f7f7f, 0, 0x7f7f7f7f); } \
        else { _Pragma("unroll") for (int m = 0; m < 4; ++m) _Pragma("unroll") for (int n = 0; n < 2; ++n) _Pragma("unroll") for (int k = 0; k < 2; ++k) \
            acc[ai][bj][m][n] = __builtin_amdgcn_mfma_f32_16x16x32_bf16(Bt[n][k], At[m][k], acc[ai][bj][m][n], 0, 0, 0); } \
        __builtin_amdgcn_s_setprio(0); } while (0)
#define PG8_WAIT_V(n) asm volatile("s_waitcnt vmcnt(" #n ")" ::: "memory")
#define PG8_WAIT_L(n) asm volatile("s_waitcnt lgkmcnt(" #n ")" ::: "memory")
#define PG8_BAR __builtin_amdgcn_s_barrier()
#define PG8_SCHED __builtin_amdgcn_sched_barrier(0)
    Unit cur, nxt; int ui = 0;
    if (!S.next(0, cur)) return;
    f32x4 acc[2][2][4][2];
#pragma unroll
    for (int a = 0; a < 2; ++a)
#pragma unroll
        for (int b = 0; b < 2; ++b)
#pragma unroll
            for (int m = 0; m < 4; ++m)
#pragma unroll
                for (int n = 0; n < 2; ++n) acc[a][b][m][n] = (f32x4){0.f, 0.f, 0.f, 0.f};
    bf16x8 At[4][2], B0[2][2], B1[2][2]; i32x8 At8[4], B08[2], B18[2];
    unsigned vA[2][2], vN[2][2];
#pragma unroll
    for (int h = 0; h < 2; ++h)
#pragma unroll
        for (int i = 0; i < 2; ++i) vA[h][i] = S.a_row(cur, h * HALF + Rr[i]) * (unsigned)lda + (unsigned)Cc[i] * 2u;
    const char* cB = S.b_base(cur);
    PG8_STAGEB(PG8_SB(0, 0), cB); PG8_STAGEB(PG8_SB(0, 1), cB + hstepB); PG8_STAGEA(PG8_SA(0, 0), gA, vA[0][0], vA[0][1]); PG8_STAGEA(PG8_SA(0, 1), gA, vA[1][0], vA[1][1]);
    if (wr == 1) PG8_BAR;
    PG8_WAIT_V(2); PG8_BAR;
    PG8_STAGEB(PG8_SB(1, 0), cB + kstep); PG8_STAGEA(PG8_SA(1, 0), gA + kstep, vA[0][0], vA[0][1]); PG8_STAGEB(PG8_SB(1, 1), cB + hstepB + kstep);
    PG8_WAIT_V(6); PG8_BAR;
    for (;;) {
        const bool has_next = S.next(ui + 1, nxt);
        const char* nB = has_next ? S.b_base(nxt) : cB;
#pragma unroll
        for (int h = 0; h < 2; ++h)
#pragma unroll
            for (int i = 0; i < 2; ++i) vN[h][i] = has_next ? S.a_row(nxt, h * HALF + Rr[i]) * (unsigned)lda + (unsigned)Cc[i] * 2u : vA[h][i];
#pragma unroll 1
        for (int t = 0; t < nt; t += 2) {
            const bool last = (t == nt - 2);
            const char* a1 = gA + (size_t)(t + 1) * kstep;
            const char* a2 = gA + (last ? (size_t)0 : (size_t)(t + 2) * kstep); const char* b2 = last ? nB : cB + (size_t)(t + 2) * kstep;
            const char* a3 = a2 + kstep; const char* b3 = b2 + kstep;
            PG8_LDB(B0, 0, 0); PG8_LDB(B1, 0, 1); PG8_SCHED; PG8_LDA(At, 0, 0); PG8_STAGEA(PG8_SA(1, 1), a1, vA[1][0], vA[1][1]);
            if (last) {
#pragma unroll
                for (int h = 0; h < 2; ++h)
#pragma unroll
                    for (int i = 0; i < 2; ++i) vA[h][i] = vN[h][i]; }
            PG8_WAIT_V(8); PG8_WAIT_L(0); PG8_BAR; PG8_MMA(0, 0, At, B0); PG8_MMA(0, 1, At, B1); PG8_BAR; PG8_SCHED;
            PG8_LDA(At, 0, 1); PG8_STAGEB(PG8_SB(0, 0), b2); PG8_STAGEB(PG8_SB(0, 1), b2 + hstepB); PG8_STAGEA(PG8_SA(0, 0), a2, vA[0][0], vA[0][1]);
            PG8_WAIT_V(8); PG8_WAIT_L(0); PG8_BAR; PG8_MMA(1, 0, At, B0); PG8_MMA(1, 1, At, B1); PG8_BAR; PG8_SCHED;
            PG8_LDB(B0, 1, 0); PG8_LDB(B1, 1, 1); PG8_SCHED; PG8_LDA(At, 1, 0); PG8_STAGEA(PG8_SA(0, 1), a2, vA[1][0], vA[1][1]);
            PG8_WAIT_V(8); PG8_WAIT_L(0); PG8_BAR; PG8_MMA(0, 0, At, B0); PG8_MMA(0, 1, At, B1); PG8_BAR; PG8_SCHED;
            PG8_LDA(At, 1, 1); PG8_STAGEB(PG8_SB(1, 0), b3); PG8_STAGEB(PG8_SB(1, 1), b3 + hstepB); PG8_STAGEA(PG8_SA(1, 0), a3, vA[0][0], vA[0][1]);
            PG8_WAIT_V(8); PG8_WAIT_L(0); PG8_BAR; PG8_MMA(1, 0, At, B0); PG8_MMA(1, 1, At, B1); PG8_BAR; PG8_SCHED;
        }
        if constexpr (ALIGN_EPI) { if (wr == 0) PG8_BAR; }
        E(acc, cur, wr, wc, fr, fq);
        if (!has_next) break;
#pragma unroll
        for (int a = 0; a < 2; ++a)
#pragma unroll
            for (int b = 0; b < 2; ++b)
#pragma unroll
                for (int m = 0; m < 4; ++m)
#pragma unroll
                    for (int n = 0; n < 2; ++n) acc[a][b][m][n] = (f32x4){0.f, 0.f, 0.f, 0.f};
        cur = nxt; cB = nB; ++ui;
        if constexpr (ALIGN_EPI) { if (wr == 1) PG8_BAR; }
    }
    PG8_WAIT_V(0);
    if constexpr (!ALIGN_EPI) { if (wr == 0) PG8_BAR; }
    PG8_BAR;
#undef PG8_SA
#undef PG8_SB
#undef PG8_STAGEA
#undef PG8_STAGEB
#undef PG8_LDA
#undef PG8_LDB
#undef PG8_MMA
#undef PG8_LD8
#undef PG8_WAIT_V
#undef PG8_WAIT_L
#undef PG8_BAR
#undef PG8_SCHED
}
}

struct Params {
    const float* in[26];
    float* out; unsigned char* ws;
    int ph_lo, ph_hi;
};
enum { I_X = 0, I_C, I_ADAW, I_ADAB, I_NORMG, I_FINALG, I_SBWIN, I_SBWOUT, I_GLAWIN, I_GLAGU, I_GLABG, I_GLANG, I_GLAWOUT, I_CONVWIN, I_CONVW, I_CONVB, I_CONVWOUT,
       I_DILWIN, I_DILWOUT, I_MGRPW, I_MGRPB, I_MEXPW, I_MEXPB, I_MWG, I_MWU, I_MWD };
struct ParamsG { const GAS float* in[26]; GAS float* out; GAS unsigned char* ws; int ph_lo, ph_hi; };
static_assert(sizeof(ParamsG) == sizeof(Params), "ParamsG mirrors Params");
typedef __attribute__((address_space(4))) ParamsG KParams;
#define PIN(i) ((const float*)P.in[(i)])
struct Ctx {
    LAS unsigned char* lds; volatile LAS unsigned* MISC;
    int tid, lane, wave, G, bid;
    const KParams* p; unsigned char* ws;
};

DI void transpose_item(const float* W, int ldw  , int k0, int n0, bf16* WT, size_t drow0, int ldk  , LAS float* scr, int lane) {
    float tv[32];
#pragma unroll
    for (int i = 0; i < 32; ++i) tv[i] = __builtin_nontemporal_load(W + (size_t)(k0 + 2 * i + (lane >> 5)) * ldw + n0 + (lane & 31));
#pragma unroll
    for (int i = 0; i < 32; ++i) scr[(2 * i + (lane >> 5)) * 33 + (lane & 31)] = tv[i];
    LDS_WAIT();
    const int c = lane & 7;
#pragma unroll
    for (int j = 0; j < 4; ++j) { const int n = (lane >> 3) + 8 * j; const LAS float* s = scr + (8 * c) * 33 + n;
        u32x4 o; o.x = pk2(s[0 * 33], s[1 * 33]); o.y = pk2(s[2 * 33], s[3 * 33]); o.z = pk2(s[4 * 33], s[5 * 33]); o.w = pk2(s[6 * 33], s[7 * 33]);
        *(u32x4*)(WT + (drow0 + n) * (size_t)ldk + k0 + 8 * c) = o; }
    LDS_WAIT();
}
DI void transpose_matrix_fp8(Ctx& F, const float* W, int K, int N, int ldw, unsigned char* WT, float scale, int gw, int NGW);
DI void transpose_matrix(Ctx& F, const float* W, int K, int N, int ldw, int ncol0, bf16* WT, int gw, int NGW) {
    LAS float* scr = (LAS float*)(F.lds + F.wave * 16384);
    const int nblk = N / 32, nitems = (K / 64) * nblk;
    for (int it = gw; it < nitems; it += NGW) { const int kb = it / nblk, nb = it % nblk;
        transpose_item(W, ldw, 64 * kb, ncol0 + 32 * nb, WT, (size_t)(32 * nb), K, scr, F.lane); }
}

DI void ph_prologue(Ctx& F) {
    const KParams& P = *F.p; unsigned char* ws = F.ws;
    const int gw = F.bid * NWAVES + F.wave, NGW = F.G * NWAVES;
    if (in_fp8(0)) transpose_matrix_fp8(F, PIN(I_SBWIN), D, 3072, 3072, ws + W_SBIN, pg8::MOE_S_W1, gw, NGW); else transpose_matrix(F, PIN(I_SBWIN), D, 3072, 3072, 0, (bf16*)(ws + W_SBIN), gw, NGW);
    if (out_fp8(0)) transpose_matrix_fp8(F, PIN(I_SBWOUT), D, D, D, ws + W_SBOUT, pg8::MOE_S_W1, gw, NGW); else transpose_matrix(F, PIN(I_SBWOUT), D, D, D, 0, (bf16*)(ws + W_SBOUT), gw, NGW);
    if (in_fp8(1)) transpose_matrix_fp8(F, PIN(I_GLAWIN), D, 3072, 3088, ws + W_GLAIN, pg8::MOE_S_W1, gw, NGW); else transpose_matrix(F, PIN(I_GLAWIN), D, 3072, 3088, 0, (bf16*)(ws + W_GLAIN), gw, NGW);
    if (out_fp8(1)) transpose_matrix_fp8(F, PIN(I_GLAWOUT), D, D, D, ws + W_GLAOUT, pg8::MOE_S_W1, gw, NGW); else transpose_matrix(F, PIN(I_GLAWOUT), D, D, D, 0, (bf16*)(ws + W_GLAOUT), gw, NGW);
    if (in_fp8(2)) transpose_matrix_fp8(F, PIN(I_CONVWIN), D, 3072, 3072, ws + W_CONVIN, pg8::MOE_S_W1, gw, NGW); else transpose_matrix(F, PIN(I_CONVWIN), D, 3072, 3072, 0, (bf16*)(ws + W_CONVIN), gw, NGW);
    if (out_fp8(2)) transpose_matrix_fp8(F, PIN(I_CONVWOUT), D, D, D, ws + W_CONVOUT, pg8::MOE_S_W1, gw, NGW); else transpose_matrix(F, PIN(I_CONVWOUT), D, D, D, 0, (bf16*)(ws + W_CONVOUT), gw, NGW);
    if (in_fp8(3)) transpose_matrix_fp8(F, PIN(I_DILWIN), D, 4608, 4608, ws + W_DILIN, pg8::MOE_S_W1, gw, NGW); else transpose_matrix(F, PIN(I_DILWIN), D, 4608, 4608, 0, (bf16*)(ws + W_DILIN), gw, NGW);
    if (out_fp8(3)) transpose_matrix_fp8(F, PIN(I_DILWOUT), 512, D, D, ws + W_DILOUT, pg8::MOE_S_W1, gw, NGW); else transpose_matrix(F, PIN(I_DILWOUT), 512, D, D, 0, (bf16*)(ws + W_DILOUT), gw, NGW);
    const float* c = PIN(I_C); const float* aw = PIN(I_ADAW); float* modp = (float*)(ws + WS_MODP);
    LAS float* scond = (LAS float*)(F.lds + 126976);
    for (int i = F.tid; i < NB * D; i += NTHR) { const float cv = c[i]; scond[i] = cv / (1.f + __expf(-cv)); }
    __syncthreads();
    for (int it = gw; it < DEPTH * 96 * KSPLIT; it += NGW) {
        const int ks = it % KSPLIT, jb = (it / KSPLIT) % 96, l = it / (KSPLIT * 96);
        const int j = jb * 64 + F.lane; const int k0 = ks * (D / KSPLIT);
        float a[NB];
#pragma unroll
        for (int b = 0; b < NB; ++b) a[b] = 0.f;
        const float* wp = aw + ((size_t)l * D + k0) * 6144 + j;
#pragma unroll 16
        for (int k = 0; k < D / KSPLIT; ++k) { const float w = __builtin_nontemporal_load(wp + (size_t)k * 6144);
#pragma unroll
            for (int b = 0; b < NB; ++b) a[b] += scond[b * D + k0 + k] * w; }
#pragma unroll
        for (int b = 0; b < NB; ++b) modp[(((size_t)ks * DEPTH + l) * NB + b) * 6144 + j] = a[b];
    }
}
DI float mod_sum(const float* modp, const float* adab, int l, int b, int j) {
    float s = adab[l * 6144 + j];
#pragma unroll
    for (int ks = 0; ks < KSPLIT; ++ks) s += modp[(((size_t)ks * DEPTH + l) * NB + b) * 6144 + j];
    return s;
}

DI void mod_vec(const float* modp, const float* adab, int l, int b, int chunk, int lane, f32x4 (&out)[4]) {
#pragma unroll
    for (int j = 0; j < 4; ++j) out[j] = *(const f32x4*)(adab + l * 6144 + chunk * D + 4 * lane + 256 * j);
#pragma unroll 1
    for (int ks = 0; ks < KSPLIT; ++ks) { const float* p = modp + (((size_t)ks * DEPTH + l) * NB + b) * 6144 + chunk * D + 4 * lane;
#pragma unroll
        for (int j = 0; j < 4; ++j) out[j] = out[j] + *(const f32x4*)(p + 256 * j); }
}
DI void mod_vec_f(const float* modf, int l, int b, int chunk, int lane, f32x4 (&out)[4]) {
    const float* p = modf + ((size_t)l * NB + b) * 6144 + chunk * D + 4 * lane;
#pragma unroll
    for (int j = 0; j < 4; ++j) out[j] = *(const f32x4*)(p + 256 * j);
}
DI void row_load(const float* row, int lane, f32x4 (&v)[4]) {
#pragma unroll
    for (int j = 0; j < 4; ++j) v[j] = *(const f32x4*)(row + 4 * lane + 256 * j);
}
DI void row_load_bf16(const bf16* row, int lane, f32x4 (&v)[4]) {
#pragma unroll
    for (int j = 0; j < 4; ++j) { const u32x2 w = *(const u32x2*)(row + 4 * lane + 256 * j); v[j] = (f32x4){bflo(w.x), bfhi(w.x), bflo(w.y), bfhi(w.y)}; }
}
DI void row_store_bf16(bf16* row, int lane, const f32x4 (&v)[4]) {
#pragma unroll
    for (int j = 0; j < 4; ++j) { u32x2 w; w.x = pk2(v[j][0], v[j][1]); w.y = pk2(v[j][2], v[j][3]); *(u32x2*)(row + 4 * lane + 256 * j) = w; }
}
DI float row_rstd(const f32x4 (&v)[4]) {
    float s = 0.f;
#pragma unroll
    for (int j = 0; j < 4; ++j) s += (v[j][0] * v[j][0] + v[j][1] * v[j][1]) + (v[j][2] * v[j][2] + v[j][3] * v[j][3]);
    return 1.f / sqrtf(wave_sum(s) * (1.f / D) + RMS_EPS);
}
DI void moe_combine_row(Ctx& F, int row, const f32x4 (&g2)[4], f32x4 (&v)[4]) {
    unsigned char* ws = F.ws;
    const int* ts = (const int*)(ws + WS_TOKS); const float* tw = (const float*)(ws + WS_TOKW); const bf16* yb = (const bf16*)(ws + WS_YB);
    const int s0 = __hip_atomic_load(ts + row * 2, __ATOMIC_RELAXED, __HIP_MEMORY_SCOPE_AGENT), s1 = __hip_atomic_load(ts + row * 2 + 1, __ATOMIC_RELAXED, __HIP_MEMORY_SCOPE_AGENT);
    const float w0 = __hip_atomic_load(tw + row * 2, __ATOMIC_RELAXED, __HIP_MEMORY_SCOPE_AGENT), w1 = __hip_atomic_load(tw + row * 2 + 1, __ATOMIC_RELAXED, __HIP_MEMORY_SCOPE_AGENT);
#pragma unroll
    for (int j = 0; j < 4; ++j) { const u32x2 a = *(const u32x2*)(yb + (size_t)s0 * D + 4 * F.lane + 256 * j), b = *(const u32x2*)(yb + (size_t)s1 * D + 4 * F.lane + 256 * j);
        f32x4 y; y[0] = w0 * bflo(a.x) + w1 * bflo(b.x); y[1] = w0 * bfhi(a.x) + w1 * bfhi(b.x); y[2] = w0 * bflo(a.y) + w1 * bflo(b.y); y[3] = w0 * bfhi(a.y) + w1 * bfhi(b.y);
        v[j] = v[j] + g2[j] * y; }
}
struct RowIn { f32x4 x[4]; unsigned ya[4], yb[4]; };
template <bool COMB, bool XF32> DI void rowin_load(RowIn& R, const void* xrow, const unsigned char* ybase, int s0, int s1, int lane) {
#pragma unroll
    for (int j = 0; j < 4; ++j) { if (XF32) R.x[j] = *(const f32x4*)((const float*)xrow + 4 * lane + 256 * j);
        else { const u32x2 w = *(const u32x2*)((const bf16*)xrow + 4 * lane + 256 * j); R.x[j] = (f32x4){bflo(w.x), bfhi(w.x), bflo(w.y), bfhi(w.y)}; } }
    if (COMB) {
#pragma unroll
        for (int j = 0; j < 4; ++j) { R.ya[j] = *(const unsigned*)(ybase + (size_t)s0 * D + 4 * lane + 256 * j); R.yb[j] = *(const unsigned*)(ybase + (size_t)s1 * D + 4 * lane + 256 * j); }
    }
}
DI void rowin_combine(const RowIn& R, float w0, float w1, const f32x4 (&g2)[4], f32x4 (&v)[4]) {
#pragma unroll
    for (int j = 0; j < 4; ++j) { const int a = (int)R.ya[j], b = (int)R.yb[j];
        const f32x2 a01 = __builtin_amdgcn_cvt_pk_f32_fp8(a, false), a23 = __builtin_amdgcn_cvt_pk_f32_fp8(a, true), b01 = __builtin_amdgcn_cvt_pk_f32_fp8(b, false), b23 = __builtin_amdgcn_cvt_pk_f32_fp8(b, true);
        f32x4 y; y[0] = w0 * a01[0] + w1 * b01[0]; y[1] = w0 * a01[1] + w1 * b01[1]; y[2] = w0 * a23[0] + w1 * b23[0]; y[3] = w0 * a23[1] + w1 * b23[1];
        v[j] = R.x[j] + g2[j] * y; }
}
DI int rdlane_i(int v, int l) { return __builtin_amdgcn_readlane(v, l); }
DI void transpose_item_fp8(const float* W, int ldw, int k0, int n0, unsigned char* WT, size_t drow0, int ldk  , float scale, LAS float* scr, int lane) {
    float tv[32];
#pragma unroll
    for (int i = 0; i < 32; ++i) tv[i] = __builtin_nontemporal_load(W + (size_t)(k0 + 2 * i + (lane >> 5)) * ldw + n0 + (lane & 31));
#pragma unroll
    for (int i = 0; i < 32; ++i) scr[(2 * i + (lane >> 5)) * 33 + (lane & 31)] = tv[i] * scale;
    LDS_WAIT();
    const int n = lane >> 1, half = lane & 1; const LAS float* sp = scr + (32 * half) * 33 + n;
    u32x4 o0, o1;
#pragma unroll
    for (int q = 0; q < 4; ++q) { o0[q] = pk4_fp8(sp[(4 * q) * 33], sp[(4 * q + 1) * 33], sp[(4 * q + 2) * 33], sp[(4 * q + 3) * 33]);
        o1[q] = pk4_fp8(sp[(16 + 4 * q) * 33], sp[(16 + 4 * q + 1) * 33], sp[(16 + 4 * q + 2) * 33], sp[(16 + 4 * q + 3) * 33]); }
    unsigned char* dst = WT + (drow0 + n) * (size_t)ldk + k0 + 32 * half;
    *(u32x4*)dst = o0; *(u32x4*)(dst + 16) = o1;
    LDS_WAIT();
}
DI void transpose_matrix_fp8(Ctx& F, const float* W, int K, int N, int ldw, unsigned char* WT, float scale, int gw, int NGW) {
    LAS float* scr = (LAS float*)(F.lds + F.wave * 16384);
    const int nblk = N / 32, nitems = (K / 64) * nblk;
    for (int it = gw; it < nitems; it += NGW) { const int kb = it / nblk, nb = it % nblk;
        transpose_item_fp8(W, ldw, 64 * kb, 32 * nb, WT, (size_t)(32 * nb), K, scale, scr, F.lane); }
}
DI void moe_weight_convert(Ctx& F, int l, int gw, int NGW) {
    const KParams& P = *F.p; unsigned char* ws = F.ws;
    LAS float* scr = (LAS float*)(F.lds + F.wave * 16384);
    unsigned char* W1T = ws + WS_W1T; unsigned char* W2T = ws + WS_W2T;
    const int per_e = 256, n1 = MOE_E * 2 * per_e;
    for (int it = gw; it < n1; it += NGW) { const int e = it / (2 * per_e), r = it % (2 * per_e), half = r / per_e, q = r % per_e, kb = q / 16, nb = q % 16;
        const float* W = (half ? PIN(I_MWU) : PIN(I_MWG)) + ((size_t)l * MOE_E + e) * D * MOE_FF;
        const int n0 = 32 * nb; const size_t drow0 = (size_t)e * 1024 + (size_t)(n0 / 128) * 256 + half * 128 + (n0 % 128);
        transpose_item_fp8(W, MOE_FF, 64 * kb, n0, W1T, drow0, D, pg8::MOE_S_W1, scr, F.lane); }
    for (int it = gw; it < MOE_E * per_e; it += NGW) { const int e = it / per_e, q = it % per_e, kb = q / 32, nb = q % 32;
        const float* W = PIN(I_MWD) + ((size_t)l * MOE_E + e) * MOE_FF * D;
        transpose_item_fp8(W, D, 64 * kb, 32 * nb, W2T, (size_t)e * 1024 + 32 * nb, MOE_FF, pg8::MOE_S_W2, scr, F.lane); }
}

DI void ph_norm1(Ctx& F, int l) {
    const KParams& P = *F.p; unsigned char* ws = F.ws;
    const int gw = F.bid * NWAVES + F.wave, NGW = F.G * NWAVES;
    const float* modp = (const float*)(ws + WS_MODP); float* modf = (float*)(ws + WS_MODF);
    if (l == 0) {
        for (int i = F.bid * NTHR + F.tid; i < DEPTH * NB * 6144; i += F.G * NTHR) { const int j = i % 6144, b = (i / 6144) % NB, ll = i / (6144 * NB); modf[i] = mod_sum(modp, PIN(I_ADAB), ll, b, j); }
    }
    const bool gla = (l == 1);
    LAS float* wgd = (LAS float*)F.lds;
    if (gla) { const float* w = PIN(I_GLAWIN);
        for (int idx = F.tid; idx < 16 * D; idx += NTHR) { const int c = idx & (D - 1), o = idx >> 10; wgd[idx] = w[(size_t)c * 3088 + 3072 + o]; }
        __syncthreads(); }
    const float* xin0 = PIN(I_X); bf16* XB = (bf16*)(ws + WS_XB);
    unsigned char* HO8 = ws + WS_HO; float* gdn = (float*)(ws + WS_GDOWN);
    const float* ng = PIN(I_NORMG) + (size_t)(l * 2 + 0) * D;
    for (int blk = gw; blk < T / 32; blk += NGW) {
        const int row0 = blk * 32, b = row0 / SEQ;
        f32x4 gm[4], sh[4], g2[4];
        if (l == 0) { mod_vec(modp, PIN(I_ADAB), l, b, 0, F.lane, sh); mod_vec(modp, PIN(I_ADAB), l, b, 1, F.lane, gm); }
        else { mod_vec_f(modf, l, b, 0, F.lane, sh); mod_vec_f(modf, l, b, 1, F.lane, gm); }
#pragma unroll
        for (int j = 0; j < 4; ++j) gm[j] = *(const f32x4*)(ng + 4 * F.lane + 256 * j) * (gm[j] + 1.f);
        if (l > 0) mod_vec_f(modf, l - 1, b, 5, F.lane, g2);
        else {
#pragma unroll
            for (int j = 0; j < 4; ++j) g2[j] = (f32x4){0.f, 0.f, 0.f, 0.f}; }
        const int* ts = (const int*)(ws + WS_TOKS); const float* tw = (const float*)(ws + WS_TOKW); const unsigned char* ybp = ws + WS_YB;
        int sl0 = 0, sl1 = 0; float wl0 = 0.f, wl1 = 0.f;
        if (l > 0) { const int rw = row0 + (F.lane & 31);
            sl0 = __hip_atomic_load(ts + rw * 2, __ATOMIC_RELAXED, __HIP_MEMORY_SCOPE_AGENT); sl1 = __hip_atomic_load(ts + rw * 2 + 1, __ATOMIC_RELAXED, __HIP_MEMORY_SCOPE_AGENT);
            wl0 = __hip_atomic_load(tw + rw * 2, __ATOMIC_RELAXED, __HIP_MEMORY_SCOPE_AGENT); wl1 = __hip_atomic_load(tw + rw * 2 + 1, __ATOMIC_RELAXED, __HIP_MEMORY_SCOPE_AGENT); }
        RowIn Rn, Rn2;
#define N1_LOAD(R, rr_) do { if (l > 0) rowin_load<true, false>(R, XB + (size_t)(row0 + (rr_)) * D, ybp, rdlane_i(sl0, (rr_)), rdlane_i(sl1, (rr_)), F.lane); else rowin_load<false, true>(R, xin0 + (size_t)(row0 + (rr_)) * D, ybp, 0, 0, F.lane); } while (0)
        N1_LOAD(Rn, 0); N1_LOAD(Rn2, 1);
        for (int r = 0; r < 32; ++r) { const int row = row0 + r;
            RowIn Rc = Rn; Rn = Rn2;
            if (r + 2 < 32) N1_LOAD(Rn2, r + 2);
            f32x4 v[4];
            if (l > 0) { rowin_combine(Rc, rdlane(wl0, r) * (1.f / pg8::MOE_S_Y), rdlane(wl1, r) * (1.f / pg8::MOE_S_Y), g2, v); row_store_bf16(XB + (size_t)row * D, F.lane, v); }
            else {
#pragma unroll
                for (int j = 0; j < 4; ++j) v[j] = Rc.x[j]; }
            const float rstd = row_rstd(v);
#pragma unroll
            for (int j = 0; j < 4; ++j) v[j] = v[j] * rstd * gm[j] + sh[j];
            if (in_fp8(l)) { unsigned* hrow = (unsigned*)(HO8 + (size_t)row * D);
#pragma unroll
              for (int j = 0; j < 4; ++j) hrow[F.lane + 64 * j] = pk4_fp8(v[j][0], v[j][1], v[j][2], v[j][3]); }
            else row_store_bf16((bf16*)HO8 + (size_t)row * D, F.lane, v);
            if (gla) {
                float ga[16];
#pragma unroll
                for (int o = 0; o < 16; ++o) { float s = 0.f;
#pragma unroll
                    for (int j = 0; j < 4; ++j) { const f32x4 w = *(const LAS f32x4*)(wgd + o * D + 4 * F.lane + 256 * j); s += (v[j][0] * w[0] + v[j][1] * w[1]) + (v[j][2] * w[2] + v[j][3] * w[3]); }
                    ga[o] = s; if (o & 1) __builtin_amdgcn_sched_barrier(0); }
                const float gk = halving_reduce<16>(ga, F.lane);
                if ((F.lane & 3) == 0) gdn[(size_t)row * 16 + (F.lane >> 2)] = gk;
            }
        }
    }
    __syncthreads();
    moe_weight_convert(F, l, gw, NGW);
}

#define MFMA32(a, b, c) __builtin_amdgcn_mfma_f32_32x32x16_bf16((a), (b), (c), 0, 0, 0)
DI bf16x8 ldg8(const bf16* p) { return *(const bf16x8*)p; }
DI bf16x8 pack8(float a0, float a1, float a2, float a3, float a4, float a5, float a6, float a7) {
    u32x4 p; p.x = pk2(a0, a1); p.y = pk2(a2, a3); p.z = pk2(a4, a5); p.w = pk2(a6, a7); return __builtin_bit_cast(bf16x8, p);
}
DI bf16x8 pack_step(const f32x16& x, int s) { return s == 0 ? pack8(x[0], x[1], x[2], x[3], x[4], x[5], x[6], x[7]) : pack8(x[8], x[9], x[10], x[11], x[12], x[13], x[14], x[15]); }
DI f32x16 zero16() { f32x16 z; for (int i = 0; i < 16; ++i) z[i] = 0.f; return z; }
DI bf16x8 tr_read2(unsigned a_lo, unsigned a_hi) {
    s16x4 lo, hi;
    asm volatile("ds_read_b64_tr_b16 %0, %2\n\tds_read_b64_tr_b16 %1, %3\n\ts_waitcnt lgkmcnt(0)" : "=&v"(lo), "=&v"(hi) : "v"(a_lo), "v"(a_hi) : "memory");
    return __builtin_shufflevector(lo, hi, 0, 1, 2, 3, 4, 5, 6, 7);
}
constexpr int VPITCH = 144;
DI bf16x8 vt_frag(unsigned vbase, int lane, int dblk, int s) {
    const int i16 = lane & 15, q = i16 >> 2, p = i16 & 3, blk = (lane >> 4) & 1, h2 = lane >> 5;
    const unsigned col = (unsigned)((32 * dblk + 16 * blk) * 2 + 8 * p);
    return tr_read2(vbase + (unsigned)((16 * s + 4 * h2 + q) * VPITCH) + col, vbase + (unsigned)((16 * s + 8 + 4 * h2 + q) * VPITCH) + col);
}

DI void vt_frags4(unsigned vbase, int lane, bf16x8& v00, bf16x8& v01, bf16x8& v10, bf16x8& v11) {
    const int i16 = lane & 15, q = i16 >> 2, p = i16 & 3, blk = (lane >> 4) & 1, h2 = lane >> 5;
    const unsigned a0 = vbase + (unsigned)((4 * h2 + q) * VPITCH) + (unsigned)(32 * blk + 8 * p);
    s16x4 r0, r1, r2, r3, r4, r5, r6, r7;
    asm volatile("ds_read_b64_tr_b16 %0, %8\n\tds_read_b64_tr_b16 %1, %8 offset:1152\n\tds_read_b64_tr_b16 %2, %8 offset:2304\n\tds_read_b64_tr_b16 %3, %8 offset:3456\n\t"
                 "ds_read_b64_tr_b16 %4, %8 offset:64\n\tds_read_b64_tr_b16 %5, %8 offset:1216\n\tds_read_b64_tr_b16 %6, %8 offset:2368\n\tds_read_b64_tr_b16 %7, %8 offset:3520\n\ts_waitcnt lgkmcnt(0)"
                 : "=&v"(r0), "=&v"(r1), "=&v"(r2), "=&v"(r3), "=&v"(r4), "=&v"(r5), "=&v"(r6), "=&v"(r7) : "v"(a0) : "memory");
    v00 = __builtin_shufflevector(r0, r1, 0, 1, 2, 3, 4, 5, 6, 7); v01 = __builtin_shufflevector(r2, r3, 0, 1, 2, 3, 4, 5, 6, 7);
    v10 = __builtin_shufflevector(r4, r5, 0, 1, 2, 3, 4, 5, 6, 7); v11 = __builtin_shufflevector(r6, r7, 0, 1, 2, 3, 4, 5, 6, 7);
}
static_assert(VPITCH == 144, "vt_frags4 offsets assume a 144-byte row pitch: 8 rows = 1152 B");

constexpr int SB_NT = 16, SB_TILE = 32 * VPITCH, SB_VOFF = SB_NT * SB_TILE;
DI void ph_sb_attn(Ctx& F) {
    unsigned char* ws = F.ws; bf16* proj = (bf16*)(ws + WS_BIG);
    const int lane = F.lane, r = lane & 31, h2 = lane >> 5, tid = F.tid;
    const int vcu = (F.G % 8 == 0) ? (F.bid % 8) * (F.G / 8) + F.bid / 8 : F.bid;
    const int prow = (tid >> 3) & 31, pch = tid & 7, ptile0 = tid >> 8;
    u32x4 kst[8], vst[8];
#define SB_LOAD(b_, hd_, wb_) do { const bf16* base_ = proj + ((size_t)(b_) * SEQ + prow) * 3072 + (hd_) * 64 + pch * 8; \
        _Pragma("unroll") for (int j = 0; j < 8; ++j) { const int kt_ = (wb_) + ptile0 + 2 * j; if (kt_ >= 0) { const bf16* p_ = base_ + (size_t)(kt_ * 32) * 3072; kst[j] = *(const u32x4*)(p_ + 1024); vst[j] = *(const u32x4*)(p_ + 2048); } } } while (0)
#define SB_STORE(wb_) do { _Pragma("unroll") for (int j = 0; j < 8; ++j) { const int sl_ = ptile0 + 2 * j; if ((wb_) + sl_ >= 0) { *(LAS u32x4*)(F.lds + sl_ * SB_TILE + prow * VPITCH + pch * 16) = kst[j]; \
            *(LAS u32x4*)(F.lds + SB_VOFF + sl_ * SB_TILE + prow * VPITCH + pch * 16) = vst[j]; } } } while (0)
#define SB_BAR() do { asm volatile("s_waitcnt lgkmcnt(0)" ::: "memory"); __builtin_amdgcn_s_barrier(); asm volatile("" ::: "memory"); } while (0)
    bool have = false;
    for (int it = vcu; it < NB * 32 * 16; it += F.G) {
        const int hd = it & 15, qb = (it >> 4) & 31, b = it >> 9;
        const int t0 = qb * 8; int wb = t0 + 7 - (SB_NT - 1);
        if (!have) SB_LOAD(b, hd, wb);
        SB_BAR();
        SB_STORE(wb);
        { const int itn = it + F.G; have = itn < NB * 32 * 16; if (have) { const int hdn = itn & 15, qbn = (itn >> 4) & 31, bn = itn >> 9; SB_LOAD(bn, hdn, qbn * 8 + 7 - (SB_NT - 1)); } }
        SB_BAR();
        const int q0 = (t0 + F.wave) * 32; const size_t rowbase = (size_t)b * SEQ;
        const bf16* qp = proj + (rowbase + q0 + r) * 3072 + hd * 64;
        bf16x8 Qf[4];
#pragma unroll
        for (int kk = 0; kk < 4; ++kk) Qf[kk] = ldg8(qp + 16 * kk + 8 * h2);
        f32x16 o0 = zero16(), o1 = zero16(); float carry = 0.f;
        const int qpos = q0 + r;
        int kt = q0 >> 5; bool done = false;
        for (;;) {
            const int klo = wb > 0 ? wb : 0;
            for (; !done && kt >= klo; --kt) {
                const int sl = kt - wb;
                const LAS unsigned char* kl = F.lds + sl * SB_TILE; const unsigned vbase = (unsigned)(size_t)(F.lds + SB_VOFF + sl * SB_TILE);
                bf16x8 Kf[4];
#pragma unroll
                for (int kk = 0; kk < 4; ++kk) Kf[kk] = *(const LAS bf16x8*)(kl + r * VPITCH + (16 * kk + 8 * h2) * 2);
                f32x16 st = zero16();
#pragma unroll
                for (int kk = 0; kk < 4; ++kk) st = MFMA32(Kf[kk], Qf[kk], st);
                const bool diag = (kt == (q0 >> 5));
                float Lv[16]; float sg[4], pg[4];
                const int kbase = kt * 32 + 4 * h2;
#pragma unroll
                for (int i = 0; i < 16; ++i) { const int kpos = kbase + (i & 3) + 8 * (i >> 2); const float z = st[i];
                    const float sp = fmaxf(z, 0.f) + flog2(1.f + fexp2(-fabsf(z)));
                    Lv[i] = (!diag || kpos < qpos) ? -sp : 0.f; }
#pragma unroll
                for (int g = 0; g < 4; ++g) { sg[g] = (Lv[4 * g] + Lv[4 * g + 1]) + (Lv[4 * g + 2] + Lv[4 * g + 3]); pg[g] = __shfl_xor(sg[g], 32); }
                float after = carry; float a[16];
#pragma unroll
                for (int g = 3; g >= 0; --g) {
                    float run = after + (h2 == 0 ? pg[g] : 0.f);
#pragma unroll
                    for (int k = 3; k >= 0; --k) { const int i = 4 * g + k; run += Lv[i]; const int kpos = kbase + k + 8 * g;
                        a[i] = (!diag || kpos < qpos) ? fexp2(st[i] + run) : 0.f; }
                    after += sg[g] + pg[g];
                }
                carry = after;
                const bf16x8 P0 = pack8(a[0], a[1], a[2], a[3], a[4], a[5], a[6], a[7]), P1 = pack8(a[8], a[9], a[10], a[11], a[12], a[13], a[14], a[15]);
                bf16x8 v00, v01, v10, v11; vt_frags4(vbase, lane, v00, v01, v10, v11);
                o0 = MFMA32(v00, P0, o0); o0 = MFMA32(v01, P1, o0); o1 = MFMA32(v10, P0, o1); o1 = MFMA32(v11, P1, o1);
                if (__all(carry < -126.f)) done = true;
            }
            const bool need = !done && kt >= 0;
            SB_BAR(); if (tid == 0) F.MISC[65] = 0u; SB_BAR(); if (need && lane == 0) F.MISC[65] = 1u; SB_BAR();
            if (F.MISC[65] == 0u) break;
            wb -= SB_NT;
            SB_LOAD(b, hd, wb); have = false;
            SB_BAR(); SB_STORE(wb); SB_BAR();
        }
        if (out_fp8(0)) { unsigned char* op8 = ws + WS_HO + (rowbase + q0 + r) * D + hd * 64 + 4 * h2;
#pragma unroll
            for (int g = 0; g < 4; ++g) { *(unsigned*)(op8 + 8 * g) = pk4_fp8(o0[4 * g], o0[4 * g + 1], o0[4 * g + 2], o0[4 * g + 3]); *(unsigned*)(op8 + 32 + 8 * g) = pk4_fp8(o1[4 * g], o1[4 * g + 1], o1[4 * g + 2], o1[4 * g + 3]); } }
        else {
        bf16* op = proj + (rowbase + q0 + r) * 3072 + hd * 64 + 4 * h2;
#pragma unroll
        for (int g = 0; g < 4; ++g) { u32x2 w; w.x = pk2(o0[4 * g], o0[4 * g + 1]); w.y = pk2(o0[4 * g + 2], o0[4 * g + 3]); *(u32x2*)(op + 8 * g) = w;
            u32x2 w1; w1.x = pk2(o1[4 * g], o1[4 * g + 1]); w1.y = pk2(o1[4 * g + 2], o1[4 * g + 3]); *(u32x2*)(op + 32 + 8 * g) = w1; } }
    }
#undef SB_LOAD
#undef SB_STORE
#undef SB_BAR
}

constexpr int DIL_NT = 12, DIL_TILE = 32 * VPITCH, DIL_VOFF = DIL_NT * DIL_TILE;
DI void ph_dil_attn(Ctx& F) {
    unsigned char* ws = F.ws; bf16* proj = (bf16*)(ws + WS_BIG); float* lse = (float*)(ws + WS_LSE);
    const int lane = F.lane, r = lane & 31, h2 = lane >> 5, tid = F.tid;
    const int vcu = (F.G % 8 == 0) ? (F.bid % 8) * (F.G / 8) + F.bid / 8 : F.bid;
    const int prow = (tid >> 3) & 31, pch = tid & 7, ptile0 = tid >> 8;
    u32x4 kst[6], vst[6];
#define DIL_DECODE(it_, g_, b_, hd_, rho_, mt0_, rr_) const int hd_ = (it_) & 7, tg_ = ((it_) >> 3) & 31, b_ = ((it_) >> 8) & 7, g_ = (it_) >> 11; const int rr_ = 1 << (2 * g_), tpc_ = 256 >> (2 * g_); \
        const int rho_ = (tg_ * 8) / tpc_, mt0_ = (tg_ * 8) % tpc_
#define DIL_LOAD(g_, b_, hd_, rho_, mt0_, rr_) do { const bf16* base_ = proj + ((size_t)(b_) * SEQ + (rho_)) * 4608 + (g_) * 1536 + (hd_) * 64 + pch * 8; \
        _Pragma("unroll") for (int j = 0; j < 6; ++j) { const int kt_ = (mt0_) - 4 + ptile0 + 2 * j; if (kt_ >= 0) { const bf16* p_ = base_ + (size_t)((kt_ * 32 + prow) * (rr_)) * 4608; kst[j] = *(const u32x4*)(p_ + 512); vst[j] = *(const u32x4*)(p_ + 1024); } } } while (0)
    int it = vcu;
    if (it < 3 * NB * 256) { DIL_DECODE(it, g, b, hd, rho, mt0, rr); DIL_LOAD(g, b, hd, rho, mt0, rr); }
    for (; it < 3 * NB * 256; it += F.G) {
        DIL_DECODE(it, g, b, hd, rho, mt0, rr);
        asm volatile("s_waitcnt lgkmcnt(0)" ::: "memory"); __builtin_amdgcn_s_barrier(); asm volatile("" ::: "memory");
#pragma unroll
        for (int j = 0; j < 6; ++j) { const int tl = ptile0 + 2 * j; if (mt0 - 4 + tl >= 0) { *(LAS u32x4*)(F.lds + tl * DIL_TILE + prow * VPITCH + pch * 16) = kst[j]; *(LAS u32x4*)(F.lds + DIL_VOFF + tl * DIL_TILE + prow * VPITCH + pch * 16) = vst[j]; } }
        { const int itn = it + F.G; if (itn < 3 * NB * 256) { DIL_DECODE(itn, gn, bn, hdn, rhon, mt0n, rrn); DIL_LOAD(gn, bn, hdn, rhon, mt0n, rrn); } }
        asm volatile("s_waitcnt lgkmcnt(0)" ::: "memory"); __builtin_amdgcn_s_barrier(); asm volatile("" ::: "memory");
        const int mt = mt0 + F.wave;
        const size_t rowbase = (size_t)b * SEQ + rho; const int cq = g * 1536 + hd * 64;
        const int m0 = mt * 32;
        const bf16* qp = proj + (rowbase + (size_t)(m0 + r) * rr) * 4608 + cq;
        bf16x8 Qf[4];
#pragma unroll
        for (int kk = 0; kk < 4; ++kk) Qf[kk] = ldg8(qp + 16 * kk + 8 * h2);
        f32x16 o0 = zero16(), o1 = zero16(); float mrun = -__builtin_inff(), lrun = 0.f;
        const int mq = m0 + r;
        for (int kt = (mt >= 4 ? mt - 4 : 0); kt <= mt; ++kt) {
            const int tl = kt - (mt0 - 4);
            const LAS unsigned char* kl = F.lds + tl * DIL_TILE; const unsigned vbase = (unsigned)(size_t)(F.lds + DIL_VOFF + tl * DIL_TILE);
            bf16x8 Kf[4];
#pragma unroll
            for (int kk = 0; kk < 4; ++kk) Kf[kk] = *(const LAS bf16x8*)(kl + r * VPITCH + (16 * kk + 8 * h2) * 2);
            f32x16 st = zero16();
#pragma unroll
            for (int kk = 0; kk < 4; ++kk) st = MFMA32(Kf[kk], Qf[kk], st);
            const int kbase = kt * 32 + 4 * h2;
            float mx = -__builtin_inff();
            if (kt == mt || kt + 4 == mt) {
#pragma unroll
                for (int i = 0; i < 16; ++i) { const int mk = kbase + (i & 3) + 8 * (i >> 2); const bool valid = (mk <= mq) && (mq - mk <= 128);
                    st[i] = valid ? st[i] : -__builtin_inff(); } }
#pragma unroll
            for (int i = 0; i < 16; ++i) mx = fmaxf(mx, st[i]);
            mx = fmaxf(mx, __shfl_xor(mx, 32));
            const float mnew = fmaxf(mrun, mx);
            const float alpha = fexp2(mrun - mnew);
            float a[16]; float ps = 0.f;
#pragma unroll
            for (int i = 0; i < 16; ++i) { a[i] = fexp2(st[i] - mnew); ps += a[i]; }
            ps += __shfl_xor(ps, 32);
            lrun = lrun * alpha + ps; mrun = mnew;
#pragma unroll
            for (int i = 0; i < 16; ++i) { o0[i] *= alpha; o1[i] *= alpha; }
            const bf16x8 P0 = pack8(a[0], a[1], a[2], a[3], a[4], a[5], a[6], a[7]), P1 = pack8(a[8], a[9], a[10], a[11], a[12], a[13], a[14], a[15]);
            bf16x8 v00, v01, v10, v11; vt_frags4(vbase, lane, v00, v01, v10, v11);
            o0 = MFMA32(v00, P0, o0); o0 = MFMA32(v01, P1, o0); o1 = MFMA32(v10, P0, o1); o1 = MFMA32(v11, P1, o1);
        }
        const float inv = 1.f / lrun;
        const size_t orow = rowbase + (size_t)(m0 + r) * rr;
        bf16* op = proj + orow * 4608 + cq + 4 * h2;
#pragma unroll
        for (int gq = 0; gq < 4; ++gq) { u32x2 w; w.x = pk2(o0[4 * gq] * inv, o0[4 * gq + 1] * inv); w.y = pk2(o0[4 * gq + 2] * inv, o0[4 * gq + 3] * inv); *(u32x2*)(op + 8 * gq) = w;
            u32x2 w1; w1.x = pk2(o1[4 * gq] * inv, o1[4 * gq + 1] * inv); w1.y = pk2(o1[4 * gq + 2] * inv, o1[4 * gq + 3] * inv); *(u32x2*)(op + 32 + 8 * gq) = w1; }
        if (h2 == 0) lse[((size_t)g * T + orow) * 8 + hd] = mrun + flog2(lrun);
    }
#undef DIL_DECODE
#undef DIL_LOAD
}
DI void ph_dil_combine(Ctx& F) {
    unsigned char* ws = F.ws; const bf16* proj = (const bf16*)(ws + WS_BIG); const float* lse = (const float*)(ws + WS_LSE); bf16* HO = (bf16*)(ws + WS_HO);
    const int gw = F.bid * NWAVES + F.wave, NGW = F.G * NWAVES; const int lane = F.lane, hd = lane >> 3;
    for (int row = gw; row < T; row += NGW) {
        const float l0 = lse[((size_t)0 * T + row) * 8 + hd], l1 = lse[((size_t)1 * T + row) * 8 + hd], l2 = lse[((size_t)2 * T + row) * 8 + hd];
        const float m = fmaxf(l0, fmaxf(l1, l2)); float w0 = fexp2(l0 - m), w1 = fexp2(l1 - m), w2 = fexp2(l2 - m); const float inv = 1.f / (w0 + w1 + w2); w0 *= inv; w1 *= inv; w2 *= inv;
        const bf16* p = proj + (size_t)row * 4608 + 8 * lane;
        const u32x4 a = *(const u32x4*)p, b = *(const u32x4*)(p + 1536), c = *(const u32x4*)(p + 3072);
        u32x4 o; float f[8];
#pragma unroll
        for (int e = 0; e < 4; ++e) { const float lo = w0 * bflo(a[e]) + w1 * bflo(b[e]) + w2 * bflo(c[e]), hi = w0 * bfhi(a[e]) + w1 * bfhi(b[e]) + w2 * bfhi(c[e]); o[e] = pk2(lo, hi); f[2 * e] = lo; f[2 * e + 1] = hi; }
        if (out_fp8(3)) { u32x2 q8; q8.x = pk4_fp8(f[0], f[1], f[2], f[3]); q8.y = pk4_fp8(f[4], f[5], f[6], f[7]); *(u32x2*)((unsigned char*)HO + (size_t)row * 512 + 8 * lane) = q8; }
        else *(u32x4*)(HO + (size_t)row * 512 + 8 * lane) = o;
    }
}

DI void ph_conv(Ctx& F) {
    const KParams& P = *F.p; unsigned char* ws = F.ws; const bf16* proj = (const bf16*)(ws + WS_BIG); bf16* HO = (bf16*)(ws + WS_HO);
    const int gw = F.bid * NWAVES + F.wave, NGW = F.G * NWAVES; const int lane = F.lane;
    const float* cw = PIN(I_CONVW); const float* cb = PIN(I_CONVB);
    f32x4 w0[4], w1[4], w2[4], bb[4];
#pragma unroll
    for (int j = 0; j < 4; ++j) { const int col = 4 * lane + 256 * j; w0[j] = *(const f32x4*)(cw + col); w1[j] = *(const f32x4*)(cw + D + col); w2[j] = *(const f32x4*)(cw + 2 * D + col); bb[j] = *(const f32x4*)(cb + col); }
    for (int blk = gw; blk < T / 32; blk += NGW) {
        const int row0 = blk * 32, pos0 = row0 % SEQ;
        f32x4 um1[4], um2[4];
#pragma unroll
        for (int j = 0; j < 4; ++j) { um1[j] = (f32x4){0.f, 0.f, 0.f, 0.f}; um2[j] = um1[j]; }
        if (pos0 >= 2) {
#pragma unroll
            for (int j = 0; j < 4; ++j) { const int col = 4 * lane + 256 * j;
                const u32x2 c1 = *(const u32x2*)(proj + (size_t)(row0 - 1) * 3072 + 1024 + col), u1 = *(const u32x2*)(proj + (size_t)(row0 - 1) * 3072 + 2048 + col);
                const u32x2 c2 = *(const u32x2*)(proj + (size_t)(row0 - 2) * 3072 + 1024 + col), u2 = *(const u32x2*)(proj + (size_t)(row0 - 2) * 3072 + 2048 + col);
                um1[j] = (f32x4){bflo(c1.x) * bflo(u1.x), bfhi(c1.x) * bfhi(u1.x), bflo(c1.y) * bflo(u1.y), bfhi(c1.y) * bfhi(u1.y)};
                um2[j] = (f32x4){bflo(c2.x) * bflo(u2.x), bfhi(c2.x) * bfhi(u2.x), bflo(c2.y) * bflo(u2.y), bfhi(c2.y) * bfhi(u2.y)}; }
        }
        u32x2 ngb[4], nc0[4], nu0[4];
#pragma unroll
        for (int j = 0; j < 4; ++j) { const int col = 4 * lane + 256 * j; const bf16* p = proj + (size_t)row0 * 3072 + col; ngb[j] = *(const u32x2*)p; nc0[j] = *(const u32x2*)(p + 1024); nu0[j] = *(const u32x2*)(p + 2048); }
        for (int rr = 0; rr < 32; ++rr) { const size_t row = (size_t)row0 + rr;
            u32x2 gbv_[4], c0v[4], u0v[4];
#pragma unroll
            for (int j = 0; j < 4; ++j) { gbv_[j] = ngb[j]; c0v[j] = nc0[j]; u0v[j] = nu0[j]; }
            if (rr + 1 < 32) {
#pragma unroll
                for (int j = 0; j < 4; ++j) { const int col = 4 * lane + 256 * j; const bf16* p = proj + (row + 1) * 3072 + col; ngb[j] = *(const u32x2*)p; nc0[j] = *(const u32x2*)(p + 1024); nu0[j] = *(const u32x2*)(p + 2048); } }
#pragma unroll
            for (int j = 0; j < 4; ++j) { const int col = 4 * lane + 256 * j;
                const u32x2 gb = gbv_[j], c0 = c0v[j], u0 = u0v[j];
                const f32x4 uc = (f32x4){bflo(c0.x) * bflo(u0.x), bfhi(c0.x) * bfhi(u0.x), bflo(c0.y) * bflo(u0.y), bfhi(c0.y) * bfhi(u0.y)};
                const f32x4 y = w0[j] * um2[j] + w1[j] * um1[j] + w2[j] * uc + bb[j];
                const f32x4 gbv = (f32x4){bflo(gb.x), bfhi(gb.x), bflo(gb.y), bfhi(gb.y)};
                const f32x4 z = gbv * y;
                if (out_fp8(2)) *(unsigned*)((unsigned char*)HO + row * D + col) = pk4_fp8(z[0], z[1], z[2], z[3]);
                else { u32x2 o; o.x = pk2(z[0], z[1]); o.y = pk2(z[2], z[3]); *(u32x2*)(HO + row * D + col) = o; }
                um2[j] = um1[j]; um1[j] = uc; }
        }
    }
}

constexpr int G1_GD = 0, G1_QIN = 4096, G1_PITCH = 1040, G1_KIN = G1_QIN + 64 * G1_PITCH;
DI void ph_gla_g1(Ctx& F) {
    const KParams& P = *F.p; unsigned char* ws = F.ws; bf16* proj = (bf16*)(ws + WS_BIG);
    const float* gdn = (const float*)(ws + WS_GDOWN); float* decay = (float*)(ws + WS_DECAY);
    bf16* kst = (bf16*)(ws + WS_KST); bf16* vT = (bf16*)(ws + WS_VT); bf16* sc = (bf16*)(ws + WS_SC);
    LAS float* GD = (LAS float*)(F.lds + G1_GD); LAS unsigned char* QIN = F.lds + G1_QIN; LAS unsigned char* KIN = F.lds + G1_KIN;
    const int tid = F.tid, ch = tid, lane = F.lane, r = lane & 31, h2 = lane >> 5;
    float wup[16];
#pragma unroll
    for (int o = 0; o < 16; ++o) wup[o] = PIN(I_GLAGU)[o * 512 + ch];
    const float bg = PIN(I_GLABG)[ch];
    for (int item = F.bid; item < T / 64; item += F.G) {
        const size_t row0 = (size_t)item * 64;
        __syncthreads();
        if (tid < 256) *(LAS f32x4*)(GD + tid * 4) = *(const f32x4*)(gdn + row0 * 16 + tid * 4);
#pragma unroll
        for (int p = 0; p < 8; ++p) { const int piece = tid + 512 * p, row = piece >> 6, c16 = piece & 63; const bf16* src = proj + (row0 + row) * 3072 + c16 * 8;
            *(LAS u32x4*)(QIN + row * G1_PITCH + c16 * 16) = *(const u32x4*)src; *(LAS u32x4*)(KIN + row * G1_PITCH + c16 * 16) = *(const u32x4*)(src + 512); }
#pragma unroll
        for (int q = 0; q < 2; ++q) { const int blk = tid + 512 * q, to = blk & 7, co = blk >> 3;
            u32x4 rw[8];
#pragma unroll
            for (int t = 0; t < 8; ++t) rw[t] = *(const u32x4*)(proj + (row0 + 8 * to + t) * 3072 + 1024 + 8 * co);
#pragma unroll
            for (int c = 0; c < 8; ++c) { const unsigned sel = (c & 1) ? 0x07060302u : 0x05040100u; u32x4 o;
                o.x = __builtin_amdgcn_perm(rw[1][c >> 1], rw[0][c >> 1], sel); o.y = __builtin_amdgcn_perm(rw[3][c >> 1], rw[2][c >> 1], sel);
                o.z = __builtin_amdgcn_perm(rw[5][c >> 1], rw[4][c >> 1], sel); o.w = __builtin_amdgcn_perm(rw[7][c >> 1], rw[6][c >> 1], sel);
                *(u32x4*)(vT + ((size_t)item * 1024 + 8 * co + c) * 64 + 8 * to) = o; } }
        __syncthreads();
        float bs[64]; float bc = 0.f;
#pragma unroll
        for (int i = 0; i < 64; ++i) {
            float u = bg;
#pragma unroll
            for (int q4 = 0; q4 < 4; ++q4) { const f32x4 g = *(const LAS f32x4*)(GD + i * 16 + q4 * 4); u += (g[0] * wup[q4 * 4] + g[1] * wup[q4 * 4 + 1]) + (g[2] * wup[q4 * 4 + 2] + g[3] * wup[q4 * 4 + 3]); }
            const float u2 = u * LOG2E;
            const float ls2 = -(fmaxf(-u2, 0.f) + flog2(1.f + fexp2(-fabsf(u2))));
            bc += ls2 * (1.f / 16.f); bs[i] = bc;
        }
        unsigned kp[32];
#pragma unroll
        for (int i = 0; i < 64; ++i) {
            LAS unsigned short* qp = (LAS unsigned short*)(QIN + i * G1_PITCH + ch * 2); LAS unsigned short* kq = (LAS unsigned short*)(KIN + i * G1_PITCH + ch * 2);
            const float qv = bf2f(*qp), kv = bf2f(*kq);
            const float qin = qv * fexp2(bs[i]), kin = kv * fexp2(-bs[i]), kstv = kv * fexp2(bs[63] - bs[i]);
            *qp = (unsigned short)f2bf(qin); *kq = (unsigned short)f2bf(kin);
            if (i & 1) kp[i >> 1] |= f2bf(kstv) << 16; else kp[i >> 1] = f2bf(kstv);
        }
        { u32x4* dst = (u32x4*)(kst + ((size_t)item * 512 + ch) * 64);
#pragma unroll
          for (int q8 = 0; q8 < 8; ++q8) dst[q8] = (u32x4){kp[4 * q8], kp[4 * q8 + 1], kp[4 * q8 + 2], kp[4 * q8 + 3]}; }
        decay[(size_t)item * 512 + ch] = fexp2(bs[63]);
        __syncthreads();
#pragma unroll
        for (int p = 0; p < 8; ++p) { const int piece = tid + 512 * p, row = piece >> 6, c16 = piece & 63;
            *(u32x4*)(proj + (row0 + row) * 3072 + c16 * 8) = *(const LAS u32x4*)(QIN + row * G1_PITCH + c16 * 16); }
        { const int shd = F.wave >> 1, jt = F.wave & 1;
#pragma unroll
          for (int itile = 0; itile < 2; ++itile) {
            f32x16 st = zero16();
            if (jt <= itile) {
#pragma unroll
                for (int s = 0; s < 8; ++s) { const bf16x8 kf = *(const LAS bf16x8*)(KIN + (jt * 32 + r) * G1_PITCH + (shd * 128 + 16 * s + 8 * h2) * 2);
                    const bf16x8 qf = *(const LAS bf16x8*)(QIN + (itile * 32 + r) * G1_PITCH + (shd * 128 + 16 * s + 8 * h2) * 2);
                    st = MFMA32(kf, qf, st); }
            }
            const int iq = itile * 32 + r;
            bf16* dst = sc + (((size_t)item * 4 + shd) * 64 + iq) * 64 + jt * 32 + 4 * h2;
#pragma unroll
            for (int g = 0; g < 4; ++g) { float v[4];
#pragma unroll
                for (int k = 0; k < 4; ++k) { const int j = jt * 32 + 8 * g + 4 * h2 + k; v[k] = (j <= iq) ? st[4 * g + k] : 0.f; }
                u32x2 w; w.x = pk2(v[0], v[1]); w.y = pk2(v[2], v[3]); *(u32x2*)(dst + 8 * g) = w; }
          } }
    }
}
constexpr int G2_SC = 0, G2_QI = 9216, G2_KS = G2_QI + 17408, G2_DC = G2_KS + 18432, G2_BUF = G2_DC + 512;
constexpr int NSEG = 8, SEGC = (SEQ / 64) / NSEG;
template <int MODE> DI void ph_gla_g2(Ctx& F) {
    unsigned char* ws = F.ws; const bf16* proj = (const bf16*)(ws + WS_BIG); const float* decay = (const float*)(ws + WS_DECAY);
    const bf16* kst = (const bf16*)(ws + WS_KST); const bf16* vT = (const bf16*)(ws + WS_VT); const bf16* sc = (const bf16*)(ws + WS_SC); bf16* oraw = (bf16*)(ws + WS_HO);
    float* send = (float*)(ws + WS_SEND); float* dseg = (float*)(ws + WS_DSEG);
    const int tid = F.tid, lane = F.lane, r = lane & 31, h2 = lane >> 5, dvs = F.wave;
    for (int item = F.bid; item < NB * 4 * NSEG; item += F.G) {
        const int seg = item & (NSEG - 1), hd = (item >> 3) & 3, b = item >> 5;
        if (MODE == 0 && seg == NSEG - 1) continue;
        const size_t ci0 = (size_t)b * (SEQ / 64) + seg * SEGC;
        const int sc_row = tid >> 3, sc_c = tid & 7;
        const int qi_row0 = tid >> 4, qi_c = tid & 15;
        const int ks_row0 = tid >> 3, ks_c = tid & 7;
        u32x4 st_sc, st_q0, st_q1, st_k0, st_k1; f32x4 st_d = (f32x4){0.f, 0.f, 0.f, 0.f};
        bf16x8 Vf[4], VfN[4];
#define G2_LOAD(ci) do { \
            if (MODE == 1) { st_sc = *(const u32x4*)(sc + (((ci) * 4 + hd) * 64 + sc_row) * 64 + sc_c * 8); \
                st_q0 = *(const u32x4*)(proj + ((ci) * 64 + qi_row0) * 3072 + hd * 128 + qi_c * 8); st_q1 = *(const u32x4*)(proj + ((ci) * 64 + qi_row0 + 32) * 3072 + hd * 128 + qi_c * 8); } \
            st_k0 = *(const u32x4*)(kst + (((ci) * 4 + hd) * 128 + ks_row0) * 64 + ks_c * 8); st_k1 = *(const u32x4*)(kst + (((ci) * 4 + hd) * 128 + ks_row0 + 64) * 64 + ks_c * 8); \
            if (tid < 32) st_d = *(const f32x4*)(decay + (ci) * 512 + hd * 128 + tid * 4); \
            { const bf16* vrow_ = vT + ((ci) * 1024 + hd * 256 + dvs * 32 + r) * 64 + 8 * h2; _Pragma("unroll") for (int s_ = 0; s_ < 4; ++s_) VfN[s_] = ldg8(vrow_ + 16 * s_); } } while (0)
#define G2_STORE(bufp) do { \
            if (MODE == 1) { *(LAS u32x4*)((bufp) + G2_SC + sc_row * 144 + sc_c * 16) = st_sc; \
                *(LAS u32x4*)((bufp) + G2_QI + qi_row0 * 272 + qi_c * 16) = st_q0; *(LAS u32x4*)((bufp) + G2_QI + (qi_row0 + 32) * 272 + qi_c * 16) = st_q1; } \
            *(LAS u32x4*)((bufp) + G2_KS + ks_row0 * 144 + ks_c * 16) = st_k0; *(LAS u32x4*)((bufp) + G2_KS + (ks_row0 + 64) * 144 + ks_c * 16) = st_k1; \
            if (tid < 32) *(LAS f32x4*)((bufp) + G2_DC + tid * 16) = st_d; } while (0)
        __syncthreads();
        G2_LOAD(ci0);
        f32x16 S[4];
#pragma unroll
        for (int mt = 0; mt < 4; ++mt) S[mt] = zero16();
        if (MODE == 1) {
            for (int sp = 0; sp < seg; ++sp) {
                const float* dp = dseg + (size_t)(item - seg + sp) * 128 + 4 * h2;
                const float* sp_ = send + ((size_t)(item - seg + sp) * NWAVES + dvs) * 4096 + lane * 4;
#pragma unroll
                for (int mt = 0; mt < 4; ++mt)
#pragma unroll
                    for (int g = 0; g < 4; ++g) { const f32x4 dv = *(const f32x4*)(dp + 32 * mt + 8 * g), sv = *(const f32x4*)(sp_ + (mt * 4 + g) * 256);
#pragma unroll
                        for (int k = 0; k < 4; ++k) S[mt][4 * g + k] = S[mt][4 * g + k] * dv[k] + sv[k]; }
            }
        } else if (tid < 128) {
            float pr = 1.f;
            for (int n = 0; n < SEGC; ++n) pr *= decay[(ci0 + n) * 512 + hd * 128 + tid];
            dseg[(size_t)item * 128 + tid] = pr;
        }
        G2_STORE(F.lds);
#pragma unroll
        for (int s = 0; s < 4; ++s) Vf[s] = VfN[s];
        __syncthreads();
        for (int n = 0; n < SEGC; ++n) {
            const size_t ci = ci0 + n;
            LAS unsigned char* buf = F.lds + (n & 1) * G2_BUF; LAS unsigned char* nbuf = F.lds + ((n + 1) & 1) * G2_BUF;
            if (n + 1 < SEGC) G2_LOAD(ci + 1);
            if (MODE == 1) {
                bf16x8 Sb[4][2];
#pragma unroll
                for (int mt = 0; mt < 4; ++mt) { Sb[mt][0] = pack_step(S[mt], 0); Sb[mt][1] = pack_step(S[mt], 1); }
#pragma unroll
                for (int itile = 0; itile < 2; ++itile) {
                    f32x16 o = zero16();
                    const LAS unsigned char* scrow = buf + G2_SC + (itile * 32 + r) * 144 + 16 * h2;
#pragma unroll
                    for (int s = 0; s < 4; ++s) o = MFMA32(Vf[s], *(const LAS bf16x8*)(scrow + 32 * s), o);
                    const LAS unsigned char* qrow = buf + G2_QI + (itile * 32 + r) * 272 + 8 * h2;
#pragma unroll
                    for (int mt = 0; mt < 4; ++mt)
#pragma unroll
                        for (int s2 = 0; s2 < 2; ++s2) { const u32x2 lo = *(const LAS u32x2*)(qrow + 64 * mt + 32 * s2), hi = *(const LAS u32x2*)(qrow + 64 * mt + 32 * s2 + 16);
                            const u32x4 fr = (u32x4){lo.x, lo.y, hi.x, hi.y};
                            o = MFMA32(Sb[mt][s2], __builtin_bit_cast(bf16x8, fr), o); }
                    bf16* op = oraw + (ci * 64 + itile * 32 + r) * 1024 + hd * 256 + dvs * 32 + 4 * h2;
#pragma unroll
                    for (int g = 0; g < 4; ++g) { u32x2 w; w.x = pk2(o[4 * g], o[4 * g + 1]); w.y = pk2(o[4 * g + 2], o[4 * g + 3]); *(u32x2*)(op + 8 * g) = w; }
                }
            }
#pragma unroll
            for (int mt = 0; mt < 4; ++mt) {
                const LAS unsigned char* dp = buf + G2_DC + (32 * mt + 4 * h2) * 4;
#pragma unroll
                for (int g = 0; g < 4; ++g) { const f32x4 dv = *(const LAS f32x4*)(dp + 32 * g);
#pragma unroll
                    for (int k = 0; k < 4; ++k) S[mt][4 * g + k] *= dv[k]; }
                const LAS unsigned char* krow = buf + G2_KS + (32 * mt + r) * 144 + 16 * h2;
#pragma unroll
                for (int s = 0; s < 4; ++s) S[mt] = MFMA32(*(const LAS bf16x8*)(krow + 32 * s), Vf[s], S[mt]);
            }
            if (n + 1 < SEGC) { G2_STORE(nbuf);
#pragma unroll
                for (int s = 0; s < 4; ++s) Vf[s] = VfN[s]; }
            asm volatile("s_waitcnt lgkmcnt(0)" ::: "memory"); __builtin_amdgcn_s_barrier(); asm volatile("" ::: "memory");
        }
        if (MODE == 1) {
            asm volatile("s_waitcnt vmcnt(0)" ::: "memory"); __syncthreads();
            const float* gng = (const float*)F.p->in[I_GLANG]; const int cl = (lane & 15) * 16;
            float gn[16];
#pragma unroll
            for (int e = 0; e < 16; ++e) gn[e] = gng[cl + e];
            u32x4 na0, na1, nr0, nr1;
            { const size_t row = ci0 * 64 + (size_t)F.wave * 4 + (lane >> 4); const bf16* op = oraw + row * D + hd * 256 + cl; const bf16* rp = proj + row * 3072 + 2048 + hd * 256 + cl;
              na0 = *(const u32x4*)op; na1 = *(const u32x4*)(op + 8); nr0 = *(const u32x4*)rp; nr1 = *(const u32x4*)(rp + 8); }
            for (int q = F.wave; q < SEGC * 16; q += NWAVES) {
                const size_t row = ci0 * 64 + (size_t)q * 4 + (lane >> 4);
                bf16* op = oraw + row * D + hd * 256 + cl;
                const u32x4 a0 = na0, a1 = na1, r0 = nr0, r1 = nr1;
                if (q + NWAVES < SEGC * 16) { const size_t rown = row + 4 * NWAVES; const bf16* opn = oraw + rown * D + hd * 256 + cl; const bf16* rpn = proj + rown * 3072 + 2048 + hd * 256 + cl;
                    na0 = *(const u32x4*)opn; na1 = *(const u32x4*)(opn + 8); nr0 = *(const u32x4*)rpn; nr1 = *(const u32x4*)(rpn + 8); }
                float v[16], rv[16];
#pragma unroll
                for (int e = 0; e < 4; ++e) { v[2 * e] = bflo(a0[e]); v[2 * e + 1] = bfhi(a0[e]); v[8 + 2 * e] = bflo(a1[e]); v[8 + 2 * e + 1] = bfhi(a1[e]);
                    rv[2 * e] = bflo(r0[e]); rv[2 * e + 1] = bfhi(r0[e]); rv[8 + 2 * e] = bflo(r1[e]); rv[8 + 2 * e + 1] = bfhi(r1[e]); }
                float ss = 0.f;
#pragma unroll
                for (int e = 0; e < 16; ++e) ss += v[e] * v[e];
                ss += __shfl_xor(ss, 1); ss += __shfl_xor(ss, 2); ss += __shfl_xor(ss, 4); ss += __shfl_xor(ss, 8);
                const float rstd = 1.f / sqrtf(ss * (1.f / 256.f) + RMS_EPS);
                float o[16];
#pragma unroll
                for (int e = 0; e < 16; ++e) { const float rr = rv[e]; o[e] = v[e] * rstd * gn[e] * (rr / (1.f + __expf(-rr))); }
                if (out_fp8(1)) { u32x4 q8;
#pragma unroll
                    for (int e = 0; e < 4; ++e) q8[e] = pk4_fp8(o[4 * e], o[4 * e + 1], o[4 * e + 2], o[4 * e + 3]);
                    *(u32x4*)(ws + WS_KST + row * D + hd * 256 + cl) = q8; }
                else { u32x4 w0, w1;
#pragma unroll
                    for (int e = 0; e < 4; ++e) { w0[e] = pk2(o[2 * e], o[2 * e + 1]); w1[e] = pk2(o[8 + 2 * e], o[8 + 2 * e + 1]); }
                    *(u32x4*)op = w0; *(u32x4*)(op + 8) = w1; }
            }
        }
        if (MODE == 0) {
            float* sp_ = send + ((size_t)item * NWAVES + dvs) * 4096 + lane * 4;
#pragma unroll
            for (int mt = 0; mt < 4; ++mt)
#pragma unroll
                for (int g = 0; g < 4; ++g) *(f32x4*)(sp_ + (mt * 4 + g) * 256) = (f32x4){S[mt][4 * g], S[mt][4 * g + 1], S[mt][4 * g + 2], S[mt][4 * g + 3]};
        }
#undef G2_LOAD
#undef G2_STORE
    }
}
DI void ph_gla_g3(Ctx& F) {
    const KParams& P = *F.p; unsigned char* ws = F.ws; const bf16* proj = (const bf16*)(ws + WS_BIG); bf16* HO = (bf16*)(ws + WS_HO);
    const int gw = F.bid * NWAVES + F.wave, NGW = F.G * NWAVES; const int lane = F.lane;
    float gn[16];
#pragma unroll
    for (int e = 0; e < 16; ++e) gn[e] = PIN(I_GLANG)[(16 * lane + e) & 255];
    for (int row = gw; row < T; row += NGW) {
        bf16* op = HO + (size_t)row * D + 16 * lane; const bf16* rp = proj + (size_t)row * 3072 + 2048 + 16 * lane;
        const u32x4 a0 = *(const u32x4*)op, a1 = *(const u32x4*)(op + 8), r0 = *(const u32x4*)rp, r1 = *(const u32x4*)(rp + 8);
        float v[16], rv[16];
#pragma unroll
        for (int e = 0; e < 4; ++e) { v[2 * e] = bflo(a0[e]); v[2 * e + 1] = bfhi(a0[e]); v[8 + 2 * e] = bflo(a1[e]); v[8 + 2 * e + 1] = bfhi(a1[e]);
            rv[2 * e] = bflo(r0[e]); rv[2 * e + 1] = bfhi(r0[e]); rv[8 + 2 * e] = bflo(r1[e]); rv[8 + 2 * e + 1] = bfhi(r1[e]); }
        float ss = 0.f;
#pragma unroll
        for (int e = 0; e < 16; ++e) ss += v[e] * v[e];
        ss += __shfl_xor(ss, 1); ss += __shfl_xor(ss, 2); ss += __shfl_xor(ss, 4); ss += __shfl_xor(ss, 8);
        const float rstd = 1.f / sqrtf(ss * (1.f / 256.f) + RMS_EPS);
        float o[16];
#pragma unroll
        for (int e = 0; e < 16; ++e) { const float rr = rv[e]; o[e] = v[e] * rstd * gn[e] * (rr / (1.f + __expf(-rr))); }
        if (out_fp8(1)) { u32x4 q8;
#pragma unroll
            for (int e = 0; e < 4; ++e) q8[e] = pk4_fp8(o[4 * e], o[4 * e + 1], o[4 * e + 2], o[4 * e + 3]);
            *(u32x4*)(ws + WS_KST + (size_t)row * D + 16 * lane) = q8; }
        else {
        u32x4 w0, w1;
#pragma unroll
        for (int e = 0; e < 4; ++e) { w0[e] = pk2(o[2 * e], o[2 * e + 1]); w1[e] = pk2(o[8 + 2 * e], o[8 + 2 * e + 1]); }
        *(u32x4*)op = w0; *(u32x4*)(op + 8) = w1; }
    }
}

constexpr int N2_PITCH = 2064, N2_GM = 37 * N2_PITCH + 432  , N2_SH = N2_GM + 4096;
DI bool n2_better(float va, int ia, float vb, int ib) { return va > vb || (va == vb && ia < ib); }
DI void ph_norm2(Ctx& F, int l) {
    const KParams& P = *F.p; unsigned char* ws = F.ws;
    const float* modf = (const float*)(ws + WS_MODF);
    LAS unsigned char* WTb = F.lds;
    LAS float* GM = (LAS float*)(F.lds + N2_GM); LAS float* SH = (LAS float*)(F.lds + N2_SH);
    volatile LAS unsigned* hist = F.MISC + 32;
    const float* wg = PIN(I_MGRPW) + (size_t)l * D * 4; const float* we = PIN(I_MEXPW) + (size_t)l * D * 32;
    const float* bgp = PIN(I_MGRPB) + l * 4; const float* bep = PIN(I_MEXPB) + l * 32;
    __syncthreads();
    for (int c = F.tid; c < D; c += NTHR) { const f32x4 w = *(const f32x4*)(wg + c * 4);
#pragma unroll
        for (int e = 0; e < 4; ++e) *(LAS unsigned short*)(WTb + (32 + e) * N2_PITCH + c * 2) = (unsigned short)f2bf(w[e]);
        *(LAS unsigned short*)(WTb + 36 * N2_PITCH + c * 2) = 0; }
    for (int idx = F.tid; idx < D * 8; idx += NTHR) { const int c = idx >> 3, part = idx & 7; const f32x4 w = *(const f32x4*)(we + c * 32 + part * 4);
#pragma unroll
        for (int e = 0; e < 4; ++e) *(LAS unsigned short*)(WTb + (part * 4 + e) * N2_PITCH + c * 2) = (unsigned short)f2bf(w[e]); }
    const bf16* X = (const bf16*)(ws + WS_XB); unsigned char* HO8 = ws + WS_HO;
    int* tok_e = (int*)(ws + WS_TOKE); float* tok_w = (float*)(ws + WS_TOKW); int* hist_g = (int*)(ws + WS_HIST);
    const float* ng = PIN(I_NORMG) + (size_t)(l * 2 + 1) * D;
    const int lane = F.lane, r = lane & 31, h2 = lane >> 5;
    for (int vb = F.bid; vb < T / 256; vb += F.G) {
        __syncthreads();
        if (F.tid < 32) hist[F.tid] = 0u;
        const int b = (vb * 256) / SEQ;
        if (F.tid < 256) { const float* mp = modf + ((size_t)l * NB + b) * 6144; const f32x4 shv = *(const f32x4*)(mp + 3 * D + 4 * F.tid), scv = *(const f32x4*)(mp + 4 * D + 4 * F.tid), gv = *(const f32x4*)(ng + 4 * F.tid);
            *(LAS f32x4*)(GM + 4 * F.tid) = gv * (scv + 1.f); *(LAS f32x4*)(SH + 4 * F.tid) = shv; }
        __syncthreads();
        const int row = vb * 256 + F.wave * 32 + r;
        const bf16* xrow = X + (size_t)row * D + 512 * h2;
        float ss = 0.f;
        { const float* sp = (const float*)(ws + WS_SSP) + (size_t)row * 16;
#pragma unroll
          for (int q = 0; q < 4; ++q) { const f32x4 pq = *(const f32x4*)(sp + 4 * q); ss += (pq[0] + pq[1]) + (pq[2] + pq[3]); } }
        const float rstd = 1.f / sqrtf(ss * (1.f / D) + RMS_EPS);
        f32x16 accE = zero16(), accG = zero16();
        const LAS unsigned char* aE = WTb + r * N2_PITCH + 1024 * h2; const LAS unsigned char* aG = WTb + (r < 4 ? 32 + r : 36) * N2_PITCH + 1024 * h2;
        const LAS float* gmp = GM + 512 * h2; const LAS float* shp = SH + 512 * h2;
        unsigned char* hrow = HO8 + (size_t)row * D + 512 * h2;
        for (int s8 = 0; s8 < 64; s8 += 8) {
            u32x4 wv[8];
#pragma unroll
            for (int q = 0; q < 8; ++q) wv[q] = *(const u32x4*)(xrow + 8 * (s8 + q));
#pragma unroll
            for (int q = 0; q < 8; q += 2) {
                u32x4 st8;
#pragma unroll
                for (int q2 = 0; q2 < 2; ++q2) { const int s2 = s8 + q + q2; const u32x4 w = wv[q + q2];
                    const f32x4 g0 = *(const LAS f32x4*)(gmp + 8 * s2), g1 = *(const LAS f32x4*)(gmp + 8 * s2 + 4), s0 = *(const LAS f32x4*)(shp + 8 * s2), s1 = *(const LAS f32x4*)(shp + 8 * s2 + 4);
                    float h[8];
                    h[0] = bflo(w.x) * rstd * g0[0] + s0[0]; h[1] = bfhi(w.x) * rstd * g0[1] + s0[1]; h[2] = bflo(w.y) * rstd * g0[2] + s0[2]; h[3] = bfhi(w.y) * rstd * g0[3] + s0[3];
                    h[4] = bflo(w.z) * rstd * g1[0] + s1[0]; h[5] = bfhi(w.z) * rstd * g1[1] + s1[1]; h[6] = bflo(w.w) * rstd * g1[2] + s1[2]; h[7] = bfhi(w.w) * rstd * g1[3] + s1[3];
                    st8[2 * q2] = pk4_fp8(h[0], h[1], h[2], h[3]); st8[2 * q2 + 1] = pk4_fp8(h[4], h[5], h[6], h[7]);
                    const bf16x8 hb = pack8(h[0], h[1], h[2], h[3], h[4], h[5], h[6], h[7]);
                    accE = MFMA32(*(const LAS bf16x8*)(aE + 16 * s2), hb, accE);
                    accG = MFMA32(*(const LAS bf16x8*)(aG + 16 * s2), hb, accG); }
                *(u32x4*)(hrow + 8 * (s8 + q)) = st8;
            }
        }
        float gl[4];
#pragma unroll
        for (int o = 0; o < 4; ++o) gl[o] = accG[o] + bgp[o];
        int grp = 0; float gmax = gl[0];
#pragma unroll
        for (int o = 1; o < 4; ++o) if (gl[o] > gmax) { gmax = gl[o]; grp = o; }
        float gden = 0.f;
#pragma unroll
        for (int o = 0; o < 4; ++o) gden += __expf(gl[o] - gmax);
        float pgrp = 1.f / gden;
        grp = __shfl(grp, r); pgrp = __shfl(pgrp, r);
        float cv[4];
#pragma unroll
        for (int k = 0; k < 4; ++k) { const float v0 = accE[k], v1 = accE[4 + k], v2 = accE[8 + k], v3 = accE[12 + k];
            cv[k] = (grp == 0 ? v0 : grp == 1 ? v1 : grp == 2 ? v2 : v3) + bep[8 * grp + 4 * h2 + k]; }
        float a1 = -__builtin_inff(), a2 = -__builtin_inff(); int i1 = 0, i2 = 0;
#pragma unroll
        for (int k = 0; k < 4; ++k) { const float sv = cv[k]; const int id = 4 * h2 + k;
            if (sv > a1) { a2 = a1; i2 = i1; a1 = sv; i1 = id; } else if (sv > a2) { a2 = sv; i2 = id; } }
        const float b1 = __shfl_xor(a1, 32), b2 = __shfl_xor(a2, 32); const int j1 = __shfl_xor(i1, 32), j2 = __shfl_xor(i2, 32);
        float t1, t2; int e1, e2;
        if (n2_better(a1, i1, b1, j1)) { t1 = a1; e1 = i1; if (n2_better(a2, i2, b1, j1)) { t2 = a2; e2 = i2; } else { t2 = b1; e2 = j1; } }
        else { t1 = b1; e1 = j1; if (n2_better(a1, i1, b2, j2)) { t2 = a1; e2 = i1; } else { t2 = b2; e2 = j2; } }
        const float ex2 = __expf(t2 - t1), inv = 1.f / (1.f + ex2);
        if (h2 == 0) { const int e0g = grp * 8 + e1, e1g = grp * 8 + e2;
            tok_e[row * 2] = e0g; tok_e[row * 2 + 1] = e1g; tok_w[row * 2] = pgrp * inv; tok_w[row * 2 + 1] = pgrp * ex2 * inv;
            __hip_atomic_fetch_add((LAS unsigned*)(hist + e0g), 1u, __ATOMIC_RELAXED, __HIP_MEMORY_SCOPE_WORKGROUP); __hip_atomic_fetch_add((LAS unsigned*)(hist + e1g), 1u, __ATOMIC_RELAXED, __HIP_MEMORY_SCOPE_WORKGROUP); }
        __syncthreads();
        if (F.tid < 32) hist_g[vb * 32 + F.tid] = (int)hist[F.tid];
    }
}
DI void ph_scatter(Ctx& F) {
    unsigned char* ws = F.ws;
    const int* hist_g = (const int*)(ws + WS_HIST); const int* tok_e = (const int*)(ws + WS_TOKE);
    int* tok_s = (int*)(ws + WS_TOKS); int* slot_tok = (int*)(ws + WS_SLOTTOK); int* tile_e = (int*)(ws + WS_TILEE);
    LAS int* H = (LAS int*)F.lds; LAS int* eid = H + 8192; LAS int* tot = eid + 512; LAS int* base = tot + 32; LAS int* pstart = base + 32; LAS int* ptotal = pstart + 32; LAS int* ptot = ptotal + 32; LAS int* pbase = ptot + 512;
    for (int vb = F.bid; vb < T / 256; vb += F.G) {
        __syncthreads();
        for (int i = F.tid; i < 8192; i += NTHR) H[i] = hist_g[i];
        eid[F.tid] = tok_e[vb * 512 + F.tid];
        __syncthreads();
        { const int e_ = F.tid & 31, part = F.tid >> 5; int total = 0, before = 0;
#pragma unroll 4
          for (int q = 0; q < 16; ++q) { const int bb = part * 16 + q; const int c = H[bb * 32 + e_]; total += c; before += (bb < vb) ? c : 0; }
          ptot[part * 32 + e_] = total; pbase[part * 32 + e_] = before; }
        __syncthreads();
        if (F.tid < 32) { int total = 0, before = 0;
#pragma unroll
            for (int q = 0; q < 16; ++q) { total += ptot[q * 32 + F.tid]; before += pbase[q * 32 + F.tid]; }
            tot[F.tid] = total; base[F.tid] = before; }
        __syncthreads();
        if (F.tid == 0) { int ps = 0; for (int e = 0; e < 32; ++e) { pstart[e] = ps; ps += ((tot[e] + 255) >> 8) << 8; } ptotal[0] = ps; }
        __syncthreads();
        const int e = eid[F.tid]; int rank = 0;
        for (int j = 0; j < F.tid; ++j) rank += (eid[j] == e) ? 1 : 0;
        const int slot = pstart[e] + base[e] + rank;
        slot_tok[slot] = vb * 256 + (F.tid >> 1); tok_s[vb * 512 + F.tid] = slot;
        if (vb == 0) {
            if (F.tid < 32) { const int ee = F.tid, s0 = pstart[ee] + tot[ee], s1 = pstart[ee] + (((tot[ee] + 255) >> 8) << 8);
                for (int s = s0; s < s1; ++s) slot_tok[s] = 0;
                for (int tl = pstart[ee] >> 8; tl < (s1 >> 8); ++tl) tile_e[tl] = ee; }
            if (F.tid == 0) tile_e[1023] = ptotal[0] >> 8;
        }
    }
}
DI void ph_final(Ctx& F) {
    const KParams& P = *F.p; unsigned char* ws = F.ws;
    const int gw = F.bid * NWAVES + F.wave, NGW = F.G * NWAVES;
    const float* modf = (const float*)(ws + WS_MODF); float* X = (float*)P.out; const bf16* XB = (const bf16*)(ws + WS_XB); const float* fg = PIN(I_FINALG);
    for (int blk = gw; blk < T / 32; blk += NGW) {
        const int row0 = blk * 32, b = row0 / SEQ;
        f32x4 g2[4], gf[4];
        mod_vec_f(modf, DEPTH - 1, b, 5, F.lane, g2);
#pragma unroll
        for (int j = 0; j < 4; ++j) gf[j] = *(const f32x4*)(fg + 4 * F.lane + 256 * j);
        const int* ts = (const int*)(ws + WS_TOKS); const float* tw = (const float*)(ws + WS_TOKW); const unsigned char* ybp = ws + WS_YB;
        const int rw = row0 + (F.lane & 31);
        const int sl0 = __hip_atomic_load(ts + rw * 2, __ATOMIC_RELAXED, __HIP_MEMORY_SCOPE_AGENT), sl1 = __hip_atomic_load(ts + rw * 2 + 1, __ATOMIC_RELAXED, __HIP_MEMORY_SCOPE_AGENT);
        const float wl0 = __hip_atomic_load(tw + rw * 2, __ATOMIC_RELAXED, __HIP_MEMORY_SCOPE_AGENT), wl1 = __hip_atomic_load(tw + rw * 2 + 1, __ATOMIC_RELAXED, __HIP_MEMORY_SCOPE_AGENT);
        RowIn Rn, Rn2; rowin_load<true, false>(Rn, XB + (size_t)row0 * D, ybp, rdlane_i(sl0, 0), rdlane_i(sl1, 0), F.lane); rowin_load<true, false>(Rn2, XB + (size_t)(row0 + 1) * D, ybp, rdlane_i(sl0, 1), rdlane_i(sl1, 1), F.lane);
        for (int r = 0; r < 32; ++r) { const int row = row0 + r;
            RowIn Rc = Rn; Rn = Rn2;
            if (r + 2 < 32) rowin_load<true, false>(Rn2, XB + (size_t)(row + 2) * D, ybp, rdlane_i(sl0, r + 2), rdlane_i(sl1, r + 2), F.lane);
            f32x4 v[4]; rowin_combine(Rc, rdlane(wl0, r) * (1.f / pg8::MOE_S_Y), rdlane(wl1, r) * (1.f / pg8::MOE_S_Y), g2, v);
            const float rstd = row_rstd(v);
#pragma unroll
            for (int j = 0; j < 4; ++j) *(f32x4*)(X + (size_t)row * D + 4 * F.lane + 256 * j) = v[j] * rstd * gf[j];
        }
    }
}

constexpr int N_PHASES = 46;
#ifndef EN
#define EN 0xFFFFu
#endif
#ifdef PROBE_GROUP
#ifndef PROBE_LAYER
#define PROBE_LAYER (-1)
#endif
#ifndef PROBE_UNIT_US
#define PROBE_UNIT_US 8.f
#endif
#ifndef PROBE_L2
#define PROBE_L2 (-1)
#endif
#endif
#define ENB(i) (((EN) >> (i)) & 1u)
__host__ __device__ inline bool phase_exists(int k) { if (k == 0 || k == 45) return true; const int l = (k - 1) / 11, j = (k - 1) % 11; if (j == 3) return l == 1 || l == 3; if (j == 4) return l == 1; if (j == 5) return false; return true; }

#define RUN(k) (ph_lo <= (k) && (k) < ph_hi)
#define FRESH() int t_ = threadIdx.x; asm volatile("" : "+v"(t_)); F.tid = t_; F.lane = t_ & 63; F.wave = __builtin_amdgcn_readfirstlane(t_ >> 6); \
    { const KParams* kp_ = (const KParams*)__builtin_amdgcn_kernarg_segment_ptr(); asm volatile("" : "+s"(kp_)); F.p = kp_; } GAS unsigned char* wsg_ = F.p->ws; asm volatile("" : "+s"(wsg_)); unsigned char* ws = (unsigned char*)wsg_;   F.ws = ws; bf16* HO = (bf16*)(ws + WS_HO); bf16* BIG = (bf16*)(ws + WS_BIG); float* modf = (float*)(ws + WS_MODF); (void)HO; (void)BIG; (void)modf
#ifdef PROBE_GROUP
#define PROBE(grp, lay) do { const unsigned long long t_ = __builtin_amdgcn_s_memrealtime(); if ((grp) == PROBE_GROUP && (PROBE_LAYER < 0 || (lay) == PROBE_LAYER)) pr_acc += t_ - pr_prev; pr_prev = t_; } while (0)
#else
#define PROBE(grp, lay) do { } while (0)
#endif
#if MK_N_LAUNCHES == 1
#define SEAM(k) do { int hi_ = ph_hi; asm volatile("" : "+s"(hi_)); if ((k) + 1 < hi_) { PROBE_BAR(99); SPREAD_ARRIVE(k); xcd_barrier<false>(bar); PROBE_BAR(16); } } while (0)
#define SEAM0() do { if (1 < ph_hi) xcd_barrier<true>(bar); } while (0)
#else
#define SEAM(k) do { } while (0)
#define SEAM0() do { } while (0)
#endif
#if defined(PROBE_GROUP) && PROBE_GROUP == 16
#define PROBE_BAR(g) PROBE(g, 0)
#else
#define PROBE_BAR(g) do { } while (0)
#endif
#if defined(PROBE_GROUP) && PROBE_GROUP == 17
#define SPREAD_ARRIVE(k) do { if (threadIdx.x == 0) { const unsigned long long t_ = __builtin_amdgcn_s_memrealtime(); unsigned long long* sp_ = (unsigned long long*)((unsigned char*)F.p->ws + WS_CTL + 65536); \
        atomicMax(sp_ + (k), ~t_); atomicMax(sp_ + 64 + (k), t_); } } while (0)
#else
#define SPREAD_ARRIVE(k) do { } while (0)
#endif
template <int l> DI void run_layer(Ctx& F, const XcdBarrier& bar, const int ph_lo, const int ph_hi, unsigned long long& pr_prev, unsigned long long& pr_acc) {
        const int pb = 1 + 11 * l;
        if (ENB(1) && RUN(pb + 0)) { FRESH(); ph_norm1(F, l); SEAM(pb + 0); PROBE(1, l); }
        if (ENB(2) && RUN(pb + 1)) { FRESH();
            const int N = (l == 3) ? 4608 : 3072;
            const void* Bt = ws + (l == 0 ? W_SBIN : l == 1 ? W_GLAIN : l == 2 ? W_CONVIN : W_DILIN);
            pg8::DenseSched S; S.init(T, N, in_fp8(l) ? D : D * 2, Bt, F.G, F.bid);
            pg8::EpiProj E; E.O = BIG; E.ldc = N; E.period = (l == 3) ? 1536 : 3072; E.qcols = (l == 0) ? 1024 : (l == 2) ? 0 : 512;
            E.qscale = (l == 1) ? 0.08838834764831845f : 0.125f * LOG2E; E.base = in_fp8(l) ? 1.f / pg8::MOE_S_W1 : 1.f;
            if constexpr (in_fp8(l)) pg8::gemm_phase<pg8::EpiProj, pg8::DenseSched, true, true>(F.tid, F.lds, (const char*)HO, D, D / 128, S, E);
            else pg8::gemm_phase<pg8::EpiProj, pg8::DenseSched, true, false>(F.tid, F.lds, (const char*)HO, D * 2, D / 64, S, E);
            SEAM(pb + 1); PROBE(2, l);
        }
        if (RUN(pb + 2)) { FRESH();
            if (l == 0) { if (ENB(3)) ph_sb_attn(F); } else if (l == 1) { if (ENB(4)) ph_gla_g1(F); } else if (l == 2) { if (ENB(5)) ph_conv(F); } else { if (ENB(6)) ph_dil_attn(F); }
            SEAM(pb + 2); PROBE(3 + l, l);
        }
        if ((l == 1 || l == 3) && RUN(pb + 3)) { FRESH(); if (l == 1) { if (ENB(7)) ph_gla_g2<0>(F); } else { if (ENB(8)) ph_dil_combine(F); } SEAM(pb + 3); PROBE(l == 1 ? 7 : 8, l); }
        if (ENB(7) && l == 1 && RUN(pb + 4)) { FRESH(); ph_gla_g2<1>(F); SEAM(pb + 4); PROBE(7, l); }
        if (ENB(10) && RUN(pb + 6)) { FRESH();
            constexpr int K = (l == 3) ? 512 : D;
            const void* Bt = ws + (l == 0 ? W_SBOUT : l == 1 ? W_GLAOUT : l == 2 ? W_CONVOUT : W_DILOUT);
            pg8::EpiResid<l == 0> E; E.resid = (l == 0) ? (const void*)(const float*)F.p->in[I_X] : (const void*)(ws + WS_XB); E.out = (bf16*)(ws + WS_XB); E.gate = modf + (size_t)l * NB * 6144 + 2 * D; E.ssp = (float*)(ws + WS_SSP);
            if constexpr (out_fp8(l)) {
                const char* A = (l == 1) ? (const char*)(ws + WS_KST) : (const char*)HO;
                pg8::DenseSched S; S.init(T, D, K, Bt, F.G, F.bid); E.gscale = 1.f / pg8::MOE_S_W1;
                pg8::gemm_phase<pg8::EpiResid<l == 0>, pg8::DenseSched, true, true>(F.tid, F.lds, A, K, K / 128, S, E);
            } else {
                const int lda = (l == 0) ? 3072 : K; const char* A = (l == 0) ? (const char*)BIG : (const char*)HO;
                pg8::DenseSched S; S.init(T, D, K * 2, Bt, F.G, F.bid); E.gscale = 1.f;
                pg8::gemm_phase<pg8::EpiResid<l == 0>, pg8::DenseSched, true>(F.tid, F.lds, A, lda * 2, K / 64, S, E);
            }
            SEAM(pb + 6); PROBE(10, l);
        }
        if (ENB(11) && RUN(pb + 7)) { FRESH(); ph_norm2(F, l); SEAM(pb + 7); PROBE(11, l); }
        if (ENB(12) && RUN(pb + 8)) { FRESH(); ph_scatter(F); SEAM(pb + 8); PROBE(12, l); }
        if (ENB(13) && RUN(pb + 9)) { FRESH();
            const int* tile_e = (const int*)(ws + WS_TILEE);
            const int ntiles = __builtin_amdgcn_readfirstlane(__hip_atomic_load(tile_e + 1023, __ATOMIC_RELAXED, __HIP_MEMORY_SCOPE_AGENT));
            pg8::MoeSched<true> S; S.G = F.G; S.c = (F.G % 8 == 0) ? (F.bid % 8) * (F.G / 8) + F.bid / 8 : F.bid;     S.ldb = D; S.Bt = (const char*)(ws + WS_W1T); S.estride = (size_t)1024 * D; S.tile_e = tile_e; S.slot_tok = (const int*)(ws + WS_SLOTTOK); S.nunits = ntiles * 4;
            pg8::EpiMoe1 E; E.O = (unsigned char*)(ws + WS_ACT);
            pg8::gemm_phase<pg8::EpiMoe1, pg8::MoeSched<true>, true, true>(F.tid, F.lds, (const char*)HO, D, D / 128, S, E);
            SEAM(pb + 9); PROBE(13, l);
        }
        if (ENB(14) && RUN(pb + 10)) { FRESH();
            const int* tile_e = (const int*)(ws + WS_TILEE);
            const int ntiles = __builtin_amdgcn_readfirstlane(__hip_atomic_load(tile_e + 1023, __ATOMIC_RELAXED, __HIP_MEMORY_SCOPE_AGENT));
            pg8::MoeSched<false> S; S.G = F.G; S.c = (F.G % 8 == 0) ? (F.bid % 8) * (F.G / 8) + F.bid / 8 : F.bid;     S.ldb = MOE_FF; S.Bt = (const char*)(ws + WS_W2T); S.estride = (size_t)1024 * MOE_FF; S.tile_e = tile_e; S.slot_tok = nullptr; S.nunits = ntiles * 4;
            pg8::EpiY8 E; E.O = ws + WS_YB; E.s = pg8::MOE_S_Y / (pg8::MOE_S_ACT * pg8::MOE_S_W2);
            pg8::gemm_phase<pg8::EpiY8, pg8::MoeSched<false>, true, true>(F.tid, F.lds, (const char*)(ws + WS_ACT), MOE_FF, MOE_FF / 128, S, E);
            SEAM(pb + 10); PROBE(14, l);
        }
    }

__global__ void __launch_bounds__(NTHR, 2) fwd(Params P) {
    extern __shared__ __attribute__((aligned(16))) unsigned char lds_raw[];
    Ctx F;
    F.lds = (LAS unsigned char*)lds_raw; F.MISC = (volatile LAS unsigned*)(F.lds + MISC_OFF);
    F.tid = threadIdx.x; F.lane = F.tid & 63; F.wave = __builtin_amdgcn_readfirstlane(F.tid >> 6); F.G = gridDim.x; F.bid = blockIdx.x; F.p = (const KParams*)__builtin_amdgcn_kernarg_segment_ptr();
    if (F.tid < 128) F.MISC[F.tid] = 0u;
    __syncthreads();
    const int ph_lo = F.p->ph_lo, ph_hi = F.p->ph_hi;
    XcdBarrier bar; bar.bar = nullptr; bar.x = 0; bar.st = nullptr;
#if MK_N_LAUNCHES == 1
    bar = xcd_barrier_post((unsigned*)((unsigned char*)F.p->ws + WS_CTL) + CW_BAR, F.MISC + 8);
#endif
    unsigned long long pr_prev = 0ull, pr_acc = 0ull;
#ifdef PROBE_GROUP
    pr_prev = __builtin_amdgcn_s_memrealtime();
#endif
    if (ENB(0) && RUN(0)) { FRESH(); ph_prologue(F); SEAM0(); PROBE(0, 0); }
    run_layer<0>(F, bar, ph_lo, ph_hi, pr_prev, pr_acc);
    run_layer<1>(F, bar, ph_lo, ph_hi, pr_prev, pr_acc);
    run_layer<2>(F, bar, ph_lo, ph_hi, pr_prev, pr_acc);
    run_layer<3>(F, bar, ph_lo, ph_hi, pr_prev, pr_acc);
    if (ENB(15) && RUN(45)) { FRESH(); ph_final(F); PROBE(15, 0); }
#ifdef PROBE_GROUP
#if PROBE_GROUP == 17
    if (blockIdx.x == 0 && threadIdx.x == 0) { unsigned long long* sp_ = (unsigned long long*)((unsigned char*)F.p->ws + WS_CTL + 65536); pr_acc = 0ull;
        for (int k = 1; k < 45; ++k) { const unsigned long long mn = ~__hip_atomic_load(sp_ + k, __ATOMIC_RELAXED, __HIP_MEMORY_SCOPE_AGENT), mx = __hip_atomic_load(sp_ + 64 + k, __ATOMIC_RELAXED, __HIP_MEMORY_SCOPE_AGENT);
            const int j = (k - 1) % 11, ll = (k - 1) / 11; if (mx != 0ull && (PROBE_LAYER < 0 || j == PROBE_LAYER) && (PROBE_L2 < 0 || ll == PROBE_L2)) pr_acc += mx - mn; } }
#endif
    if (blockIdx.x == 0 && threadIdx.x == 0) { asm volatile("s_waitcnt vmcnt(0)" ::: "memory"); ((float*)F.p->out)[0] = 8.f + (float)pr_acc * (1.f / (100.f * PROBE_UNIT_US)); }
#endif
}
#undef RUN
#undef SEAM
#undef SEAM0
#undef FRESH
#undef PROBE

extern "C" void kernel_launch(void* const* d_in, const int* in_sizes, int n_in, void* d_out, int out_size, void* d_ws, size_t ws_size, hipStream_t stream) {
    static int grid = 0;
    if (grid == 0) {
        if (n_in != 26 || out_size != T * D || ws_size < WS_END) { fprintf(stderr, "kernel_launch: unexpected shapes (n_in %d, out %d, ws %zu < %zu)\n", n_in, out_size, ws_size, (size_t)WS_END); grid = -1; return; }
        int dev = 0, cus = 0, per_cu = 0;
        if (hipGetDevice(&dev) != hipSuccess || hipDeviceGetAttribute(&cus, hipDeviceAttributeMultiprocessorCount, dev) != hipSuccess) { grid = -1; return; }
        if (hipFuncSetAttribute((const void*)fwd, hipFuncAttributeMaxDynamicSharedMemorySize, LDS_BYTES) != hipSuccess) { fprintf(stderr, "kernel_launch: hipFuncSetAttribute failed\n"); grid = -1; return; }
        if (hipOccupancyMaxActiveBlocksPerMultiprocessor(&per_cu, (const void*)fwd, NTHR, LDS_BYTES) != hipSuccess || per_cu < 1) fprintf(stderr, "kernel_launch: occupancy query reports %d\n", per_cu);
        (void)hipGetLastError();
        grid = cus;
    }
    if (grid < 0) return;
    (void)hipMemsetAsync((char*)d_ws + WS_CTL, 0, CTL_ZERO_BYTES, stream);
    Params p{};
    for (int i = 0; i < 26; ++i) p.in[i] = (const float*)d_in[i];
    p.out = (float*)d_out; p.ws = (unsigned char*)d_ws;
#if MK_N_LAUNCHES == 1
    p.ph_lo = 0; p.ph_hi = N_PHASES;
    hipLaunchKernelGGL(fwd, dim3(grid), dim3(NTHR), LDS_BYTES, stream, p);
#else
    for (int k = 0; k < N_PHASES; ++k) { if (!phase_exists(k)) continue; p.ph_lo = k; p.ph_hi = k + 1; hipLaunchKernelGGL(fwd, dim3(grid), dim3(NTHR), LDS_BYTES, stream, p); }
#endif
}
```
